# Optimizing an MI355X kernel written in HIP

```python
import math
import jax
import jax.numpy as jnp
from jax import lax
import numpy as np

D_MODEL = 1024
BATCH = 4
SEQ = 8192
DEPTH = 4
DEC_BATCH = 16
DEC_SEQ = 64
PAST_LEN = 4096

CHUNK = 64
N_MIXERS = 4
Q_BLOCK = 128
NORM_EPS = 1e-6
ROPE_THETA = 10000.0
NEG_INF = -1e30
D_FF = 4 * D_MODEL

S5_GROUP = 16
S5_GROUPS = D_MODEL // S5_GROUP
S5_STATE = 64
S5_SCAN_BLOCK = 128
S5_DT_MIN = 1e-3
S5_DT_MAX = 1e-1

DIFF_HEADS = 8
DIFF_DH = D_MODEL // (2 * DIFF_HEADS)
DIFF_LAYER = 1
LAMBDA_INIT = 0.8 - 0.6 * math.exp(-0.3 * DIFF_LAYER)

MLA_HEADS = 16
MLA_Q_RANK = 256
MLA_KV_RANK = 128
MLA_NOPE = 64
MLA_ROPE = 32
MLA_V = 64
MLA_SCALE = (MLA_NOPE + MLA_ROPE) ** -0.5

SGU_CHUNK = 128
SGU_WIDTH = 2 * D_MODEL
SGU_GROUPS = 8
SGU_GDIM = SGU_WIDTH // SGU_GROUPS

kernel_name = 'hybrid_streaming_encoder_step'


def rmsnorm(x, g):
    xf = x.astype(jnp.float32)
    y = xf * lax.rsqrt(jnp.mean(xf * xf, axis=-1, keepdims=True) + NORM_EPS)
    return (y * g.astype(jnp.float32)).astype(x.dtype)


def modulate(x, g, shift, scale):
    return rmsnorm(x, g) * (1.0 + scale[:, None, :]) + shift[:, None, :]


def rope(x, pos):
    half = x.shape[-1] // 2
    inv_freq = ROPE_THETA ** (-jnp.arange(half, dtype=jnp.float32) / half)
    ang = pos.astype(jnp.float32)[:, None] * inv_freq[None, :]
    cos = jnp.cos(ang)[:, None, :]
    sin = jnp.sin(ang)[:, None, :]
    xf = x.astype(jnp.float32)
    x1, x2 = xf[..., :half], xf[..., half:]
    return jnp.concatenate([x1 * cos - x2 * sin, x1 * sin + x2 * cos], axis=-1).astype(x.dtype)


def block_causal_sweep(fn, q_parts, seq_len):
    nb = seq_len // Q_BLOCK
    key_chunk = jnp.arange(seq_len) // CHUNK

    def to_blocks(a):
        return jnp.moveaxis(a.reshape((a.shape[0], nb, Q_BLOCK) + a.shape[2:]), 1, 0)

    def body(args):
        j, qs = args
        q_chunk = (j * Q_BLOCK + jnp.arange(Q_BLOCK)) // CHUNK
        mask = key_chunk[None, :] <= q_chunk[:, None]
        return fn(qs, mask)

    out = lax.map(body, (jnp.arange(nb), tuple(to_blocks(a) for a in q_parts)))
    out = jnp.moveaxis(out, 0, 1)
    return out.reshape((out.shape[0], seq_len) + out.shape[3:])


def _lin_combine(e1, e2):
    a1, b1 = e1
    a2, b2 = e2
    return a1 * a2, a2 * b1 + b2


def s5_mixer(h, h0_re, h0_im, a_re, a_im, b_re, b_im, c_re, c_im, d, log_dt, w_glu_a, w_glu_b):
    B, L, _ = h.shape
    f32 = jnp.float32
    lam = lax.complex(a_re.astype(f32), a_im.astype(f32))
    dt = jnp.exp(log_dt.astype(f32))[:, None]
    a_bar = jnp.exp(lam * dt)
    b_bar = ((a_bar - 1.0) / lam)[..., None] * lax.complex(b_re.astype(f32), b_im.astype(f32))
    c_mat = lax.complex(c_re.astype(f32), c_im.astype(f32))
    u = h.astype(f32).reshape(B, L, S5_GROUPS, S5_GROUP)
    if h0_re is None:
        h0 = jnp.zeros((B, S5_GROUPS, S5_STATE), jnp.complex64)
    else:
        h0 = lax.complex(h0_re.astype(f32), h0_im.astype(f32))
    T = S5_SCAN_BLOCK if L % S5_SCAN_BLOCK == 0 else L
    ub = jnp.moveaxis(u.reshape(B, L // T, T, S5_GROUPS, S5_GROUP), 1, 0)

    def block(hc, u_blk):
        bu = jnp.einsum('gpc,btgc->btgp', b_bar, u_blk.astype(jnp.complex64))
        bu = bu.at[:, 0].add(a_bar * hc)
        a = jnp.broadcast_to(a_bar, bu.shape)
        _, hs = lax.associative_scan(_lin_combine, (a, bu), axis=1)
        y = jnp.real(jnp.einsum('gcp,btgp->btgc', c_mat, hs))
        return hs[:, -1], y

    h_last, ys = lax.scan(block, h0, ub)
    y = jnp.moveaxis(ys, 0, 1).reshape(B, L, D_MODEL) + d.astype(f32) * h.astype(f32)
    z = jax.nn.gelu(y).astype(h.dtype)
    out = (z @ w_glu_a) * jax.nn.sigmoid(z @ w_glu_b)
    return out, jnp.real(h_last).astype(h.dtype), jnp.imag(h_last).astype(h.dtype)


def diff_core(q, k, v, lam, mask):
    s = jnp.einsum('bqhcd,bkhcd->bhcqk', q, k, preferred_element_type=jnp.float32) * (DIFF_DH ** -0.5)
    if mask is not None:
        s = jnp.where(mask, s, NEG_INF)
    p = jax.nn.softmax(s, axis=-1)
    a = p[:, :, 0] - lam * p[:, :, 1]
    return jnp.einsum('bhqk,bkhe->bqhe', a, v).astype(v.dtype)


def diff_attn_mixer(h, pos, cache_k, cache_v, w_qkv, lq1, lk1, lq2, lk2, g_sub, w_o):
    B, L, _ = h.shape
    q, k, v = jnp.split(h @ w_qkv, 3, axis=-1)
    q = rope(q.reshape(B, L, 2 * DIFF_HEADS, DIFF_DH), pos).reshape(B, L, DIFF_HEADS, 2, DIFF_DH)
    k = rope(k.reshape(B, L, 2 * DIFF_HEADS, DIFF_DH), pos).reshape(B, L, DIFF_HEADS, 2, DIFF_DH)
    v = v.reshape(B, L, DIFF_HEADS, 2 * DIFF_DH)
    f32 = jnp.float32
    lam = (jnp.exp(jnp.sum(lq1.astype(f32) * lk1.astype(f32)))
           - jnp.exp(jnp.sum(lq2.astype(f32) * lk2.astype(f32))) + LAMBDA_INIT)
    if cache_k is None:
        o = block_causal_sweep(lambda qs, m: diff_core(qs[0], k, v, lam, m), (q,), L)
    else:
        P = cache_k.shape[1]
        k_all = jnp.concatenate([cache_k.reshape(B, P, DIFF_HEADS, 2, DIFF_DH), k], axis=1)
        v_all = jnp.concatenate([cache_v, v], axis=1)
        o = diff_core(q, k_all, v_all, lam, None)
    o = rmsnorm(o, g_sub) * (1.0 - LAMBDA_INIT)
    out = o.reshape(B, L, D_MODEL) @ w_o
    return out, k.reshape(B, L, DIFF_HEADS, 2 * DIFF_DH), v


def mla_core(q_nope, q_rope, k_nope, k_rope, v, mask):
    s = (jnp.einsum('bqhn,bkhn->bhqk', q_nope, k_nope, preferred_element_type=jnp.float32)
         + jnp.einsum('bqhe,bke->bhqk', q_rope, k_rope, preferred_element_type=jnp.float32)) * MLA_SCALE
    if mask is not None:
        s = jnp.where(mask, s, NEG_INF)
    p = jax.nn.softmax(s, axis=-1)
    return jnp.einsum('bhqk,bkhv->bqhv', p, v).astype(v.dtype)


def mla_mixer(h, pos, cache_ckv, cache_krope, w_dq, g_q, w_uq, w_dkv, g_kv, w_uk, w_uv, w_o):
    B, L, _ = h.shape
    q = (rmsnorm(h @ w_dq, g_q) @ w_uq).reshape(B, L, MLA_HEADS, MLA_NOPE + MLA_ROPE)
    q_nope = q[..., :MLA_NOPE]
    q_rope = rope(q[..., MLA_NOPE:], pos)
    kv = h @ w_dkv
    ckv = rmsnorm(kv[..., :MLA_KV_RANK], g_kv)
    krope = rope(kv[..., None, MLA_KV_RANK:], pos)[:, :, 0]
    if cache_ckv is None:
        ckv_all, krope_all = ckv, krope
    else:
        ckv_all = jnp.concatenate([cache_ckv, ckv], axis=1)
        krope_all = jnp.concatenate([cache_krope, krope], axis=1)
    k_nope = jnp.einsum('bkr,rhn->bkhn', ckv_all, w_uk)
    v = jnp.einsum('bkr,rhv->bkhv', ckv_all, w_uv)
    if cache_ckv is None:
        o = block_causal_sweep(lambda qs, m: mla_core(qs[0], qs[1], k_nope, krope_all, v, m),
                               (q_nope, q_rope), L)
    else:
        o = mla_core(q_nope, q_rope, k_nope, krope_all, v, None)
    out = o.reshape(B, L, MLA_HEADS * MLA_V) @ w_o
    return out, ckv, krope


def sgu_mixer(h, w_in, g_v, w_s, b_s, w_out):
    B, L, _ = h.shape
    u, v = jnp.split(jax.nn.gelu(h @ w_in), 2, axis=-1)
    v = rmsnorm(v, g_v)
    T = min(L, SGU_CHUNK)
    vb = v.reshape(B, L // T, T, SGU_GROUPS, SGU_GDIM)
    w = jnp.tril(w_s[:, :T, :T])
    sv = jnp.einsum('gts,bnsgd->bntgd', w, vb) + b_s[:, :T].T[:, :, None]
    out = (u * sv.reshape(B, L, SGU_WIDTH)) @ w_out
    return out, v


def sq_relu_mlp(h, w_up, w_down):
    return jnp.square(jax.nn.relu(h @ w_up)) @ w_down


def run_trunk(x, c, pos, past, p):
    new = {}
    cond = jax.nn.silu(c)
    for i in range(DEPTH):
        mod = cond @ p['w_ada'][i] + p['b_ada'][i]
        sh1, sc1, gt1, sh2, sc2, gt2 = jnp.split(mod, 6, axis=-1)
        h = modulate(x, p['g_mix'][i], sh1, sc1)
        kind = i % N_MIXERS
        if kind == 0:
            h0_re = None if past is None else past['s5_re']
            h0_im = None if past is None else past['s5_im']
            out, new['s5_re'], new['s5_im'] = s5_mixer(
                h, h0_re, h0_im, p['s5_a_re'], p['s5_a_im'], p['s5_b_re'], p['s5_b_im'],
                p['s5_c_re'], p['s5_c_im'], p['s5_d'], p['s5_log_dt'], p['s5_w_glu_a'], p['s5_w_glu_b'])
        elif kind == 1:
            ck = None if past is None else past['diff_k']
            cv = None if past is None else past['diff_v']
            out, new['diff_k'], new['diff_v'] = diff_attn_mixer(
                h, pos, ck, cv, p['diff_w_qkv'], p['diff_lambda_q1'], p['diff_lambda_k1'],
                p['diff_lambda_q2'], p['diff_lambda_k2'], p['diff_g_sub'], p['diff_w_o'])
        elif kind == 2:
            cc = None if past is None else past['mla_ckv']
            cr = None if past is None else past['mla_krope']
            out, new['mla_ckv'], new['mla_krope'] = mla_mixer(
                h, pos, cc, cr, p['mla_w_dq'], p['mla_g_q'], p['mla_w_uq'], p['mla_w_dkv'],
                p['mla_g_kv'], p['mla_w_uk'], p['mla_w_uv'], p['mla_w_o'])
        else:
            out, new['sgu_v'] = sgu_mixer(h, p['sgu_w_in'], p['sgu_g_v'], p['sgu_w_s'],
                                          p['sgu_b_s'], p['sgu_w_out'])
        x = x + (1.0 + gt1)[:, None, :] * out
        h = modulate(x, p['g_ffn'][i], sh2, sc2)
        x = x + (1.0 + gt2)[:, None, :] * sq_relu_mlp(h, p['w_up'][i], p['w_down'][i])
    return rmsnorm(x, p['g_final']), new


def setup_inputs(seed: int = 0) -> dict:
    key = jax.random.key(seed)
    keys = list(jax.random.split(key, 64))
    f32 = jnp.float32
    counter = [0]

    def nxt():
        k = keys[counter[0]]
        counter[0] += 1
        return k

    def nrm(shape, scale=1.0):
        return jax.random.normal(nxt(), shape, f32) * scale

    D = D_MODEL
    G, P, C = S5_GROUPS, S5_STATE, S5_GROUP
    n_idx = jnp.arange(P, dtype=f32)[None, :]
    out = {}
    out['x_prompt'] = nrm((BATCH, SEQ, D))
    out['x_sample'] = nrm((DEC_BATCH, DEC_SEQ, D))
    out['c_prompt'] = nrm((BATCH, D))
    out['c_sample'] = nrm((DEC_BATCH, D))
    out['state_s5_re'] = nrm((DEC_BATCH, G, P), 0.3)
    out['state_s5_im'] = nrm((DEC_BATCH, G, P), 0.3)
    out['cache_diff_k'] = nrm((DEC_BATCH, PAST_LEN, DIFF_HEADS, 2 * DIFF_DH))
    out['cache_diff_v'] = nrm((DEC_BATCH, PAST_LEN, DIFF_HEADS, 2 * DIFF_DH))
    out['cache_mla_ckv'] = nrm((DEC_BATCH, PAST_LEN, MLA_KV_RANK))
    out['cache_mla_krope'] = nrm((DEC_BATCH, PAST_LEN, MLA_ROPE))
    out['w_ada'] = nrm((DEPTH, D, 6 * D), 0.1 * D ** -0.5)
    out['b_ada'] = nrm((DEPTH, 6 * D), 0.01)
    out['g_mix'] = 1.0 + nrm((DEPTH, D), 0.05)
    out['g_ffn'] = 1.0 + nrm((DEPTH, D), 0.05)
    out['w_up'] = nrm((DEPTH, D, D_FF), D ** -0.5)
    out['w_down'] = nrm((DEPTH, D_FF, D), D_FF ** -0.5)
    out['g_final'] = 1.0 + nrm((D,), 0.05)
    out['s5_a_re'] = -0.5 + nrm((G, P), 0.01)
    out['s5_a_im'] = math.pi * n_idx + nrm((G, P), 0.01)
    out['s5_b_re'] = nrm((G, P, C), (2 * C) ** -0.5)
    out['s5_b_im'] = nrm((G, P, C), (2 * C) ** -0.5)
    out['s5_c_re'] = nrm((G, C, P), (2 * P) ** -0.5)
    out['s5_c_im'] = nrm((G, C, P), (2 * P) ** -0.5)
    out['s5_d'] = nrm((D,))
    out['s5_log_dt'] = jax.random.uniform(nxt(), (G,), f32, math.log(S5_DT_MIN), math.log(S5_DT_MAX))
    out['s5_w_glu_a'] = nrm((D, D), D ** -0.5)
    out['s5_w_glu_b'] = nrm((D, D), D ** -0.5)
    out['diff_w_qkv'] = nrm((D, 3 * D), D ** -0.5)
    out['diff_lambda_q1'] = nrm((DIFF_DH,), 0.1)
    out['diff_lambda_k1'] = nrm((DIFF_DH,), 0.1)
    out['diff_lambda_q2'] = nrm((DIFF_DH,), 0.1)
    out['diff_lambda_k2'] = nrm((DIFF_DH,), 0.1)
    out['diff_g_sub'] = 1.0 + nrm((2 * DIFF_DH,), 0.05)
    out['diff_w_o'] = nrm((D, D), D ** -0.5)
    out['mla_w_dq'] = nrm((D, MLA_Q_RANK), D ** -0.5)
    out['mla_g_q'] = 1.0 + nrm((MLA_Q_RANK,), 0.05)
    out['mla_w_uq'] = nrm((MLA_Q_RANK, MLA_HEADS * (MLA_NOPE + MLA_ROPE)), MLA_Q_RANK ** -0.5)
    out['mla_w_dkv'] = nrm((D, MLA_KV_RANK + MLA_ROPE), D ** -0.5)
    out['mla_g_kv'] = 1.0 + nrm((MLA_KV_RANK,), 0.05)
    out['mla_w_uk'] = nrm((MLA_KV_RANK, MLA_HEADS, MLA_NOPE), MLA_KV_RANK ** -0.5)
    out['mla_w_uv'] = nrm((MLA_KV_RANK, MLA_HEADS, MLA_V), MLA_KV_RANK ** -0.5)
    out['mla_w_o'] = nrm((MLA_HEADS * MLA_V, D), (MLA_HEADS * MLA_V) ** -0.5)
    out['sgu_w_in'] = nrm((D, 2 * SGU_WIDTH), D ** -0.5)
    out['sgu_g_v'] = 1.0 + nrm((SGU_WIDTH,), 0.05)
    out['sgu_w_s'] = nrm((SGU_GROUPS, SGU_CHUNK, SGU_CHUNK), SGU_CHUNK ** -0.5)
    out['sgu_b_s'] = 1.0 + nrm((SGU_GROUPS, SGU_CHUNK), 0.05)
    out['sgu_w_out'] = nrm((SGU_WIDTH, D), SGU_WIDTH ** -0.5)
    return out


def reference(x_prompt, x_sample, c_prompt, c_sample, state_s5_re, state_s5_im,
              cache_diff_k, cache_diff_v, cache_mla_ckv, cache_mla_krope,
              w_ada, b_ada, g_mix, g_ffn, w_up, w_down, g_final,
              s5_a_re, s5_a_im, s5_b_re, s5_b_im, s5_c_re, s5_c_im, s5_d, s5_log_dt,
              s5_w_glu_a, s5_w_glu_b,
              diff_w_qkv, diff_lambda_q1, diff_lambda_k1, diff_lambda_q2, diff_lambda_k2,
              diff_g_sub, diff_w_o,
              mla_w_dq, mla_g_q, mla_w_uq, mla_w_dkv, mla_g_kv, mla_w_uk, mla_w_uv, mla_w_o,
              sgu_w_in, sgu_g_v, sgu_w_s, sgu_b_s, sgu_w_out):
    params = {
        'w_ada': w_ada, 'b_ada': b_ada, 'g_mix': g_mix, 'g_ffn': g_ffn,
        'w_up': w_up, 'w_down': w_down, 'g_final': g_final,
        's5_a_re': s5_a_re, 's5_a_im': s5_a_im, 's5_b_re': s5_b_re, 's5_b_im': s5_b_im,
        's5_c_re': s5_c_re, 's5_c_im': s5_c_im, 's5_d': s5_d, 's5_log_dt': s5_log_dt,
        's5_w_glu_a': s5_w_glu_a, 's5_w_glu_b': s5_w_glu_b,
        'diff_w_qkv': diff_w_qkv, 'diff_lambda_q1': diff_lambda_q1, 'diff_lambda_k1': diff_lambda_k1,
        'diff_lambda_q2': diff_lambda_q2, 'diff_lambda_k2': diff_lambda_k2,
        'diff_g_sub': diff_g_sub, 'diff_w_o': diff_w_o,
        'mla_w_dq': mla_w_dq, 'mla_g_q': mla_g_q, 'mla_w_uq': mla_w_uq, 'mla_w_dkv': mla_w_dkv,
        'mla_g_kv': mla_g_kv, 'mla_w_uk': mla_w_uk, 'mla_w_uv': mla_w_uv, 'mla_w_o': mla_w_o,
        'sgu_w_in': sgu_w_in, 'sgu_g_v': sgu_g_v, 'sgu_w_s': sgu_w_s, 'sgu_b_s': sgu_b_s,
        'sgu_w_out': sgu_w_out,
    }
    past = {
        's5_re': state_s5_re, 's5_im': state_s5_im,
        'diff_k': cache_diff_k, 'diff_v': cache_diff_v,
        'mla_ckv': cache_mla_ckv, 'mla_krope': cache_mla_krope,
    }
    pos_p = jnp.arange(x_prompt.shape[1], dtype=jnp.int32)
    pos_s = cache_diff_k.shape[1] + jnp.arange(x_sample.shape[1], dtype=jnp.int32)
    y_prompt, sp = run_trunk(x_prompt, c_prompt, pos_p, None, params)
    y_sample, ss = run_trunk(x_sample, c_sample, pos_s, past, params)
    return (y_prompt, y_sample,
            sp['s5_re'], sp['s5_im'], ss['s5_re'], ss['s5_im'],
            sp['diff_k'], sp['diff_v'], ss['diff_k'], ss['diff_v'],
            sp['mla_ckv'], sp['mla_krope'], ss['mla_ckv'], ss['mla_krope'],
            ss['sgu_v'])
```

```cpp
#include <hip/hip_runtime.h>
#include <hip/hip_cooperative_groups.h>
#include <stdint.h>
#include <stdio.h>
namespace cg = cooperative_groups;

#ifndef MK_SINGLE
#define MK_SINGLE 1
#endif

typedef unsigned short bf16_t;
typedef __attribute__((ext_vector_type(8))) short bf16x8;
typedef __attribute__((ext_vector_type(4))) short s16x4;
typedef __attribute__((ext_vector_type(4))) unsigned u32x4;
typedef __attribute__((ext_vector_type(16))) float f32x16;
typedef __bf16 bf2_t __attribute__((ext_vector_type(2)));
typedef float fl2_t __attribute__((ext_vector_type(2)));
#define DI __device__ __forceinline__
#define MFMA(a, b, c) __builtin_amdgcn_mfma_f32_32x32x16_bf16((a), (b), (c), 0, 0, 0)

constexpr int NTP = 32768, NTS = 1024, NT = 33792;
constexpr int SLK = 4160;
constexpr int KROWS = 99328;
constexpr float NORM_EPS = 1e-6f;
constexpr float LAMBDA_INIT = 0.35550906759096933f;
constexpr float L2E = 1.4426950408889634f;

constexpr size_t O_S5RP = (size_t)NT * 1024, O_S5IP = O_S5RP + 16384, O_S5RS = O_S5IP + 16384, O_S5IS = O_S5RS + 65536,
                 O_DKP = O_S5IS + 65536, O_DVP = O_DKP + (size_t)NTP * 1024, O_DKS = O_DVP + (size_t)NTP * 1024,
                 O_DVS = O_DKS + (size_t)NTS * 1024, O_CKP = O_DVS + (size_t)NTS * 1024, O_KRP = O_CKP + (size_t)NTP * 128,
                 O_CKS = O_KRP + (size_t)NTP * 32, O_KRS = O_CKS + (size_t)NTS * 128, O_SGV = O_KRS + (size_t)NTS * 32;

constexpr size_t W_CTRL = 0;
constexpr size_t W_LAM = 4096;
constexpr size_t W_MODP = W_LAM + 256;
constexpr size_t W_MOD = W_MODP + 8ull * 20 * 24576 * 4;
constexpr size_t W_AP = W_MOD + 20ull * 24576 * 4;
constexpr size_t W_BBAR = W_AP + 64ull * 65 * 64 * 8;
constexpr size_t W_E = W_BBAR + 64ull * 64 * 16 * 8;
constexpr size_t W_CH = W_E + 64ull * 16 * 2048 * 2;
constexpr size_t W_MEND = W_CH + 64ull * 1024 * 128 * 2;
constexpr size_t W_WS1 = W_MEND + 64ull * 128 * 1024 * 2;
constexpr size_t W_WS2 = W_WS1 + 8ull * 128 * 128 * 2;
constexpr size_t W_WUP = W_WS2 + 8ull * 128 * 128 * 2;
constexpr size_t W_WDN = W_WUP + 4ull * 4096 * 1024 * 2;
constexpr size_t W_GLU = W_WDN + 4ull * 4096 * 1024 * 2;
constexpr size_t W_QKV = W_GLU + 2048ull * 1024 * 2;
constexpr size_t W_DWO = W_QKV + 3072ull * 1024 * 2;
constexpr size_t W_MD = W_DWO + 1024ull * 1024 * 2;
constexpr size_t W_MUQ = W_MD + 512ull * 1024 * 2;
constexpr size_t W_MUKV = W_MUQ + 1536ull * 256 * 2;
constexpr size_t W_MWO = W_MUKV + 2048ull * 128 * 2;
constexpr size_t W_SIN = W_MWO + 1024ull * 1024 * 2;
constexpr size_t W_SOUT = W_SIN + 4096ull * 1024 * 2;
constexpr size_t W_H = W_SOUT + 1024ull * 2048 * 2;
constexpr size_t W_BIG = W_H + (size_t)NT * 1024 * 2;
constexpr size_t B_HG = 0, B_SLOC = 94371840ull, B_Z = 115343360ull;
constexpr size_t B_ACT = 0;
constexpr size_t B_QB = 0, B_KB = 69206016ull, B_VTD = 272629760ull, B_OB = 476053504ull;
constexpr size_t B_RAW = 0, B_CQ = 51904512ull, B_OBM = 0, B_CKV = 69206016ull, B_KR = 94633984ull, B_QM = 100990976ull,
                 B_KN = 204800000ull, B_VTM = 408223744ull;
constexpr size_t B_U = 0, B_VRAW = 138412032ull, B_VTS = 276824064ull, B_G = 415236096ull;
constexpr size_t WS_NEED = W_BIG + 611647488ull;

struct P {
  const float* in[47];
  float* out;
  unsigned char* ws;
  int lo, hi;
};

DI unsigned pack2(float a, float b) {
  fl2_t f = {a, b};
  bf2_t r = __builtin_convertvector(f, bf2_t);
  return __builtin_bit_cast(unsigned, r);
}
DI bf16_t f2bf(float a) { return (bf16_t)(pack2(a, 0.f) & 0xffffu); }
DI float bf2f(bf16_t v) { return __uint_as_float(((unsigned)v) << 16); }
DI float gelu_t(float x) {
  float u = 0.7978845608028654f * (x + 0.044715f * x * x * x);
  float t = 1.f - 2.f / (__expf(2.f * u) + 1.f);
  return 0.5f * x * (1.f + t);
}
DI float sigmoid_f(float x) { return 1.f / (1.f + __expf(-x)); }
DI int batch_of(int row) { return row < NTP ? (row >> 13) : 4 + ((row - NTP) >> 6); }
DI int pos_of(int row) { return row < NTP ? (row & 8191) : 4096 + ((row - NTP) & 63); }
DI int krow_of(int row) { return row < NTP ? row : NTP + ((row - NTP) >> 6) * SLK + 4096 + ((row - NTP) & 63); }
DI void rope_cs(int pos, float invf, float& c, float& s) {
  double t = (double)pos * (double)invf * 0.15915494309189535;
  t -= __builtin_rint(t);
  float ft = (float)t;
  c = __builtin_amdgcn_cosf(ft);
  s = __builtin_amdgcn_sinf(ft);
}
DI float wave_sum(float v) {
#pragma unroll
  for (int o = 32; o > 0; o >>= 1) v += __shfl_xor(v, o);
  return v;
}

constexpr int LST = 72;
template <class AF, class BF, class EPI>
DI void gemm_tile(bf16_t* smem, AF af, BF bf, int nkt, EPI epi) {
  const int tid = threadIdx.x, lane = tid & 63, wave = tid >> 6;
  const int wm = wave >> 1, wn = wave & 1, r = lane & 31, h = lane >> 5;
  bf16_t* sA = smem;
  bf16_t* sB = smem + 2 * 128 * LST;
  f32x16 acc[2][2];
#pragma unroll
  for (int a = 0; a < 2; ++a)
#pragma unroll
    for (int b = 0; b < 2; ++b)
#pragma unroll
      for (int i = 0; i < 16; ++i) acc[a][b][i] = 0.f;
  const int lr = tid >> 3, lc = (tid & 7) * 8;
  uint4 ra[4], rb[4];
#pragma unroll
  for (int i = 0; i < 4; ++i) {
    ra[i] = *(const uint4*)(af(lr + 32 * i, 0) + lc);
    rb[i] = *(const uint4*)(bf(lr + 32 * i, 0) + lc);
  }
#pragma unroll
  for (int i = 0; i < 4; ++i) {
    *(uint4*)(sA + (lr + 32 * i) * LST + lc) = ra[i];
    *(uint4*)(sB + (lr + 32 * i) * LST + lc) = rb[i];
  }
  __syncthreads();
  for (int kt = 0; kt < nkt; ++kt) {
    const bool more = (kt + 1 < nkt);
    if (more) {
#pragma unroll
      for (int i = 0; i < 4; ++i) {
        ra[i] = *(const uint4*)(af(lr + 32 * i, kt + 1) + lc);
        rb[i] = *(const uint4*)(bf(lr + 32 * i, kt + 1) + lc);
      }
    }
    const bf16_t* pa = sA + (kt & 1) * 128 * LST + (wm * 64 + r) * LST + h * 8;
    const bf16_t* pb = sB + (kt & 1) * 128 * LST + (wn * 64 + r) * LST + h * 8;
#pragma unroll
    for (int ks = 0; ks < 4; ++ks) {
      bf16x8 a0 = *(const bf16x8*)(pa + ks * 16);
      bf16x8 a1 = *(const bf16x8*)(pa + 32 * LST + ks * 16);
      bf16x8 b0 = *(const bf16x8*)(pb + ks * 16);
      bf16x8 b1 = *(const bf16x8*)(pb + 32 * LST + ks * 16);
      acc[0][0] = MFMA(a0, b0, acc[0][0]);
      acc[0][1] = MFMA(a0, b1, acc[0][1]);
      acc[1][0] = MFMA(a1, b0, acc[1][0]);
      acc[1][1] = MFMA(a1, b1, acc[1][1]);
    }
    if (more) {
      const int nb = ((kt + 1) & 1) * 128 * LST;
#pragma unroll
      for (int i = 0; i < 4; ++i) {
        *(uint4*)(sA + nb + (lr + 32 * i) * LST + lc) = ra[i];
        *(uint4*)(sB + nb + (lr + 32 * i) * LST + lc) = rb[i];
      }
    }
    __syncthreads();
  }
#pragma unroll
  for (int mi = 0; mi < 2; ++mi)
#pragma unroll
    for (int g = 0; g < 4; ++g) {
      float4 v0 = {acc[mi][0][4 * g], acc[mi][0][4 * g + 1], acc[mi][0][4 * g + 2], acc[mi][0][4 * g + 3]};
      float4 v1 = {acc[mi][1][4 * g], acc[mi][1][4 * g + 1], acc[mi][1][4 * g + 2], acc[mi][1][4 * g + 3]};
      epi(wm * 64 + mi * 32 + 8 * g + 4 * h, wn * 64 + r, v0, v1);
      __builtin_amdgcn_sched_barrier(0);
    }
}

DI float f4get(const float4& v, int j) { return j == 0 ? v.x : (j == 1 ? v.y : (j == 2 ? v.z : v.w)); }

template <class F>
DI void prep_w(bf16_t* dst, int K, int N, int ld, F colsrc) {
  const long total = (long)N * (K / 8);
  for (long idx = (long)blockIdx.x * 256 + threadIdx.x; idx < total; idx += (long)gridDim.x * 256) {
    const int n = (int)(idx % N);
    const int kg = (int)(idx / N);
    const float* s = colsrc(n);
    uint4 o = {0u, 0u, 0u, 0u};
    if (s) {
      s += (long)kg * 8 * ld;
      float v0 = s[0], v1 = s[(long)ld], v2 = s[2l * ld], v3 = s[3l * ld], v4 = s[4l * ld], v5 = s[5l * ld], v6 = s[6l * ld], v7 = s[7l * ld];
      o.x = pack2(v0, v1); o.y = pack2(v2, v3); o.z = pack2(v4, v5); o.w = pack2(v6, v7);
    }
    *(uint4*)(dst + (long)n * K + kg * 8) = o;
  }
}

DI void phase0(const P& p, float* smf) {
  unsigned char* ws = p.ws;
  const int gt = blockIdx.x * 256 + threadIdx.x, gs = gridDim.x * 256;
  {
    float* modp = (float*)(ws + W_MODP);
    for (int it = blockIdx.x; it < 768; it += gridDim.x) {
      const int kc = it / 96, ch = it % 96;
      __syncthreads();
      for (int e = threadIdx.x; e < 20 * 128; e += 256) {
        const int m = e >> 7, k = e & 127;
        const float c = (m < 4) ? p.in[2][m * 1024 + kc * 128 + k] : p.in[3][(m - 4) * 1024 + kc * 128 + k];
        smf[k * 20 + m] = c / (1.f + __expf(-c));
      }
      __syncthreads();
      const int n = ch * 256 + threadIdx.x;
      const int layer = n / 6144, col = n % 6144;
      const float* w = p.in[10] + ((long)(layer * 1024 + kc * 128)) * 6144 + col;
      float acc[20];
#pragma unroll
      for (int m = 0; m < 20; ++m) acc[m] = 0.f;
      for (int k = 0; k < 128; ++k) {
        const float wv = w[(long)k * 6144];
#pragma unroll
        for (int m = 0; m < 20; ++m) acc[m] += smf[k * 20 + m] * wv;
      }
#pragma unroll
      for (int m = 0; m < 20; ++m) modp[(long)(kc * 20 + m) * 24576 + n] = acc[m];
    }
  }
  {
    float2* ap = (float2*)(ws + W_AP);
    for (int idx = gt; idx < 64 * 65 * 64; idx += gs) {
      const int g = idx / (65 * 64), tau = (idx / 64) % 65, pp = idx & 63;
      const float dt = expf(p.in[24][g]);
      const float are = p.in[17][g * 64 + pp], aim = p.in[18][g * 64 + pp];
      const float mag = expf(are * dt * (float)tau);
      double t = (double)aim * (double)dt * (double)tau * 0.15915494309189535;
      t -= __builtin_rint(t);
      const float ft = (float)t;
      ap[idx] = make_float2(mag * __builtin_amdgcn_cosf(ft), mag * __builtin_amdgcn_sinf(ft));
    }
    float2* bb = (float2*)(ws + W_BBAR);
    for (int idx = gt; idx < 64 * 64 * 16; idx += gs) {
      const int g = idx / 1024, pp = (idx >> 4) & 63;
      const float dt = expf(p.in[24][g]);
      const float are = p.in[17][g * 64 + pp], aim = p.in[18][g * 64 + pp];
      const float mag = expf(are * dt);
      double t = (double)aim * (double)dt * 0.15915494309189535;
      t -= __builtin_rint(t);
      const float ft = (float)t;
      const float nr = mag * __builtin_amdgcn_cosf(ft) - 1.f, ni = mag * __builtin_amdgcn_sinf(ft);
      const float den = are * are + aim * aim;
      const float qr = (nr * are + ni * aim) / den, qi = (ni * are - nr * aim) / den;
      const float br = p.in[19][idx], bi = p.in[20][idx];
      bb[idx] = make_float2(qr * br - qi * bi, qr * bi + qi * br);
    }
  }
  if (gt == 0) {
    float s1 = 0.f, s2 = 0.f;
    for (int i = 0; i < 64; ++i) { s1 += p.in[28][i] * p.in[29][i]; s2 += p.in[30][i] * p.in[31][i]; }
    *(float*)(ws + W_LAM) = expf(s1) - expf(s2) + LAMBDA_INIT;
  }
  {
    bf16_t* w1 = (bf16_t*)(ws + W_WS1);
    bf16_t* w2 = (bf16_t*)(ws + W_WS2);
    const float* wsrc = p.in[44];
    for (int idx = gt; idx < 8 * 128 * 128; idx += gs) {
      const int g = idx >> 14, t = (idx >> 7) & 127, s = idx & 127;
      w1[idx] = f2bf(s <= t ? wsrc[idx] : 0.f);
      const int tt = t & 63, ss = s & 63;
      w2[idx] = f2bf(((t >> 6) == (s >> 6) && ss <= tt) ? wsrc[(g * 128 + tt) * 128 + ss] : 0.f);
    }
  }
  for (int l = 0; l < 4; ++l) {
    const float* up = p.in[14] + (long)l * 1024 * 4096;
    prep_w((bf16_t*)(ws + W_WUP) + (long)l * 4096 * 1024, 1024, 4096, 4096, [=](int n) { return up + n; });
    const float* dn = p.in[15] + (long)l * 4096 * 1024;
    prep_w((bf16_t*)(ws + W_WDN) + (long)l * 1024 * 4096, 4096, 1024, 1024, [=](int n) { return dn + n; });
  }
  {
    const float* ga = p.in[25]; const float* gb = p.in[26];
    prep_w((bf16_t*)(ws + W_GLU), 1024, 2048, 1024, [=](int n) { const int sp = n >> 6, w = n & 63; return ((w < 32) ? ga : gb) + sp * 32 + (w & 31); });
    const float* s = p.in[27];
    prep_w((bf16_t*)(ws + W_QKV), 1024, 3072, 3072, [=](int n) { return s + n; });
    const float* s2 = p.in[33];
    prep_w((bf16_t*)(ws + W_DWO), 1024, 1024, 1024, [=](int n) { return s2 + n; });
    const float* dq = p.in[34];
    prep_w((bf16_t*)(ws + W_MD), 1024, 256, 256, [=](int n) { return dq + n; });
    const float* dkv = p.in[37];
    prep_w((bf16_t*)(ws + W_MD) + 256 * 1024, 1024, 256, 160, [=](int n) -> const float* {
      if (n < 128) return dkv + n;
      const int w = n - 128;
      if (w < 16) return dkv + 128 + w;
      if (w >= 32 && w < 48) return dkv + 144 + (w - 32);
      return nullptr;
    });
    const float* uq = p.in[36];
    prep_w((bf16_t*)(ws + W_MUQ), 256, 1536, 1536, [=](int n) {
      if (n < 1024) return uq + (n >> 6) * 96 + (n & 63);
      const int sp = (n - 1024) >> 6, w = (n - 1024) & 63, half = w >> 5, ix = w & 31;
      const int head = sp * 2 + (ix >> 4), i = ix & 15;
      return uq + head * 96 + 64 + half * 16 + i;
    });
    const float* uk = p.in[39]; const float* uv = p.in[40];
    prep_w((bf16_t*)(ws + W_MUKV), 128, 2048, 1024, [=](int n) { return n < 1024 ? uk + n : uv + (n - 1024); });
    const float* mwo = p.in[41];
    prep_w((bf16_t*)(ws + W_MWO), 1024, 1024, 1024, [=](int n) { return mwo + n; });
    const float* sin_ = p.in[42];
    prep_w((bf16_t*)(ws + W_SIN), 1024, 4096, 4096, [=](int n) { return sin_ + n; });
    const float* sout = p.in[46];
    prep_w((bf16_t*)(ws + W_SOUT), 2048, 1024, 1024, [=](int n) { return sout + n; });
  }
}

DI void phase1(const P& p) {
  unsigned char* ws = p.ws;
  const int gt = blockIdx.x * 256 + threadIdx.x, gs = gridDim.x * 256;
  {
    const float* modp = (const float*)(ws + W_MODP);
    float* mod = (float*)(ws + W_MOD);
    for (int idx = gt; idx < 20 * 24576; idx += gs) {
      const int n = idx % 24576;
      float s = p.in[11][n];
#pragma unroll
      for (int kc = 0; kc < 8; ++kc) s += modp[(long)kc * 20 * 24576 + idx];
      mod[idx] = s;
    }
  }
  const float2* ap = (const float2*)(ws + W_AP);
  const float2* bb = (const float2*)(ws + W_BBAR);
  const float* cre = p.in[21]; const float* cim = p.in[22];
  {
    bf16_t* E = (bf16_t*)(ws + W_E);
    for (int idx = gt; idx < 64 * 16 * 2048; idx += gs) {
      const int g = idx >> 15, co = (idx >> 11) & 15, j = idx & 2047;
      float v = 0.f;
      if (j < 1024) {
        const int tau = 63 - (j >> 4), ci = j & 15;
        for (int pp = 0; pp < 64; ++pp) {
          const float2 a = ap[(g * 65 + tau) * 64 + pp];
          const float2 b = bb[(g * 64 + pp) * 16 + ci];
          const float cr = cre[(g * 16 + co) * 64 + pp], cimv = cim[(g * 16 + co) * 64 + pp];
          const float abr = a.x * b.x - a.y * b.y, abi = a.x * b.y + a.y * b.x;
          v += cr * abr - cimv * abi;
        }
        if (tau == 0 && co == ci) v += p.in[23][g * 16 + co];
      }
      E[idx] = f2bf(v);
    }
    bf16_t* CH = (bf16_t*)(ws + W_CH);
    for (int idx = gt; idx < 64 * 1024 * 128; idx += gs) {
      const int g = idx >> 17, m = (idx >> 7) & 1023, q = idx & 127;
      const int t = m >> 4, co = m & 15, pp = q & 63;
      const float2 a = ap[(g * 65 + t + 1) * 64 + pp];
      const float cr = cre[(g * 16 + co) * 64 + pp], cimv = cim[(g * 16 + co) * 64 + pp];
      const float zr = cr * a.x - cimv * a.y, zi = cr * a.y + cimv * a.x;
      CH[idx] = f2bf(q < 64 ? zr : -zi);
    }
    bf16_t* ME = (bf16_t*)(ws + W_MEND);
    for (int idx = gt; idx < 64 * 128 * 1024; idx += gs) {
      const int g = idx >> 17, q = (idx >> 10) & 127, k = idx & 1023;
      const int s = k >> 4, c = k & 15, pp = q & 63;
      const float2 a = ap[(g * 65 + 63 - s) * 64 + pp];
      const float2 b = bb[(g * 64 + pp) * 16 + c];
      ME[idx] = f2bf(q < 64 ? (a.x * b.x - a.y * b.y) : (a.x * b.y + a.y * b.x));
    }
  }
}

template <int MODE>
DI void phase_modulate(const P& p, int layer, int which) {
  unsigned char* ws = p.ws;
  const float* mod = (const float*)(ws + W_MOD);
  const float* gam = (which == 0 ? p.in[12] : p.in[13]) + layer * 1024;
  const int lane = threadIdx.x & 63;
  const int wv = blockIdx.x * 4 + (threadIdx.x >> 6), nwv = gridDim.x * 4;
  bf16_t* H = (bf16_t*)(ws + W_H);
  bf16_t* HG = (bf16_t*)(ws + W_BIG + B_HG);
  for (int row = wv; row < NT; row += nwv) {
    const float* x = (MODE == 1) ? (row < NTP ? p.in[0] + (long)row * 1024 : p.in[1] + (long)(row - NTP) * 1024) : p.out + (long)row * 1024;
    float4 v[4];
    float ss = 0.f;
#pragma unroll
    for (int i = 0; i < 4; ++i) {
      v[i] = *(const float4*)(x + lane * 4 + 256 * i);
      ss += v[i].x * v[i].x + v[i].y * v[i].y + v[i].z * v[i].z + v[i].w * v[i].w;
    }
    ss = wave_sum(ss);
    const float rinv = rsqrtf(ss * (1.f / 1024.f) + NORM_EPS);
    const int b = batch_of(row);
    const float* sh = mod + (long)b * 24576 + layer * 6144 + (which * 3) * 1024;
    const float* sc = sh + 1024;
#pragma unroll
    for (int i = 0; i < 4; ++i) {
      const int col = lane * 4 + 256 * i;
      const float4 g4 = *(const float4*)(gam + col), sh4 = *(const float4*)(sh + col), sc4 = *(const float4*)(sc + col);
      const float h0 = v[i].x * rinv * g4.x * (1.f + sc4.x) + sh4.x;
      const float h1 = v[i].y * rinv * g4.y * (1.f + sc4.y) + sh4.y;
      const float h2 = v[i].z * rinv * g4.z * (1.f + sc4.z) + sh4.z;
      const float h3 = v[i].w * rinv * g4.w * (1.f + sc4.w) + sh4.w;
      uint2 o = {pack2(h0, h1), pack2(h2, h3)};
      if (MODE == 1) {
        *(float4*)(p.out + (long)row * 1024 + col) = v[i];
        const int g = col >> 4, c = col & 15, n = row >> 6, s = row & 63;
        *(uint2*)(HG + ((long)(g * 640 + n)) * 1152 + s * 16 + c) = o;
      } else {
        *(uint2*)(H + (long)row * 1024 + col) = o;
      }
    }
  }
}

DI void phase_s5_carry(const P& p) {
  unsigned char* ws = p.ws;
  const float2* ap = (const float2*)(ws + W_AP);
  const float* sloc = (const float*)(ws + W_BIG + B_SLOC);
  bf16_t* HG = (bf16_t*)(ws + W_BIG + B_HG);
  const int gt = blockIdx.x * 256 + threadIdx.x, gs = gridDim.x * 256;
  for (int idx = gt; idx < 64 * 20 * 64; idx += gs) {
    const int g = idx / 1280, bb = (idx >> 6) % 20, pp = idx & 63;
    const float2 a = ap[(g * 65 + 64) * 64 + pp];
    if (bb < 4) {
      float hr = 0.f, hi = 0.f;
#pragma unroll 8
      for (int k = 0; k < 128; ++k) {
        const long n = (long)g * 640 + bb * 128 + k;
        HG[n * 1152 + 1024 + pp] = f2bf(hr);
        HG[n * 1152 + 1088 + pp] = f2bf(hi);
        const float sr = sloc[n * 128 + pp], si = sloc[n * 128 + 64 + pp];
        const float nr = a.x * hr - a.y * hi + sr, ni = a.x * hi + a.y * hr + si;
        hr = nr; hi = ni;
      }
      p.out[O_S5RP + (bb * 64 + g) * 64 + pp] = hr;
      p.out[O_S5IP + (bb * 64 + g) * 64 + pp] = hi;
    } else {
      const int b = bb - 4;
      const long n = (long)g * 640 + 512 + b;
      float hr = p.in[4][(b * 64 + g) * 64 + pp], hi = p.in[5][(b * 64 + g) * 64 + pp];
      HG[n * 1152 + 1024 + pp] = f2bf(hr);
      HG[n * 1152 + 1088 + pp] = f2bf(hi);
      const float sr = sloc[n * 128 + pp], si = sloc[n * 128 + 64 + pp];
      p.out[O_S5RS + (b * 64 + g) * 64 + pp] = a.x * hr - a.y * hi + sr;
      p.out[O_S5IS + (b * 64 + g) * 64 + pp] = a.x * hi + a.y * hr + si;
    }
  }
}

DI const float* mod_ptr(const P& p, int layer, int k) { return (const float*)(p.ws + W_MOD) + layer * 6144 + k * 1024; }

DI void phase_s5a(const P& p, bf16_t* smem) {
  const bf16_t* HG = (const bf16_t*)(p.ws + W_BIG + B_HG);
  const bf16_t* ME = (const bf16_t*)(p.ws + W_MEND);
  float* sloc = (float*)(p.ws + W_BIG + B_SLOC);
  for (int t = blockIdx.x; t < 64 * 5; t += gridDim.x) {
    const int g = t / 5, mi = t % 5;
    const bf16_t* a0 = HG + (long)(g * 640 + mi * 128) * 1152;
    const bf16_t* b0 = ME + (long)g * 128 * 1024;
    float* o = sloc + (long)(g * 640 + mi * 128) * 128;
    gemm_tile(smem, [=](int r, int kt) { return a0 + (long)r * 1152 + kt * 64; }, [=](int r, int kt) { return b0 + (long)r * 1024 + kt * 64; }, 16,
              [=](int row0, int col, float4 v0, float4 v1) {
#pragma unroll
                for (int j = 0; j < 4; ++j) {
                  o[(long)(row0 + j) * 128 + col] = f4get(v0, j);
                  o[(long)(row0 + j) * 128 + col + 32] = f4get(v1, j);
                }
              });
  }
}

DI void phase_s5b(const P& p, bf16_t* smem) {
  const bf16_t* HG = (const bf16_t*)(p.ws + W_BIG + B_HG);
  const bf16_t* E = (const bf16_t*)(p.ws + W_E);
  const bf16_t* CH = (const bf16_t*)(p.ws + W_CH);
  bf16_t* Z = (bf16_t*)(p.ws + W_BIG + B_Z);
  for (int t = blockIdx.x; t < 64 * 5 * 8; t += gridDim.x) {
    const int g = t / 40, mi = (t % 40) >> 3, j = 7 - (t & 7);
    const int nE = 2 * j + 2;
    const bf16_t* a0 = HG + (long)(g * 640 + mi * 128) * 1152;
    const bf16_t* e0 = E + (long)g * 16 * 2048;
    const bf16_t* c0 = CH + ((long)g * 1024 + j * 128) * 128;
    gemm_tile(smem,
              [=](int r, int kt) { const int k = kt < nE ? kt : 16 + kt - nE; return a0 + (long)r * 1152 + k * 64; },
              [=](int r, int kt) -> const bf16_t* {
                if (kt < nE) { const int tt = 8 * j + (r >> 4), co = r & 15; return e0 + co * 2048 + (63 - tt) * 16 + kt * 64; }
                return c0 + (long)r * 128 + (kt - nE) * 64;
              },
              nE + 2,
              [=](int row0, int col, float4 v0, float4 v1) {
#pragma unroll
                for (int q = 0; q < 4; ++q) {
                  const int n = mi * 128 + row0 + q;
                  if (n < 528) {
                    const int c0_ = col, c1_ = col + 32;
                    const long tok0 = (long)n * 64 + 8 * j + (c0_ >> 4), tok1 = (long)n * 64 + 8 * j + (c1_ >> 4);
                    Z[tok0 * 1024 + g * 16 + (c0_ & 15)] = f2bf(gelu_t(f4get(v0, q)));
                    Z[tok1 * 1024 + g * 16 + (c1_ & 15)] = f2bf(gelu_t(f4get(v1, q)));
                  }
                }
              });
  }
}

template <class EPI>
DI void run_gemm(bf16_t* smem, const bf16_t* A, int lda, const bf16_t* B, int ldb, int mtiles, int ntiles, int nkt, EPI epi) {
  for (int t = blockIdx.x; t < mtiles * ntiles; t += gridDim.x) {
    const int mt = t / ntiles, nt = t % ntiles;
    const bf16_t* a0 = A + (long)mt * 128 * lda;
    const bf16_t* b0 = B + (long)nt * 128 * ldb;
    gemm_tile(smem, [=](int r, int kt) { return a0 + (long)r * lda + kt * 64; }, [=](int r, int kt) { return b0 + (long)r * ldb + kt * 64; }, nkt,
              [=](int row0, int col, float4 v0, float4 v1) { epi(mt * 128 + row0, nt * 128 + col, v0, v1); });
  }
}

DI void resid_add(const P& p, const float* gate, int row0, int col, float4 v0, float4 v1) {
  const float* gb = gate + (long)batch_of(row0) * 24576;
  const float g0 = 1.f + gb[col], g1 = 1.f + gb[col + 32];
#pragma unroll
  for (int j = 0; j < 4; ++j) {
    float* x = p.out + (long)(row0 + j) * 1024;
    x[col] += g0 * f4get(v0, j);
    x[col + 32] += g1 * f4get(v1, j);
  }
}

DI void phase_glu(const P& p, bf16_t* smem) {
  const float* gate = mod_ptr(p, 0, 2);
  run_gemm(smem, (const bf16_t*)(p.ws + W_BIG + B_Z), 1024, (const bf16_t*)(p.ws + W_GLU), 1024, 264, 16, 16,
           [=](int row0, int col, float4 v0, float4 v1) {
             const int oc = (col >> 6) * 32 + (col & 31);
             const float g0 = 1.f + gate[(long)batch_of(row0) * 24576 + oc];
#pragma unroll
             for (int j = 0; j < 4; ++j) {
               float* x = p.out + (long)(row0 + j) * 1024 + oc;
               *x += g0 * f4get(v0, j) * sigmoid_f(f4get(v1, j));
             }
           });
}

DI void phase_mlp_up(const P& p, bf16_t* smem, int layer) {
  bf16_t* act = (bf16_t*)(p.ws + W_BIG + B_ACT);
  run_gemm(smem, (const bf16_t*)(p.ws + W_H), 1024, (const bf16_t*)(p.ws + W_WUP) + (long)layer * 4096 * 1024, 1024, 264, 32, 16,
           [=](int row0, int col, float4 v0, float4 v1) {
#pragma unroll
             for (int j = 0; j < 4; ++j) {
               const float a = fmaxf(f4get(v0, j), 0.f), b = fmaxf(f4get(v1, j), 0.f);
               act[(long)(row0 + j) * 4096 + col] = f2bf(a * a);
               act[(long)(row0 + j) * 4096 + col + 32] = f2bf(b * b);
             }
           });
}

DI void phase_mlp_down(const P& p, bf16_t* smem, int layer) {
  const float* gate = mod_ptr(p, layer, 5);
  run_gemm(smem, (const bf16_t*)(p.ws + W_BIG + B_ACT), 4096, (const bf16_t*)(p.ws + W_WDN) + (long)layer * 1024 * 4096, 4096, 264, 8, 64,
           [=](int row0, int col, float4 v0, float4 v1) { resid_add(p, gate, row0, col, v0, v1); });
}

DI void phase_proj_resid(const P& p, bf16_t* smem, const bf16_t* A, int K, const bf16_t* B, int layer) {
  const float* gate = mod_ptr(p, layer, 2);
  run_gemm(smem, A, K, B, K, 264, 8, K / 64, [=](int row0, int col, float4 v0, float4 v1) { resid_add(p, gate, row0, col, v0, v1); });
}

DI void store_t4(bf16_t* dst, float4 v) { *(uint2*)dst = make_uint2(pack2(v.x, v.y), pack2(v.z, v.w)); }

DI void phase_qkv(const P& p, bf16_t* smem) {
  unsigned char* big = p.ws + W_BIG;
  bf16_t* Qb = (bf16_t*)(big + B_QB);
  bf16_t* Kb = (bf16_t*)(big + B_KB);
  bf16_t* VT = (bf16_t*)(big + B_VTD);
  const float qscale = 0.125f * L2E;
  run_gemm(smem, (const bf16_t*)(p.ws + W_H), 1024, (const bf16_t*)(p.ws + W_QKV), 1024, 264, 24, 16,
           [=](int row0, int col, float4 v0, float4 v1) {
             const int region = col >> 10;
             if (region < 2) {
               const int d = col & 31;
               const float invf = exp2f(-(float)d * (13.287712379549449f / 32.f));
#pragma unroll
               for (int j = 0; j < 4; ++j) {
                 const int row = row0 + j;
                 float c, s;
                 rope_cs(pos_of(row), invf, c, s);
                 const float x1 = f4get(v0, j), x2 = f4get(v1, j);
                 const float o1 = x1 * c - x2 * s, o2 = x1 * s + x2 * c;
                 if (region == 0) {
                   Qb[(long)row * 1024 + col] = f2bf(o1 * qscale);
                   Qb[(long)row * 1024 + col + 32] = f2bf(o2 * qscale);
                 } else {
                   const int kc = col - 1024;
                   float* ko = (row < NTP) ? p.out + O_DKP + (long)row * 1024 : p.out + O_DKS + (long)(row - NTP) * 1024;
                   ko[kc] = o1; ko[kc + 32] = o2;
                   const long kr = krow_of(row);
                   Kb[kr * 1024 + kc] = f2bf(o1);
                   Kb[kr * 1024 + kc + 32] = f2bf(o2);
                 }
               }
             } else {
               const int vc = col - 2048;
#pragma unroll
               for (int j = 0; j < 4; ++j) {
                 const int row = row0 + j;
                 float* vo = (row < NTP) ? p.out + O_DVP + (long)row * 1024 : p.out + O_DVS + (long)(row - NTP) * 1024;
                 vo[vc] = f4get(v0, j); vo[vc + 32] = f4get(v1, j);
               }
               long base; int Lk, key;
               if (row0 < NTP) { const int b = row0 >> 13; key = row0 & 8191; Lk = 8192; base = (long)b * 1024 * 8192; }
               else { const int b = (row0 - NTP) >> 6; key = 4096 + ((row0 - NTP) & 63); Lk = SLK; base = 4l * 1024 * 8192 + (long)b * 1024 * SLK; }
               store_t4(VT + base + (long)vc * Lk + key, v0);
               store_t4(VT + base + (long)(vc + 32) * Lk + key, v1);
             }
           });
  {
    const float* ck = p.in[6]; const float* cv = p.in[7];
    const long gt = (long)blockIdx.x * 256 + threadIdx.x, gs = (long)gridDim.x * 256;
    for (long idx = gt; idx < 16l * 4096 * 128; idx += gs) {
      const long rowc = idx >> 7; const int c8 = (int)(idx & 127) * 8;
      const int b = (int)(rowc >> 12), jk = (int)(rowc & 4095);
      const float4 a = *(const float4*)(ck + rowc * 1024 + c8), bq = *(const float4*)(ck + rowc * 1024 + c8 + 4);
      uint4 o = {pack2(a.x, a.y), pack2(a.z, a.w), pack2(bq.x, bq.y), pack2(bq.z, bq.w)};
      *(uint4*)(Kb + ((long)NTP + (long)b * SLK + jk) * 1024 + c8) = o;
    }
    for (long idx = gt; idx < 16l * 512 * 1024; idx += gs) {
      const int hd = (int)(idx & 1023); const long t = idx >> 10;
      const int kg = (int)(t & 511), b = (int)(t >> 9);
      const float* src = cv + ((long)b * 4096 + kg * 8) * 1024 + hd;
      const float v0 = src[0], v1 = src[1024], v2 = src[2048], v3 = src[3072], v4 = src[4096], v5 = src[5120], v6 = src[6144], v7 = src[7168];
      uint4 o = {pack2(v0, v1), pack2(v2, v3), pack2(v4, v5), pack2(v6, v7)};
      *(uint4*)(VT + 4l * 1024 * 8192 + (long)b * 1024 * SLK + (long)hd * SLK + kg * 8) = o;
    }
  }
}

DI void phase_mla_down(const P& p, bf16_t* smem) {
  unsigned char* big = p.ws + W_BIG;
  float* raw = (float*)(big + B_RAW);
  bf16_t* KR = (bf16_t*)(big + B_KR);
  run_gemm(smem, (const bf16_t*)(p.ws + W_H), 1024, (const bf16_t*)(p.ws + W_MD), 1024, 264, 4, 16,
           [=](int row0, int col, float4 v0, float4 v1) {
             if (col < 384) {
#pragma unroll
               for (int j = 0; j < 4; ++j) {
                 raw[(long)(row0 + j) * 384 + col] = f4get(v0, j);
                 raw[(long)(row0 + j) * 384 + col + 32] = f4get(v1, j);
               }
             } else if (col < 400) {
               const int i = col - 384;
               const float invf = exp2f(-(float)i * (13.287712379549449f / 16.f));
#pragma unroll
               for (int j = 0; j < 4; ++j) {
                 const int row = row0 + j;
                 float c, s;
                 rope_cs(pos_of(row), invf, c, s);
                 const float x1 = f4get(v0, j), x2 = f4get(v1, j);
                 const float o1 = x1 * c - x2 * s, o2 = x1 * s + x2 * c;
                 float* ko = (row < NTP) ? p.out + O_KRP + (long)row * 32 : p.out + O_KRS + (long)(row - NTP) * 32;
                 ko[i] = o1; ko[16 + i] = o2;
                 const long kr = krow_of(row);
                 KR[kr * 32 + i] = f2bf(o1); KR[kr * 32 + 16 + i] = f2bf(o2);
               }
             }
           });
  {
    bf16_t* CKV = (bf16_t*)(big + B_CKV);
    const float* cc = p.in[8]; const float* cr = p.in[9];
    const long gt = (long)blockIdx.x * 256 + threadIdx.x, gs = (long)gridDim.x * 256;
    for (long idx = gt; idx < 16l * 4096 * 16; idx += gs) {
      const long rowc = idx >> 4; const int c8 = (int)(idx & 15) * 8;
      const int b = (int)(rowc >> 12), jk = (int)(rowc & 4095);
      const float4 a = *(const float4*)(cc + rowc * 128 + c8), bq = *(const float4*)(cc + rowc * 128 + c8 + 4);
      uint4 o = {pack2(a.x, a.y), pack2(a.z, a.w), pack2(bq.x, bq.y), pack2(bq.z, bq.w)};
      *(uint4*)(CKV + ((long)NTP + (long)b * SLK + jk) * 128 + c8) = o;
    }
    for (long idx = gt; idx < 16l * 4096 * 4; idx += gs) {
      const long rowc = idx >> 2; const int c8 = (int)(idx & 3) * 8;
      const int b = (int)(rowc >> 12), jk = (int)(rowc & 4095);
      const float4 a = *(const float4*)(cr + rowc * 32 + c8), bq = *(const float4*)(cr + rowc * 32 + c8 + 4);
      uint4 o = {pack2(a.x, a.y), pack2(a.z, a.w), pack2(bq.x, bq.y), pack2(bq.z, bq.w)};
      *(uint4*)(KR + ((long)NTP + (long)b * SLK + jk) * 32 + c8) = o;
    }
  }
}

DI void phase_mla_norm(const P& p) {
  unsigned char* big = p.ws + W_BIG;
  const float* raw = (const float*)(big + B_RAW);
  bf16_t* CQ = (bf16_t*)(big + B_CQ);
  bf16_t* CKV = (bf16_t*)(big + B_CKV);
  const int lane = threadIdx.x & 63;
  const int wv = blockIdx.x * 4 + (threadIdx.x >> 6), nwv = gridDim.x * 4;
  const float4 gq = *(const float4*)(p.in[35] + lane * 4);
  const float2 gk = *(const float2*)(p.in[38] + lane * 2);
  for (int row = wv; row < NT; row += nwv) {
    const float4 q = *(const float4*)(raw + (long)row * 384 + lane * 4);
    const float2 k = *(const float2*)(raw + (long)row * 384 + 256 + lane * 2);
    const float sq = wave_sum(q.x * q.x + q.y * q.y + q.z * q.z + q.w * q.w);
    const float sk = wave_sum(k.x * k.x + k.y * k.y);
    const float rq = rsqrtf(sq * (1.f / 256.f) + NORM_EPS), rk = rsqrtf(sk * (1.f / 128.f) + NORM_EPS);
    *(uint2*)(CQ + (long)row * 256 + lane * 4) = make_uint2(pack2(q.x * rq * gq.x, q.y * rq * gq.y), pack2(q.z * rq * gq.z, q.w * rq * gq.w));
    const float c0 = k.x * rk * gk.x, c1 = k.y * rk * gk.y;
    float* co = (row < NTP) ? p.out + O_CKP + (long)row * 128 : p.out + O_CKS + (long)(row - NTP) * 128;
    *(float2*)(co + lane * 2) = make_float2(c0, c1);
    *(unsigned*)(CKV + (long)krow_of(row) * 128 + lane * 2) = pack2(c0, c1);
  }
}

DI void phase_mla_up(const P& p, bf16_t* smem) {
  unsigned char* big = p.ws + W_BIG;
  bf16_t* QM = (bf16_t*)(big + B_QM);
  bf16_t* KN = (bf16_t*)(big + B_KN);
  bf16_t* VT = (bf16_t*)(big + B_VTM);
  const float qscale = 0.10206207261596577f * L2E;
  run_gemm(smem, (const bf16_t*)(big + B_CQ), 256, (const bf16_t*)(p.ws + W_MUQ), 256, 264, 12, 4,
           [=](int row0, int col, float4 v0, float4 v1) {
             if (col < 1024) {
               const int o = (col >> 6) * 96 + (col & 63);
#pragma unroll
               for (int j = 0; j < 4; ++j) {
                 QM[(long)(row0 + j) * 1536 + o] = f2bf(f4get(v0, j) * qscale);
                 QM[(long)(row0 + j) * 1536 + o + 32] = f2bf(f4get(v1, j) * qscale);
               }
             } else {
               const int sp = (col - 1024) >> 6, ix = col & 31;
               const int head = sp * 2 + (ix >> 4), i = ix & 15;
               const float invf = exp2f(-(float)i * (13.287712379549449f / 16.f));
#pragma unroll
               for (int j = 0; j < 4; ++j) {
                 const int row = row0 + j;
                 float c, s;
                 rope_cs(pos_of(row), invf, c, s);
                 const float x1 = f4get(v0, j), x2 = f4get(v1, j);
                 QM[(long)row * 1536 + head * 96 + 64 + i] = f2bf((x1 * c - x2 * s) * qscale);
                 QM[(long)row * 1536 + head * 96 + 80 + i] = f2bf((x1 * s + x2 * c) * qscale);
               }
             }
           });
  run_gemm(smem, (const bf16_t*)(big + B_CKV), 128, (const bf16_t*)(p.ws + W_MUKV), 128, 776, 16, 2,
           [=](int row0, int col, float4 v0, float4 v1) {
             if (col < 1024) {
#pragma unroll
               for (int j = 0; j < 4; ++j) {
                 KN[(long)(row0 + j) * 1024 + col] = f2bf(f4get(v0, j));
                 KN[(long)(row0 + j) * 1024 + col + 32] = f2bf(f4get(v1, j));
               }
             } else {
               const int vc = col - 1024;
               long base; int Lk, key;
               if (row0 < NTP) { const int b = row0 >> 13; key = row0 & 8191; Lk = 8192; base = (long)b * 1024 * 8192; }
               else { const int b = (row0 - NTP) / SLK; key = (row0 - NTP) - b * SLK; Lk = SLK; base = 4l * 1024 * 8192 + (long)b * 1024 * SLK; }
               store_t4(VT + base + (long)vc * Lk + key, v0);
               store_t4(VT + base + (long)(vc + 32) * Lk + key, v1);
             }
           });
}

DI void phase_sgu_in(const P& p, bf16_t* smem) {
  unsigned char* big = p.ws + W_BIG;
  bf16_t* U = (bf16_t*)(big + B_U);
  bf16_t* VR = (bf16_t*)(big + B_VRAW);
  run_gemm(smem, (const bf16_t*)(p.ws + W_H), 1024, (const bf16_t*)(p.ws + W_SIN), 1024, 264, 32, 16,
           [=](int row0, int col, float4 v0, float4 v1) {
             bf16_t* dst = (col < 2048) ? U + col : VR + (col - 2048);
#pragma unroll
             for (int j = 0; j < 4; ++j) {
               dst[(long)(row0 + j) * 2048] = f2bf(gelu_t(f4get(v0, j)));
               dst[(long)(row0 + j) * 2048 + 32] = f2bf(gelu_t(f4get(v1, j)));
             }
           });
}

DI void phase_sgu_norm(const P& p, float* smf) {
  unsigned char* big = p.ws + W_BIG;
  const bf16_t* VR = (const bf16_t*)(big + B_VRAW);
  bf16_t* VTS = (bf16_t*)(big + B_VTS);
  const float* gv = p.in[43];
  const int lane = threadIdx.x & 63, wave = threadIdx.x >> 6;
  for (int c64 = blockIdx.x; c64 < 528; c64 += gridDim.x) {
    __syncthreads();
    for (int s = wave; s < 64; s += 4) {
      const bf16_t* rowp = VR + (long)(c64 * 64 + s) * 2048;
      float ss = 0.f;
#pragma unroll
      for (int i = 0; i < 4; ++i) {
        const uint4 q = *(const uint4*)(rowp + lane * 8 + 512 * i);
        const unsigned w[4] = {q.x, q.y, q.z, q.w};
#pragma unroll
        for (int e = 0; e < 4; ++e) {
          const float a = __uint_as_float(w[e] << 16), b = __uint_as_float(w[e] & 0xffff0000u);
          ss += a * a + b * b;
        }
      }
      ss = wave_sum(ss);
      if (lane == 0) smf[s] = rsqrtf(ss * (1.f / 2048.f) + NORM_EPS);
    }
    __syncthreads();
    for (int task = threadIdx.x; task < 512 * 8; task += 256) {
      const int d4 = (task & 511) * 4, sg = task >> 9;
      const float4 g4 = *(const float4*)(gv + d4);
      float v[8][4];
#pragma unroll
      for (int j = 0; j < 8; ++j) {
        const int s = sg * 8 + j;
        const uint2 q = *(const uint2*)(VR + (long)(c64 * 64 + s) * 2048 + d4);
        const float rs = smf[s];
        v[j][0] = __uint_as_float(q.x << 16) * rs * g4.x;
        v[j][1] = __uint_as_float(q.x & 0xffff0000u) * rs * g4.y;
        v[j][2] = __uint_as_float(q.y << 16) * rs * g4.z;
        v[j][3] = __uint_as_float(q.y & 0xffff0000u) * rs * g4.w;
        if (c64 >= 512) *(float4*)(p.out + O_SGV + (long)((c64 - 512) * 64 + s) * 2048 + d4) = make_float4(v[j][0], v[j][1], v[j][2], v[j][3]);
      }
#pragma unroll
      for (int e = 0; e < 4; ++e) {
        uint4 o = {pack2(v[0][e], v[1][e]), pack2(v[2][e], v[3][e]), pack2(v[4][e], v[5][e]), pack2(v[6][e], v[7][e])};
        *(uint4*)(VTS + ((long)c64 * 2048 + d4 + e) * 64 + sg * 8) = o;
      }
    }
  }
}

DI void phase_sgu_spatial(const P& p, bf16_t* smem) {
  unsigned char* big = p.ws + W_BIG;
  const bf16_t* U = (const bf16_t*)(big + B_U);
  const bf16_t* VTS = (const bf16_t*)(big + B_VTS);
  bf16_t* G = (bf16_t*)(big + B_G);
  const float* bs = p.in[45];
  for (int t = blockIdx.x; t < 264 * 16; t += gridDim.x) {
    const int mt = t >> 4, g = (t >> 1) & 7, dt = t & 1;
    const bf16_t* a0 = (const bf16_t*)(p.ws + (mt < 256 ? W_WS1 : W_WS2)) + g * 128 * 128;
    const bf16_t* b0 = VTS + ((long)mt * 2 * 2048 + g * 256 + dt * 128) * 64;
    const bool prompt = mt < 256;
    gemm_tile(smem, [=](int r, int kt) { return a0 + r * 128 + kt * 64; }, [=](int r, int kt) { return b0 + (long)kt * 2048 * 64 + r * 64; }, 2,
              [=](int row0, int col, float4 v0, float4 v1) {
                const int gc = g * 256 + dt * 128 + col;
#pragma unroll
                for (int j = 0; j < 4; ++j) {
                  const int tr = row0 + j;
                  const float bias = bs[g * 128 + (prompt ? tr : (tr & 63))];
                  const long o = (long)(mt * 128 + tr) * 2048 + gc;
                  G[o] = f2bf(bf2f(U[o]) * (f4get(v0, j) + bias));
                  G[o + 32] = f2bf(bf2f(U[o + 32]) * (f4get(v1, j) + bias));
                }
              });
  }
}

DI void phase_final_norm(const P& p) {
  const int lane = threadIdx.x & 63;
  const int wv = blockIdx.x * 4 + (threadIdx.x >> 6), nwv = gridDim.x * 4;
  const float* gam = p.in[16];
  for (int row = wv; row < NT; row += nwv) {
    float* x = p.out + (long)row * 1024;
    float4 v[4];
    float ss = 0.f;
#pragma unroll
    for (int i = 0; i < 4; ++i) {
      v[i] = *(const float4*)(x + lane * 4 + 256 * i);
      ss += v[i].x * v[i].x + v[i].y * v[i].y + v[i].z * v[i].z + v[i].w * v[i].w;
    }
    ss = wave_sum(ss);
    const float rinv = rsqrtf(ss * (1.f / 1024.f) + NORM_EPS);
#pragma unroll
    for (int i = 0; i < 4; ++i) {
      const int col = lane * 4 + 256 * i;
      const float4 g4 = *(const float4*)(gam + col);
      *(float4*)(x + col) = make_float4(v[i].x * rinv * g4.x, v[i].y * rinv * g4.y, v[i].z * rinv * g4.z, v[i].w * rinv * g4.w);
    }
  }
}

DI bf16x8 pack8(const f32x16& x, int s) {
  unsigned a = pack2(x[8 * s], x[8 * s + 1]), b = pack2(x[8 * s + 2], x[8 * s + 3]), c = pack2(x[8 * s + 4], x[8 * s + 5]), d = pack2(x[8 * s + 6], x[8 * s + 7]);
  uint4 u = {a, b, c, d};
  return __builtin_bit_cast(bf16x8, u);
}

template <bool MLA>
DI void phase_attn(const P& p, bf16_t* smem) {
  constexpr int NKS = MLA ? 6 : 4;
  constexpr int NDT = MLA ? 2 : 4;
  constexpr int NLD = MLA ? 9 : 8;
  unsigned char* big = p.ws + W_BIG;
  const bf16_t* Q = (const bf16_t*)(big + (MLA ? B_QM : B_QB));
  const bf16_t* KK = (const bf16_t*)(big + (MLA ? B_KN : B_KB));
  const bf16_t* KR = (const bf16_t*)(big + B_KR);
  const bf16_t* VT = (const bf16_t*)(big + (MLA ? B_VTM : B_VTD));
  bf16_t* OB = (bf16_t*)(big + (MLA ? B_OBM : B_OB));
  const float lam = *(const float*)(p.ws + W_LAM);
  const float* gsub = p.in[32];
  const int tid = threadIdx.x, lane = tid & 63, wave = tid >> 6;
  const int wp = wave >> 1, wq = wave & 1, r = lane & 31, hh = lane >> 5;
  constexpr int L_K0 = 0, L_K1 = 4608, L_KR = 9216, L_V0 = MLA ? 11776 : 9216, L_V1 = 16384;
  for (int it = blockIdx.x; it < 4224; it += gridDim.x) {
    int b, hx, qrow0, ntiles, Lk; long R0, vbase;
    if (it < 128) {
      b = it >> 3; hx = it & 7; qrow0 = NTP + b * 64; ntiles = 65; Lk = SLK;
      R0 = (long)NTP + (long)b * SLK; vbase = 4l * 1024 * 8192 + (long)b * 1024 * SLK;
    } else {
      const int i = it - 128; const int qc = 127 - (i >> 5); b = (i & 31) >> 3; hx = i & 7;
      qrow0 = b * 8192 + qc * 64; ntiles = qc + 1; Lk = 8192; R0 = (long)b * 8192; vbase = (long)b * 1024 * 8192;
    }
    bf16x8 qf[NKS];
    {
      const long qr = (long)(qrow0 + wq * 32 + r);
      const bf16_t* qp = MLA ? Q + qr * 1536 + (hx * 2 + wp) * 96 + 8 * hh : Q + qr * 1024 + (hx * 2 + wp) * 64 + 8 * hh;
#pragma unroll
      for (int ks = 0; ks < NKS; ++ks) qf[ks] = *(const bf16x8*)(qp + ks * 16);
    }
    f32x16 O[NDT];
#pragma unroll
    for (int d = 0; d < NDT; ++d)
#pragma unroll
      for (int i = 0; i < 16; ++i) O[d][i] = 0.f;
    float m_run = -1e30f, l_run = 0.f;
    u32x4 ld[NLD];
#define ATT_GLOAD(KT)                                                                                                   \
  {                                                                                                                     \
    const long kr0 = R0 + (long)(KT) * 64;                                                                              \
    _Pragma("unroll") for (int j = 0; j < 4; ++j) {                                                                     \
      const int c = j >> 1, id = tid + 256 * (j & 1), key = id >> 3, ch = id & 7;                                       \
      ld[j] = *(const u32x4*)(KK + (kr0 + key) * 1024 + (hx * 2 + c) * 64 + ch * 8);                                    \
    }                                                                                                                   \
    if (!MLA) {                                                                                                         \
      _Pragma("unroll") for (int i = 0; i < 4; ++i) {                                                                   \
        const int id = tid + 256 * i, dv = id >> 3, ch = id & 7;                                                        \
        ld[4 + i] = *(const u32x4*)(VT + vbase + (long)(hx * 128 + dv) * Lk + (KT) * 64 + ch * 8);                      \
      }                                                                                                                 \
    } else {                                                                                                            \
      _Pragma("unroll") for (int j = 0; j < 4; ++j) {                                                                   \
        const int c = j >> 1, id = tid + 256 * (j & 1), dv = id >> 3, ch = id & 7;                                      \
        ld[4 + j] = *(const u32x4*)(VT + vbase + (long)((hx * 2 + c) * 64 + dv) * Lk + (KT) * 64 + ch * 8);             \
      }                                                                                                                 \
      ld[NLD - 1] = *(const u32x4*)(KR + (kr0 + (tid >> 2)) * 32 + (tid & 3) * 8);                                      \
    }                                                                                                                   \
  }
#define ATT_SWRITE()                                                                                                    \
  {                                                                                                                     \
    _Pragma("unroll") for (int j = 0; j < 4; ++j) {                                                                     \
      const int c = j >> 1, id = tid + 256 * (j & 1), key = id >> 3, ch = id & 7;                                       \
      *(u32x4*)(smem + (c ? L_K1 : L_K0) + key * LST + ch * 8) = ld[j];                                                 \
    }                                                                                                                   \
    if (!MLA) {                                                                                                         \
      _Pragma("unroll") for (int i = 0; i < 4; ++i) {                                                                   \
        const int id = tid + 256 * i, dv = id >> 3, ch = id & 7;                                                        \
        *(u32x4*)(smem + L_V0 + dv * LST + ch * 8) = ld[4 + i];                                                         \
      }                                                                                                                 \
    } else {                                                                                                            \
      _Pragma("unroll") for (int j = 0; j < 4; ++j) {                                                                   \
        const int c = j >> 1, id = tid + 256 * (j & 1), dv = id >> 3, ch = id & 7;                                      \
        *(u32x4*)(smem + (c ? L_V1 : L_V0) + dv * LST + ch * 8) = ld[4 + j];                                            \
      }                                                                                                                 \
      *(u32x4*)(smem + L_KR + (tid >> 2) * 40 + (tid & 3) * 8) = ld[NLD - 1];                                           \
    }                                                                                                                   \
  }
    ATT_GLOAD(0)
    const bf16_t* sK = smem + (wp ? L_K1 : L_K0);
    const bf16_t* sV = smem + ((MLA && wp) ? L_V1 : L_V0);
    for (int kt = 0; kt < ntiles; ++kt) {
      __syncthreads();
      ATT_SWRITE()
      __syncthreads();
      if (kt + 1 < ntiles) ATT_GLOAD(kt + 1)
      f32x16 st[2];
#pragma unroll
      for (int mt = 0; mt < 2; ++mt) {
#pragma unroll
        for (int i = 0; i < 16; ++i) st[mt][i] = 0.f;
#pragma unroll
        for (int ks = 0; ks < NKS; ++ks) {
          bf16x8 a;
          if (ks < 4) a = *(const bf16x8*)(sK + (mt * 32 + r) * LST + ks * 16 + 8 * hh);
          else a = *(const bf16x8*)(smem + L_KR + (mt * 32 + r) * 40 + (ks - 4) * 16 + 8 * hh);
          st[mt] = MFMA(a, qf[ks], st[mt]);
        }
      }
      float mloc = st[0][0];
#pragma unroll
      for (int i = 1; i < 16; ++i) mloc = fmaxf(mloc, st[0][i]);
#pragma unroll
      for (int i = 0; i < 16; ++i) mloc = fmaxf(mloc, st[1][i]);
      mloc = fmaxf(mloc, __shfl_xor(mloc, 32));
      const float mnew = fmaxf(m_run, mloc);
      const float alpha = exp2f(m_run - mnew);
      m_run = mnew;
      float ps = 0.f;
#pragma unroll
      for (int mt = 0; mt < 2; ++mt)
#pragma unroll
        for (int i = 0; i < 16; ++i) { const float e = exp2f(st[mt][i] - mnew); st[mt][i] = e; ps += e; }
      l_run = l_run * alpha + ps;
#pragma unroll
      for (int d = 0; d < NDT; ++d)
#pragma unroll
        for (int i = 0; i < 16; ++i) O[d][i] *= alpha;
#pragma unroll
      for (int k2 = 0; k2 < 4; ++k2) {
        const bf16x8 pf = pack8(st[k2 >> 1], k2 & 1);
#pragma unroll
        for (int d = 0; d < NDT; ++d) {
          const bf16_t* vp = sV + (d * 32 + r) * LST + 16 * k2 + 4 * hh;
          const s16x4 lo = *(const s16x4*)vp;
          const s16x4 hi = *(const s16x4*)(vp + 8);
          const bf16x8 va = __builtin_shufflevector(lo, hi, 0, 1, 2, 3, 4, 5, 6, 7);
          O[d] = MFMA(va, pf, O[d]);
        }
      }
    }
    const float ltot = l_run + __shfl_xor(l_run, 32);
    const float linv = 1.f / ltot;
    const long orow = (long)(qrow0 + wq * 32 + r);
    if (MLA) {
#pragma unroll
      for (int d = 0; d < NDT; ++d)
#pragma unroll
        for (int g = 0; g < 4; ++g) {
          uint2 o = {pack2(O[d][4 * g] * linv, O[d][4 * g + 1] * linv), pack2(O[d][4 * g + 2] * linv, O[d][4 * g + 3] * linv)};
          *(uint2*)(OB + orow * 1024 + (hx * 2 + wp) * 64 + d * 32 + 8 * g + 4 * hh) = o;
        }
    } else {
      float* xs = (float*)smem;
      __syncthreads();
      if (wp == 1) {
#pragma unroll
        for (int d = 0; d < NDT; ++d)
#pragma unroll
          for (int i = 0; i < 16; ++i) xs[(wq * 64 + d * 16 + i) * 64 + lane] = O[d][i] * linv;
      }
      __syncthreads();
      if (wp == 0) {
        float ss = 0.f;
#pragma unroll
        for (int d = 0; d < NDT; ++d)
#pragma unroll
          for (int i = 0; i < 16; ++i) {
            const float o = O[d][i] * linv - lam * xs[(wq * 64 + d * 16 + i) * 64 + lane];
            O[d][i] = o; ss += o * o;
          }
        ss += __shfl_xor(ss, 32);
        const float rinv = rsqrtf(ss * (1.f / 128.f) + NORM_EPS) * (1.f - LAMBDA_INIT);
#pragma unroll
        for (int d = 0; d < NDT; ++d)
#pragma unroll
          for (int g = 0; g < 4; ++g) {
            const int dv = d * 32 + 8 * g + 4 * hh;
            const float4 gs4 = *(const float4*)(gsub + dv);
            uint2 o = {pack2(O[d][4 * g] * rinv * gs4.x, O[d][4 * g + 1] * rinv * gs4.y), pack2(O[d][4 * g + 2] * rinv * gs4.z, O[d][4 * g + 3] * rinv * gs4.w)};
            *(uint2*)(OB + orow * 1024 + hx * 128 + dv) = o;
          }
      }
    }
  }
}

constexpr int NPH = 35;
__global__ void __launch_bounds__(256, 2) mk_forward(P p) {
  __shared__ __attribute__((aligned(16))) unsigned char smem_raw[73728];
  cg::grid_group grid = cg::this_grid();
  bf16_t* smem = (bf16_t*)smem_raw;
  float* smf = (float*)smem_raw;
  unsigned char* big = p.ws + W_BIG;
  int ph = 0;
#ifndef ONLY_PH
#define ONLY_PH -1
#endif
#define PH(...) { if ((ONLY_PH < 0 || ph == ONLY_PH) && ph >= p.lo && ph < p.hi) { __VA_ARGS__; } ++ph; if (ph > p.lo && ph < p.hi) grid.sync(); }
  PH(phase0(p, smf))
  PH(phase1(p))
  PH(phase_modulate<1>(p, 0, 0))
  PH(phase_s5a(p, smem))
  PH(phase_s5_carry(p))
  PH(phase_s5b(p, smem))
  PH(phase_glu(p, smem))
  PH(phase_modulate<0>(p, 0, 1))
  PH(phase_mlp_up(p, smem, 0))
  PH(phase_mlp_down(p, smem, 0))
  PH(phase_modulate<0>(p, 1, 0))
  PH(phase_qkv(p, smem))
  PH(phase_attn<false>(p, smem))
  PH(phase_proj_resid(p, smem, (const bf16_t*)(big + B_OB), 1024, (const bf16_t*)(p.ws + W_DWO), 1))
  PH(phase_modulate<0>(p, 1, 1))
  PH(phase_mlp_up(p, smem, 1))
  PH(phase_mlp_down(p, smem, 1))
  PH(phase_modulate<0>(p, 2, 0))
  PH(phase_mla_down(p, smem))
  PH(phase_mla_norm(p))
  PH(phase_mla_up(p, smem))
  PH(phase_attn<true>(p, smem))
  PH(phase_proj_resid(p, smem, (const bf16_t*)(big + B_OBM), 1024, (const bf16_t*)(p.ws + W_MWO), 2))
  PH(phase_modulate<0>(p, 2, 1))
  PH(phase_mlp_up(p, smem, 2))
  PH(phase_mlp_down(p, smem, 2))
  PH(phase_modulate<0>(p, 3, 0))
  PH(phase_sgu_in(p, smem))
  PH(phase_sgu_norm(p, smf))
  PH(phase_sgu_spatial(p, smem))
  PH(phase_proj_resid(p, smem, (const bf16_t*)(big + B_G), 2048, (const bf16_t*)(p.ws + W_SOUT), 3))
  PH(phase_modulate<0>(p, 3, 1))
  PH(phase_mlp_up(p, smem, 3))
  PH(phase_mlp_down(p, smem, 3))
  PH(phase_final_norm(p))
#undef PH
}

extern "C" void kernel_launch(void* const* d_in, const int* in_sizes, int n_in, void* d_out, int out_size, void* d_ws, size_t ws_size,
                              hipStream_t stream) {
  static int grid_blocks = 0;
  if (!grid_blocks) {
    int dev = 0, cus = 0, per_cu = 0;
    hipGetDevice(&dev);
    hipDeviceGetAttribute(&cus, hipDeviceAttributeMultiprocessorCount, dev);
    hipOccupancyMaxActiveBlocksPerMultiprocessor(&per_cu, mk_forward, 256, 0);
    if (per_cu < 1) per_cu = 1;
    if (per_cu > 2) per_cu = 2;
    grid_blocks = cus * per_cu;
    if (ws_size < WS_NEED) fprintf(stderr, "kernel_launch: workspace too small: %zu < %zu\n", ws_size, (size_t)WS_NEED);
  }
  P p{};
  for (int i = 0; i < 47; ++i) p.in[i] = (const float*)d_in[i];
  p.out = (float*)d_out;
  p.ws = (unsigned char*)d_ws;
#if MK_SINGLE
  p.lo = 0; p.hi = NPH;
  void* args[] = {&p};
  hipError_t e = hipLaunchCooperativeKernel((void*)mk_forward, dim3(grid_blocks), dim3(256), args, 0, stream);
  if (e != hipSuccess) fprintf(stderr, "cooperative launch failed: %s (grid %d)\n", hipGetErrorString(e), grid_blocks);
#else
  for (int ph = 0; ph < NPH; ++ph) {
    p.lo = ph; p.hi = ph + 1;
    hipLaunchKernelGGL(mk_forward, dim3(grid_blocks), dim3(256), 0, stream, p);
  }
#endif
}
```

```cpp
#include <hip/hip_runtime.h>
#include <hip/hip_cooperative_groups.h>
#include <stdint.h>
#include <stdio.h>
namespace cg = cooperative_groups;

#ifndef MK_SINGLE
#define MK_SINGLE 1
#endif

typedef unsigned short bf16_t;
typedef __attribute__((ext_vector_type(8))) short bf16x8;
typedef __attribute__((ext_vector_type(4))) short s16x4;
typedef __attribute__((ext_vector_type(4))) unsigned u32x4;
typedef __attribute__((ext_vector_type(16))) float f32x16;
typedef __bf16 bf2_t __attribute__((ext_vector_type(2)));
typedef float fl2_t __attribute__((ext_vector_type(2)));
#define DI __device__ __forceinline__
#define MFMA(a, b, c) __builtin_amdgcn_mfma_f32_32x32x16_bf16((a), (b), (c), 0, 0, 0)

constexpr int NTP = 32768, NTS = 1024, NT = 33792;
constexpr int SLK = 4160;
constexpr int KROWS = 99328;
constexpr float NORM_EPS = 1e-6f;
constexpr float LAMBDA_INIT = 0.35550906759096933f;
constexpr float L2E = 1.4426950408889634f;

constexpr size_t O_S5RP = (size_t)NT * 1024, O_S5IP = O_S5RP + 16384, O_S5RS = O_S5IP + 16384, O_S5IS = O_S5RS + 65536,
                 O_DKP = O_S5IS + 65536, O_DVP = O_DKP + (size_t)NTP * 1024, O_DKS = O_DVP + (size_t)NTP * 1024,
                 O_DVS = O_DKS + (size_t)NTS * 1024, O_CKP = O_DVS + (size_t)NTS * 1024, O_KRP = O_CKP + (size_t)NTP * 128,
                 O_CKS = O_KRP + (size_t)NTP * 32, O_KRS = O_CKS + (size_t)NTS * 128, O_SGV = O_KRS + (size_t)NTS * 32;

constexpr size_t W_CTRL = 0;
constexpr size_t W_LAM = 16384;
constexpr size_t W_MODP = W_LAM + 256;
constexpr size_t W_MOD = W_MODP + 8ull * 20 * 24576 * 4;
constexpr size_t W_AP = W_MOD + 20ull * 24576 * 4;
constexpr size_t W_BBAR = W_AP + 64ull * 65 * 64 * 8;
constexpr size_t W_E = W_BBAR + 64ull * 64 * 16 * 8;
constexpr size_t W_CH = W_E + 64ull * 16 * 2048 * 2;
constexpr size_t W_MEND = W_CH + 64ull * 1024 * 128 * 2;
constexpr size_t W_WS1 = W_MEND + 64ull * 128 * 1024 * 2;
constexpr size_t W_WS2 = W_WS1 + 8ull * 128 * 128 * 2;
constexpr size_t W_WUP = W_WS2 + 8ull * 128 * 128 * 2;
constexpr size_t W_WDN = W_WUP + 4ull * 4096 * 1024 * 2;
constexpr size_t W_GLU = W_WDN + 4ull * 4096 * 1024 * 2;
constexpr size_t W_QKV = W_GLU + 2048ull * 1024 * 2;
constexpr size_t W_DWO = W_QKV + 3072ull * 1024 * 2;
constexpr size_t W_MD = W_DWO + 1024ull * 1024 * 2;
constexpr size_t W_MUQ = W_MD + 512ull * 1024 * 2;
constexpr size_t W_MUKV = W_MUQ + 1536ull * 256 * 2;
constexpr size_t W_MWO = W_MUKV + 2048ull * 128 * 2;
constexpr size_t W_SIN = W_MWO + 1024ull * 1024 * 2;
constexpr size_t W_SOUT = W_SIN + 4096ull * 1024 * 2;
constexpr size_t W_H = W_SOUT + 1024ull * 2048 * 2;
constexpr size_t W_BIG = W_H + (size_t)NT * 1024 * 2;
constexpr size_t B_HG = 0, B_SLOC = 94371840ull, B_Z = 115343360ull;
constexpr size_t B_ACT = 0;
constexpr size_t B_QB = 0, B_KB = 69206016ull, B_VTD = 272629760ull, B_OB = 476053504ull;
constexpr size_t B_RAW = 0, B_CQ = 51904512ull, B_OBM = 0, B_CKV = 69206016ull, B_KR = 94633984ull, B_QM = 100990976ull,
                 B_KN = 204800000ull, B_VTM = 408223744ull;
constexpr size_t B_U = 0, B_VRAW = 138412032ull, B_VTS = 276824064ull, B_G = 415236096ull;
constexpr size_t WS_NEED = W_BIG + 611647488ull;

struct P {
  const float* in[47];
  float* out;
  unsigned char* ws;
  int lo, hi;
};

DI unsigned pack2(float a, float b) {
  fl2_t f = {a, b};
  bf2_t r = __builtin_convertvector(f, bf2_t);
  return __builtin_bit_cast(unsigned, r);
}
DI bf16_t f2bf(float a) { return (bf16_t)(pack2(a, 0.f) & 0xffffu); }
DI float bf2f(bf16_t v) { return __uint_as_float(((unsigned)v) << 16); }
DI float gelu_t(float x) {
  float u = 0.7978845608028654f * (x + 0.044715f * x * x * x);
  float t = 1.f - 2.f / (__expf(2.f * u) + 1.f);
  return 0.5f * x * (1.f + t);
}
DI float sigmoid_f(float x) { return 1.f / (1.f + __expf(-x)); }
DI int batch_of(int row) { return row < NTP ? (row >> 13) : 4 + ((row - NTP) >> 6); }
DI int pos_of(int row) { return row < NTP ? (row & 8191) : 4096 + ((row - NTP) & 63); }
DI int krow_of(int row) { return row < NTP ? row : NTP + ((row - NTP) >> 6) * SLK + 4096 + ((row - NTP) & 63); }
DI void rope_cs(int pos, float invf, float& c, float& s) {
  double t = (double)pos * (double)invf * 0.15915494309189535;
  t -= __builtin_rint(t);
  float ft = (float)t;
  c = __builtin_amdgcn_cosf(ft);
  s = __builtin_amdgcn_sinf(ft);
}
DI float wave_sum(float v) {
#pragma unroll
  for (int o = 32; o > 0; o >>= 1) v += __shfl_xor(v, o);
  return v;
}

constexpr int LST = 72;
template <class AF, class BF, class EPI>
DI void gemm_tile(bf16_t* smem, AF af, BF bf, int nkt, EPI epi) {
  const int tid = threadIdx.x, lane = tid & 63, wave = tid >> 6;
  const int wm = wave >> 1, wn = wave & 1, r = lane & 31, h = lane >> 5;
  bf16_t* sA = smem;
  bf16_t* sB = smem + 2 * 128 * LST;
  f32x16 acc[2][2];
#pragma unroll
  for (int a = 0; a < 2; ++a)
#pragma unroll
    for (int b = 0; b < 2; ++b)
#pragma unroll
      for (int i = 0; i < 16; ++i) acc[a][b][i] = 0.f;
  const int lr = tid >> 3, lc = (tid & 7) * 8;
  uint4 ra[4], rb[4];
#pragma unroll
  for (int i = 0; i < 4; ++i) {
    ra[i] = *(const uint4*)(af(lr + 32 * i, 0) + lc);
    rb[i] = *(const uint4*)(bf(lr + 32 * i, 0) + lc);
  }
#pragma unroll
  for (int i = 0; i < 4; ++i) {
    *(uint4*)(sA + (lr + 32 * i) * LST + lc) = ra[i];
    *(uint4*)(sB + (lr + 32 * i) * LST + lc) = rb[i];
  }
  __syncthreads();
  for (int kt = 0; kt < nkt; ++kt) {
    const bool more = (kt + 1 < nkt);
    if (more) {
#pragma unroll
      for (int i = 0; i < 4; ++i) {
        ra[i] = *(const uint4*)(af(lr + 32 * i, kt + 1) + lc);
        rb[i] = *(const uint4*)(bf(lr + 32 * i, kt + 1) + lc);
      }
    }
    const bf16_t* pa = sA + (kt & 1) * 128 * LST + (wm * 64 + r) * LST + h * 8;
    const bf16_t* pb = sB + (kt & 1) * 128 * LST + (wn * 64 + r) * LST + h * 8;
#pragma unroll
    for (int ks = 0; ks < 4; ++ks) {
      bf16x8 a0 = *(const bf16x8*)(pa + ks * 16);
      bf16x8 a1 = *(const bf16x8*)(pa + 32 * LST + ks * 16);
      bf16x8 b0 = *(const bf16x8*)(pb + ks * 16);
      bf16x8 b1 = *(const bf16x8*)(pb + 32 * LST + ks * 16);
      acc[0][0] = MFMA(a0, b0, acc[0][0]);
      acc[0][1] = MFMA(a0, b1, acc[0][1]);
      acc[1][0] = MFMA(a1, b0, acc[1][0]);
      acc[1][1] = MFMA(a1, b1, acc[1][1]);
    }
    if (more) {
      const int nb = ((kt + 1) & 1) * 128 * LST;
#pragma unroll
      for (int i = 0; i < 4; ++i) {
        *(uint4*)(sA + nb + (lr + 32 * i) * LST + lc) = ra[i];
        *(uint4*)(sB + nb + (lr + 32 * i) * LST + lc) = rb[i];
      }
    }
    __syncthreads();
  }
#pragma unroll
  for (int mi = 0; mi < 2; ++mi)
#pragma unroll
    for (int g = 0; g < 4; ++g) {
      float4 v0 = {acc[mi][0][4 * g], acc[mi][0][4 * g + 1], acc[mi][0][4 * g + 2], acc[mi][0][4 * g + 3]};
      float4 v1 = {acc[mi][1][4 * g], acc[mi][1][4 * g + 1], acc[mi][1][4 * g + 2], acc[mi][1][4 * g + 3]};
      epi(wm * 64 + mi * 32 + 8 * g + 4 * h, wn * 64 + r, v0, v1);
      __builtin_amdgcn_sched_barrier(0);
    }
}

DI float f4get(const float4& v, int j) { return j == 0 ? v.x : (j == 1 ? v.y : (j == 2 ? v.z : v.w)); }

template <class F>
DI void prep_w(bf16_t* dst, int K, int N, int ld, F colsrc) {
  const long total = (long)N * (K / 8);
  for (long idx = (long)blockIdx.x * 256 + threadIdx.x; idx < total; idx += (long)gridDim.x * 256) {
    const int n = (int)(idx % N);
    const int kg = (int)(idx / N);
    const float* s = colsrc(n);
    uint4 o = {0u, 0u, 0u, 0u};
    if (s) {
      s += (long)kg * 8 * ld;
      float v0 = s[0], v1 = s[(long)ld], v2 = s[2l * ld], v3 = s[3l * ld], v4 = s[4l * ld], v5 = s[5l * ld], v6 = s[6l * ld], v7 = s[7l * ld];
      o.x = pack2(v0, v1); o.y = pack2(v2, v3); o.z = pack2(v4, v5); o.w = pack2(v6, v7);
    }
    *(uint4*)(dst + (long)n * K + kg * 8) = o;
  }
}

DI void phase0(const P& p, float* smf) {
  unsigned char* ws = p.ws;
  const int gt = blockIdx.x * 256 + threadIdx.x, gs = gridDim.x * 256;
  {
    float* modp = (float*)(ws + W_MODP);
    for (int it = blockIdx.x; it < 768; it += gridDim.x) {
      const int kc = it / 96, ch = it % 96;
      __syncthreads();
      for (int e = threadIdx.x; e < 20 * 128; e += 256) {
        const int m = e >> 7, k = e & 127;
        const float c = (m < 4) ? p.in[2][m * 1024 + kc * 128 + k] : p.in[3][(m - 4) * 1024 + kc * 128 + k];
        smf[k * 20 + m] = c / (1.f + __expf(-c));
      }
      __syncthreads();
      const int n = ch * 256 + threadIdx.x;
      const int layer = n / 6144, col = n % 6144;
      const float* w = p.in[10] + ((long)(layer * 1024 + kc * 128)) * 6144 + col;
      float acc[20];
#pragma unroll
      for (int m = 0; m < 20; ++m) acc[m] = 0.f;
      for (int k = 0; k < 128; ++k) {
        const float wv = w[(long)k * 6144];
#pragma unroll
        for (int m = 0; m < 20; ++m) acc[m] += smf[k * 20 + m] * wv;
      }
#pragma unroll
      for (int m = 0; m < 20; ++m) modp[(long)(kc * 20 + m) * 24576 + n] = acc[m];
    }
  }
  {
    float2* ap = (float2*)(ws + W_AP);
    for (int idx = gt; idx < 64 * 65 * 64; idx += gs) {
      const int g = idx / (65 * 64), tau = (idx / 64) % 65, pp = idx & 63;
      const float dt = expf(p.in[24][g]);
      const float are = p.in[17][g * 64 + pp], aim = p.in[18][g * 64 + pp];
      const float mag = expf(are * dt * (float)tau);
      double t = (double)aim * (double)dt * (double)tau * 0.15915494309189535;
      t -= __builtin_rint(t);
      const float ft = (float)t;
      ap[idx] = make_float2(mag * __builtin_amdgcn_cosf(ft), mag * __builtin_amdgcn_sinf(ft));
    }
    float2* bb = (float2*)(ws + W_BBAR);
    for (int idx = gt; idx < 64 * 64 * 16; idx += gs) {
      const int g = idx / 1024, pp = (idx >> 4) & 63;
      const float dt = expf(p.in[24][g]);
      const float are = p.in[17][g * 64 + pp], aim = p.in[18][g * 64 + pp];
      const float mag = expf(are * dt);
      double t = (double)aim * (double)dt * 0.15915494309189535;
      t -= __builtin_rint(t);
      const float ft = (float)t;
      const float nr = mag * __builtin_amdgcn_cosf(ft) - 1.f, ni = mag * __builtin_amdgcn_sinf(ft);
      const float den = are * are + aim * aim;
      const float qr = (nr * are + ni * aim) / den, qi = (ni * are - nr * aim) / den;
      const float br = p.in[19][idx], bi = p.in[20][idx];
      bb[idx] = make_float2(qr * br - qi * bi, qr * bi + qi * br);
    }
  }
  if (gt == 0) {
    float s1 = 0.f, s2 = 0.f;
    for (int i = 0; i < 64; ++i) { s1 += p.in[28][i] * p.in[29][i]; s2 += p.in[30][i] * p.in[31][i]; }
    *(float*)(ws + W_LAM) = expf(s1) - expf(s2) + LAMBDA_INIT;
  }
  {
    bf16_t* w1 = (bf16_t*)(ws + W_WS1);
    bf16_t* w2 = (bf16_t*)(ws + W_WS2);
    const float* wsrc = p.in[44];
    for (int idx = gt; idx < 8 * 128 * 128; idx += gs) {
      const int g = idx >> 14, t = (idx >> 7) & 127, s = idx & 127;
      w1[idx] = f2bf(s <= t ? wsrc[idx] : 0.f);
      const int tt = t & 63, ss = s & 63;
      w2[idx] = f2bf(((t >> 6) == (s >> 6) && ss <= tt) ? wsrc[(g * 128 + tt) * 128 + ss] : 0.f);
    }
  }
  for (int l = 0; l < 4; ++l) {
    const float* up = p.in[14] + (long)l * 1024 * 4096;
    prep_w((bf16_t*)(ws + W_WUP) + (long)l * 4096 * 1024, 1024, 4096, 4096, [=](int n) { return up + n; });
    const float* dn = p.in[15] + (long)l * 4096 * 1024;
    prep_w((bf16_t*)(ws + W_WDN) + (long)l * 1024 * 4096, 4096, 1024, 1024, [=](int n) { return dn + n; });
  }
  {
    const float* ga = p.in[25]; const float* gb = p.in[26];
    prep_w((bf16_t*)(ws + W_GLU), 1024, 2048, 1024, [=](int n) { const int sp = n >> 6, w = n & 63; return ((w < 32) ? ga : gb) + sp * 32 + (w & 31); });
    const float* s = p.in[27];
    prep_w((bf16_t*)(ws + W_QKV), 1024, 3072, 3072, [=](int n) { return s + n; });
    const float* s2 = p.in[33];
    prep_w((bf16_t*)(ws + W_DWO), 1024, 1024, 1024, [=](int n) { return s2 + n; });
    const float* dq = p.in[34];
    prep_w((bf16_t*)(ws + W_MD), 1024, 256, 256, [=](int n) { return dq + n; });
    const float* dkv = p.in[37];
    prep_w((bf16_t*)(ws + W_MD) + 256 * 1024, 1024, 256, 160, [=](int n) -> const float* {
      if (n < 128) return dkv + n;
      const int w = n - 128;
      if (w < 16) return dkv + 128 + w;
      if (w >= 32 && w < 48) return dkv + 144 + (w - 32);
      return nullptr;
    });
    const float* uq = p.in[36];
    prep_w((bf16_t*)(ws + W_MUQ), 256, 1536, 1536, [=](int n) {
      if (n < 1024) return uq + (n >> 6) * 96 + (n & 63);
      const int sp = (n - 1024) >> 6, w = (n - 1024) & 63, half = w >> 5, ix = w & 31;
      const int head = sp * 2 + (ix >> 4), i = ix & 15;
      return uq + head * 96 + 64 + half * 16 + i;
    });
    const float* uk = p.in[39]; const float* uv = p.in[40];
    prep_w((bf16_t*)(ws + W_MUKV), 128, 2048, 1024, [=](int n) { return n < 1024 ? uk + n : uv + (n - 1024); });
    const float* mwo = p.in[41];
    prep_w((bf16_t*)(ws + W_MWO), 1024, 1024, 1024, [=](int n) { return mwo + n; });
    const float* sin_ = p.in[42];
    prep_w((bf16_t*)(ws + W_SIN), 1024, 4096, 4096, [=](int n) { return sin_ + n; });
    const float* sout = p.in[46];
    prep_w((bf16_t*)(ws + W_SOUT), 2048, 1024, 1024, [=](int n) { return sout + n; });
  }
}

DI void phase1(const P& p) {
  unsigned char* ws = p.ws;
  const int gt = blockIdx.x * 256 + threadIdx.x, gs = gridDim.x * 256;
  {
    const float* modp = (const float*)(ws + W_MODP);
    float* mod = (float*)(ws + W_MOD);
    for (int idx = gt; idx < 20 * 24576; idx += gs) {
      const int n = idx % 24576;
      float s = p.in[11][n];
#pragma unroll
      for (int kc = 0; kc < 8; ++kc) s += modp[(long)kc * 20 * 24576 + idx];
      mod[idx] = s;
    }
  }
  const float2* ap = (const float2*)(ws + W_AP);
  const float2* bb = (const float2*)(ws + W_BBAR);
  const float* cre = p.in[21]; const float* cim = p.in[22];
  {
    bf16_t* E = (bf16_t*)(ws + W_E);
    for (int idx = gt; idx < 64 * 16 * 2048; idx += gs) {
      const int g = idx >> 15, co = (idx >> 11) & 15, j = idx & 2047;
      float v = 0.f;
      if (j < 1024) {
        const int tau = 63 - (j >> 4), ci = j & 15;
        for (int pp = 0; pp < 64; ++pp) {
          const float2 a = ap[(g * 65 + tau) * 64 + pp];
          const float2 b = bb[(g * 64 + pp) * 16 + ci];
          const float cr = cre[(g * 16 + co) * 64 + pp], cimv = cim[(g * 16 + co) * 64 + pp];
          const float abr = a.x * b.x - a.y * b.y, abi = a.x * b.y + a.y * b.x;
          v += cr * abr - cimv * abi;
        }
        if (tau == 0 && co == ci) v += p.in[23][g * 16 + co];
      }
      E[idx] = f2bf(v);
    }
    bf16_t* CH = (bf16_t*)(ws + W_CH);
    for (int idx = gt; idx < 64 * 1024 * 128; idx += gs) {
      const int g = idx >> 17, m = (idx >> 7) & 1023, q = idx & 127;
      const int t = m >> 4, co = m & 15, pp = q & 63;
      const float2 a = ap[(g * 65 + t + 1) * 64 + pp];
      const float cr = cre[(g * 16 + co) * 64 + pp], cimv = cim[(g * 16 + co) * 64 + pp];
      const float zr = cr * a.x - cimv * a.y, zi = cr * a.y + cimv * a.x;
      CH[idx] = f2bf(q < 64 ? zr : -zi);
    }
    bf16_t* ME = (bf16_t*)(ws + W_MEND);
    for (int idx = gt; idx < 64 * 128 * 1024; idx += gs) {
      const int g = idx >> 17, q = (idx >> 10) & 127, k = idx & 1023;
      const int s = k >> 4, c = k & 15, pp = q & 63;
      const float2 a = ap[(g * 65 + 63 - s) * 64 + pp];
      const float2 b = bb[(g * 64 + pp) * 16 + c];
      ME[idx] = f2bf(q < 64 ? (a.x * b.x - a.y * b.y) : (a.x * b.y + a.y * b.x));
    }
  }
}

template <int MODE>
DI void phase_modulate(const P& p, int layer, int which) {
  unsigned char* ws = p.ws;
  const float* mod = (const float*)(ws + W_MOD);
  const float* gam = (which == 0 ? p.in[12] : p.in[13]) + layer * 1024;
  const int lane = threadIdx.x & 63;
  const int wv = blockIdx.x * 4 + (threadIdx.x >> 6), nwv = gridDim.x * 4;
  bf16_t* H = (bf16_t*)(ws + W_H);
  bf16_t* HG = (bf16_t*)(ws + W_BIG + B_HG);
  for (int row = wv; row < NT; row += nwv) {
    const float* x = (MODE == 1) ? (row < NTP ? p.in[0] + (long)row * 1024 : p.in[1] + (long)(row - NTP) * 1024) : p.out + (long)row * 1024;
    float4 v[4];
    float ss = 0.f;
#pragma unroll
    for (int i = 0; i < 4; ++i) {
      v[i] = *(const float4*)(x + lane * 4 + 256 * i);
      ss += v[i].x * v[i].x + v[i].y * v[i].y + v[i].z * v[i].z + v[i].w * v[i].w;
    }
    ss = wave_sum(ss);
    const float rinv = rsqrtf(ss * (1.f / 1024.f) + NORM_EPS);
    const int b = batch_of(row);
    const float* sh = mod + (long)b * 24576 + layer * 6144 + (which * 3) * 1024;
    const float* sc = sh + 1024;
#pragma unroll
    for (int i = 0; i < 4; ++i) {
      const int col = lane * 4 + 256 * i;
      const float4 g4 = *(const float4*)(gam + col), sh4 = *(const float4*)(sh + col), sc4 = *(const float4*)(sc + col);
      const float h0 = v[i].x * rinv * g4.x * (1.f + sc4.x) + sh4.x;
      const float h1 = v[i].y * rinv * g4.y * (1.f + sc4.y) + sh4.y;
      const float h2 = v[i].z * rinv * g4.z * (1.f + sc4.z) + sh4.z;
      const float h3 = v[i].w * rinv * g4.w * (1.f + sc4.w) + sh4.w;
      uint2 o = {pack2(h0, h1), pack2(h2, h3)};
      if (MODE == 1) {
        *(float4*)(p.out + (long)row * 1024 + col) = v[i];
        const int g = col >> 4, c = col & 15, n = row >> 6, s = row & 63;
        *(uint2*)(HG + ((long)(g * 640 + n)) * 1152 + s * 16 + c) = o;
      } else {
        *(uint2*)(H + (long)row * 1024 + col) = o;
      }
    }
  }
}

DI void phase_s5_carry(const P& p) {
  unsigned char* ws = p.ws;
  const float2* ap = (const float2*)(ws + W_AP);
  const float* sloc = (const float*)(ws + W_BIG + B_SLOC);
  bf16_t* HG = (bf16_t*)(ws + W_BIG + B_HG);
  const int gt = blockIdx.x * 256 + threadIdx.x, gs = gridDim.x * 256;
  for (int idx = gt; idx < 64 * 20 * 64; idx += gs) {
    const int g = idx / 1280, bb = (idx >> 6) % 20, pp = idx & 63;
    const float2 a = ap[(g * 65 + 64) * 64 + pp];
    if (bb < 4) {
      float hr = 0.f, hi = 0.f;
#pragma unroll 8
      for (int k = 0; k < 128; ++k) {
        const long n = (long)g * 640 + bb * 128 + k;
        HG[n * 1152 + 1024 + pp] = f2bf(hr);
        HG[n * 1152 + 1088 + pp] = f2bf(hi);
        const float sr = sloc[n * 128 + pp], si = sloc[n * 128 + 64 + pp];
        const float nr = a.x * hr - a.y * hi + sr, ni = a.x * hi + a.y * hr + si;
        hr = nr; hi = ni;
      }
      p.out[O_S5RP + (bb * 64 + g) * 64 + pp] = hr;
      p.out[O_S5IP + (bb * 64 + g) * 64 + pp] = hi;
    } else {
      const int b = bb - 4;
      const long n = (long)g * 640 + 512 + b;
      float hr = p.in[4][(b * 64 + g) * 64 + pp], hi = p.in[5][(b * 64 + g) * 64 + pp];
      HG[n * 1152 + 1024 + pp] = f2bf(hr);
      HG[n * 1152 + 1088 + pp] = f2bf(hi);
      const float sr = sloc[n * 128 + pp], si = sloc[n * 128 + 64 + pp];
      p.out[O_S5RS + (b * 64 + g) * 64 + pp] = a.x * hr - a.y * hi + sr;
      p.out[O_S5IS + (b * 64 + g) * 64 + pp] = a.x * hi + a.y * hr + si;
    }
  }
}

DI const float* mod_ptr(const P& p, int layer, int k) { return (const float*)(p.ws + W_MOD) + layer * 6144 + k * 1024; }

DI void phase_s5a(const P& p, bf16_t* smem) {
  const bf16_t* HG = (const bf16_t*)(p.ws + W_BIG + B_HG);
  const bf16_t* ME = (const bf16_t*)(p.ws + W_MEND);
  float* sloc = (float*)(p.ws + W_BIG + B_SLOC);
  for (int t = blockIdx.x; t < 64 * 5; t += gridDim.x) {
    const int g = t / 5, mi = t % 5;
    const bf16_t* a0 = HG + (long)(g * 640 + mi * 128) * 1152;
    const bf16_t* b0 = ME + (long)g * 128 * 1024;
    float* o = sloc + (long)(g * 640 + mi * 128) * 128;
    gemm_tile(smem, [=](int r, int kt) { return a0 + (long)r * 1152 + kt * 64; }, [=](int r, int kt) { return b0 + (long)r * 1024 + kt * 64; }, 16,
              [=](int row0, int col, float4 v0, float4 v1) {
#pragma unroll
                for (int j = 0; j < 4; ++j) {
                  o[(long)(row0 + j) * 128 + col] = f4get(v0, j);
                  o[(long)(row0 + j) * 128 + col + 32] = f4get(v1, j);
                }
              });
  }
}

DI void phase_s5b(const P& p, bf16_t* smem) {
  const bf16_t* HG = (const bf16_t*)(p.ws + W_BIG + B_HG);
  const bf16_t* E = (const bf16_t*)(p.ws + W_E);
  const bf16_t* CH = (const bf16_t*)(p.ws + W_CH);
  bf16_t* Z = (bf16_t*)(p.ws + W_BIG + B_Z);
  for (int t = blockIdx.x; t < 64 * 5 * 8; t += gridDim.x) {
    const int g = t / 40, mi = (t % 40) >> 3, j = 7 - (t & 7);
    const int nE = 2 * j + 2;
    const bf16_t* a0 = HG + (long)(g * 640 + mi * 128) * 1152;
    const bf16_t* e0 = E + (long)g * 16 * 2048;
    const bf16_t* c0 = CH + ((long)g * 1024 + j * 128) * 128;
    gemm_tile(smem,
              [=](int r, int kt) { const int k = kt < nE ? kt : 16 + kt - nE; return a0 + (long)r * 1152 + k * 64; },
              [=](int r, int kt) -> const bf16_t* {
                if (kt < nE) { const int tt = 8 * j + (r >> 4), co = r & 15; return e0 + co * 2048 + (63 - tt) * 16 + kt * 64; }
                return c0 + (long)r * 128 + (kt - nE) * 64;
              },
              nE + 2,
              [=](int row0, int col, float4 v0, float4 v1) {
#pragma unroll
                for (int q = 0; q < 4; ++q) {
                  const int n = mi * 128 + row0 + q;
                  if (n < 528) {
                    const int c0_ = col, c1_ = col + 32;
                    const long tok0 = (long)n * 64 + 8 * j + (c0_ >> 4), tok1 = (long)n * 64 + 8 * j + (c1_ >> 4);
                    Z[tok0 * 1024 + g * 16 + (c0_ & 15)] = f2bf(gelu_t(f4get(v0, q)));
                    Z[tok1 * 1024 + g * 16 + (c1_ & 15)] = f2bf(gelu_t(f4get(v1, q)));
                  }
                }
              });
  }
}

template <class EPI>
DI void run_gemm(bf16_t* smem, const bf16_t* A, int lda, const bf16_t* B, int ldb, int mtiles, int ntiles, int nkt, EPI epi) {
  for (int t = blockIdx.x; t < mtiles * ntiles; t += gridDim.x) {
    const int mt = t / ntiles, nt = t % ntiles;
    const bf16_t* a0 = A + (long)mt * 128 * lda;
    const bf16_t* b0 = B + (long)nt * 128 * ldb;
    gemm_tile(smem, [=](int r, int kt) { return a0 + (long)r * lda + kt * 64; }, [=](int r, int kt) { return b0 + (long)r * ldb + kt * 64; }, nkt,
              [=](int row0, int col, float4 v0, float4 v1) { epi(mt * 128 + row0, nt * 128 + col, v0, v1); });
  }
}

DI void resid_add(const P& p, const float* gate, int row0, int col, float4 v0, float4 v1) {
  const float* gb = gate + (long)batch_of(row0) * 24576;
  const float g0 = 1.f + gb[col], g1 = 1.f + gb[col + 32];
#pragma unroll
  for (int j = 0; j < 4; ++j) {
    float* x = p.out + (long)(row0 + j) * 1024;
    x[col] += g0 * f4get(v0, j);
    x[col + 32] += g1 * f4get(v1, j);
  }
}

DI void phase_glu(const P& p, bf16_t* smem) {
  const float* gate = mod_ptr(p, 0, 2);
  run_gemm(smem, (const bf16_t*)(p.ws + W_BIG + B_Z), 1024, (const bf16_t*)(p.ws + W_GLU), 1024, 264, 16, 16,
           [=](int row0, int col, float4 v0, float4 v1) {
             const int oc = (col >> 6) * 32 + (col & 31);
             const float g0 = 1.f + gate[(long)batch_of(row0) * 24576 + oc];
#pragma unroll
             for (int j = 0; j < 4; ++j) {
               float* x = p.out + (long)(row0 + j) * 1024 + oc;
               *x += g0 * f4get(v0, j) * sigmoid_f(f4get(v1, j));
             }
           });
}

DI void phase_mlp_up(const P& p, bf16_t* smem, int layer) {
  bf16_t* act = (bf16_t*)(p.ws + W_BIG + B_ACT);
  run_gemm(smem, (const bf16_t*)(p.ws + W_H), 1024, (const bf16_t*)(p.ws + W_WUP) + (long)layer * 4096 * 1024, 1024, 264, 32, 16,
           [=](int row0, int col, float4 v0, float4 v1) {
#pragma unroll
             for (int j = 0; j < 4; ++j) {
               const float a = fmaxf(f4get(v0, j), 0.f), b = fmaxf(f4get(v1, j), 0.f);
               act[(long)(row0 + j) * 4096 + col] = f2bf(a * a);
               act[(long)(row0 + j) * 4096 + col + 32] = f2bf(b * b);
             }
           });
}

DI void phase_mlp_down(const P& p, bf16_t* smem, int layer) {
  const float* gate = mod_ptr(p, layer, 5);
  run_gemm(smem, (const bf16_t*)(p.ws + W_BIG + B_ACT), 4096, (const bf16_t*)(p.ws + W_WDN) + (long)layer * 1024 * 4096, 4096, 264, 8, 64,
           [=](int row0, int col, float4 v0, float4 v1) { resid_add(p, gate, row0, col, v0, v1); });
}

DI void phase_proj_resid(const P& p, bf16_t* smem, const bf16_t* A, int K, const bf16_t* B, int layer) {
  const float* gate = mod_ptr(p, layer, 2);
  run_gemm(smem, A, K, B, K, 264, 8, K / 64, [=](int row0, int col, float4 v0, float4 v1) { resid_add(p, gate, row0, col, v0, v1); });
}

DI void store_t4(bf16_t* dst, float4 v) { *(uint2*)dst = make_uint2(pack2(v.x, v.y), pack2(v.z, v.w)); }

DI void phase_qkv(const P& p, bf16_t* smem) {
  unsigned char* big = p.ws + W_BIG;
  bf16_t* Qb = (bf16_t*)(big + B_QB);
  bf16_t* Kb = (bf16_t*)(big + B_KB);
  bf16_t* VT = (bf16_t*)(big + B_VTD);
  const float qscale = 0.125f * L2E;
  run_gemm(smem, (const bf16_t*)(p.ws + W_H), 1024, (const bf16_t*)(p.ws + W_QKV), 1024, 264, 24, 16,
           [=](int row0, int col, float4 v0, float4 v1) {
             const int region = col >> 10;
             if (region < 2) {
               const int d = col & 31;
               const float invf = exp2f(-(float)d * (13.287712379549449f / 32.f));
#pragma unroll
               for (int j = 0; j < 4; ++j) {
                 const int row = row0 + j;
                 float c, s;
                 rope_cs(pos_of(row), invf, c, s);
                 const float x1 = f4get(v0, j), x2 = f4get(v1, j);
                 const float o1 = x1 * c - x2 * s, o2 = x1 * s + x2 * c;
                 if (region == 0) {
                   Qb[(long)row * 1024 + col] = f2bf(o1 * qscale);
                   Qb[(long)row * 1024 + col + 32] = f2bf(o2 * qscale);
                 } else {
                   const int kc = col - 1024;
                   float* ko = (row < NTP) ? p.out + O_DKP + (long)row * 1024 : p.out + O_DKS + (long)(row - NTP) * 1024;
                   ko[kc] = o1; ko[kc + 32] = o2;
                   const long kr = krow_of(row);
                   Kb[kr * 1024 + kc] = f2bf(o1);
                   Kb[kr * 1024 + kc + 32] = f2bf(o2);
                 }
               }
             } else {
               const int vc = col - 2048;
#pragma unroll
               for (int j = 0; j < 4; ++j) {
                 const int row = row0 + j;
                 float* vo = (row < NTP) ? p.out + O_DVP + (long)row * 1024 : p.out + O_DVS + (long)(row - NTP) * 1024;
                 vo[vc] = f4get(v0, j); vo[vc + 32] = f4get(v1, j);
               }
               long base; int Lk, key;
               if (row0 < NTP) { const int b = row0 >> 13; key = row0 & 8191; Lk = 8192; base = (long)b * 1024 * 8192; }
               else { const int b = (row0 - NTP) >> 6; key = 4096 + ((row0 - NTP) & 63); Lk = SLK; base = 4l * 1024 * 8192 + (long)b * 1024 * SLK; }
               store_t4(VT + base + (long)vc * Lk + key, v0);
               store_t4(VT + base + (long)(vc + 32) * Lk + key, v1);
             }
           });
  {
    const float* ck = p.in[6]; const float* cv = p.in[7];
    const long gt = (long)blockIdx.x * 256 + threadIdx.x, gs = (long)gridDim.x * 256;
    for (long idx = gt; idx < 16l * 4096 * 128; idx += gs) {
      const long rowc = idx >> 7; const int c8 = (int)(idx & 127) * 8;
      const int b = (int)(rowc >> 12), jk = (int)(rowc & 4095);
      const float4 a = *(const float4*)(ck + rowc * 1024 + c8), bq = *(const float4*)(ck + rowc * 1024 + c8 + 4);
      uint4 o = {pack2(a.x, a.y), pack2(a.z, a.w), pack2(bq.x, bq.y), pack2(bq.z, bq.w)};
      *(uint4*)(Kb + ((long)NTP + (long)b * SLK + jk) * 1024 + c8) = o;
    }
    for (long idx = gt; idx < 16l * 512 * 1024; idx += gs) {
      const int hd = (int)(idx & 1023); const long t = idx >> 10;
      const int kg = (int)(t & 511), b = (int)(t >> 9);
      const float* src = cv + ((long)b * 4096 + kg * 8) * 1024 + hd;
      const float v0 = src[0], v1 = src[1024], v2 = src[2048], v3 = src[3072], v4 = src[4096], v5 = src[5120], v6 = src[6144], v7 = src[7168];
      uint4 o = {pack2(v0, v1), pack2(v2, v3), pack2(v4, v5), pack2(v6, v7)};
      *(uint4*)(VT + 4l * 1024 * 8192 + (long)b * 1024 * SLK + (long)hd * SLK + kg * 8) = o;
    }
  }
}

DI void phase_mla_down(const P& p, bf16_t* smem) {
  unsigned char* big = p.ws + W_BIG;
  float* raw = (float*)(big + B_RAW);
  bf16_t* KR = (bf16_t*)(big + B_KR);
  run_gemm(smem, (const bf16_t*)(p.ws + W_H), 1024, (const bf16_t*)(p.ws + W_MD), 1024, 264, 4, 16,
           [=](int row0, int col, float4 v0, float4 v1) {
             if (col < 384) {
#pragma unroll
               for (int j = 0; j < 4; ++j) {
                 raw[(long)(row0 + j) * 384 + col] = f4get(v0, j);
                 raw[(long)(row0 + j) * 384 + col + 32] = f4get(v1, j);
               }
             } else if (col < 400) {
               const int i = col - 384;
               const float invf = exp2f(-(float)i * (13.287712379549449f / 16.f));
#pragma unroll
               for (int j = 0; j < 4; ++j) {
                 const int row = row0 + j;
                 float c, s;
                 rope_cs(pos_of(row), invf, c, s);
                 const float x1 = f4get(v0, j), x2 = f4get(v1, j);
                 const float o1 = x1 * c - x2 * s, o2 = x1 * s + x2 * c;
                 float* ko = (row < NTP) ? p.out + O_KRP + (long)row * 32 : p.out + O_KRS + (long)(row - NTP) * 32;
                 ko[i] = o1; ko[16 + i] = o2;
                 const long kr = krow_of(row);
                 KR[kr * 32 + i] = f2bf(o1); KR[kr * 32 + 16 + i] = f2bf(o2);
               }
             }
           });
  {
    bf16_t* CKV = (bf16_t*)(big + B_CKV);
    const float* cc = p.in[8]; const float* cr = p.in[9];
    const long gt = (long)blockIdx.x * 256 + threadIdx.x, gs = (long)gridDim.x * 256;
    for (long idx = gt; idx < 16l * 4096 * 16; idx += gs) {
      const long rowc = idx >> 4; const int c8 = (int)(idx & 15) * 8;
      const int b = (int)(rowc >> 12), jk = (int)(rowc & 4095);
      const float4 a = *(const float4*)(cc + rowc * 128 + c8), bq = *(const float4*)(cc + rowc * 128 + c8 + 4);
      uint4 o = {pack2(a.x, a.y), pack2(a.z, a.w), pack2(bq.x, bq.y), pack2(bq.z, bq.w)};
      *(uint4*)(CKV + ((long)NTP + (long)b * SLK + jk) * 128 + c8) = o;
    }
    for (long idx = gt; idx < 16l * 4096 * 4; idx += gs) {
      const long rowc = idx >> 2; const int c8 = (int)(idx & 3) * 8;
      const int b = (int)(rowc >> 12), jk = (int)(rowc & 4095);
      const float4 a = *(const float4*)(cr + rowc * 32 + c8), bq = *(const float4*)(cr + rowc * 32 + c8 + 4);
      uint4 o = {pack2(a.x, a.y), pack2(a.z, a.w), pack2(bq.x, bq.y), pack2(bq.z, bq.w)};
      *(uint4*)(KR + ((long)NTP + (long)b * SLK + jk) * 32 + c8) = o;
    }
  }
}

DI void phase_mla_norm(const P& p) {
  unsigned char* big = p.ws + W_BIG;
  const float* raw = (const float*)(big + B_RAW);
  bf16_t* CQ = (bf16_t*)(big + B_CQ);
  bf16_t* CKV = (bf16_t*)(big + B_CKV);
  const int lane = threadIdx.x & 63;
  const int wv = blockIdx.x * 4 + (threadIdx.x >> 6), nwv = gridDim.x * 4;
  const float4 gq = *(const float4*)(p.in[35] + lane * 4);
  const float2 gk = *(const float2*)(p.in[38] + lane * 2);
  for (int row = wv; row < NT; row += nwv) {
    const float4 q = *(const float4*)(raw + (long)row * 384 + lane * 4);
    const float2 k = *(const float2*)(raw + (long)row * 384 + 256 + lane * 2);
    const float sq = wave_sum(q.x * q.x + q.y * q.y + q.z * q.z + q.w * q.w);
    const float sk = wave_sum(k.x * k.x + k.y * k.y);
    const float rq = rsqrtf(sq * (1.f / 256.f) + NORM_EPS), rk = rsqrtf(sk * (1.f / 128.f) + NORM_EPS);
    *(uint2*)(CQ + (long)row * 256 + lane * 4) = make_uint2(pack2(q.x * rq * gq.x, q.y * rq * gq.y), pack2(q.z * rq * gq.z, q.w * rq * gq.w));
    const float c0 = k.x * rk * gk.x, c1 = k.y * rk * gk.y;
    float* co = (row < NTP) ? p.out + O_CKP + (long)row * 128 : p.out + O_CKS + (long)(row - NTP) * 128;
    *(float2*)(co + lane * 2) = make_float2(c0, c1);
    *(unsigned*)(CKV + (long)krow_of(row) * 128 + lane * 2) = pack2(c0, c1);
  }
}

DI void phase_mla_up(const P& p, bf16_t* smem) {
  unsigned char* big = p.ws + W_BIG;
  bf16_t* QM = (bf16_t*)(big + B_QM);
  bf16_t* KN = (bf16_t*)(big + B_KN);
  bf16_t* VT = (bf16_t*)(big + B_VTM);
  const float qscale = 0.10206207261596577f * L2E;
  run_gemm(smem, (const bf16_t*)(big + B_CQ), 256, (const bf16_t*)(p.ws + W_MUQ), 256, 264, 12, 4,
           [=](int row0, int col, float4 v0, float4 v1) {
             if (col < 1024) {
               const int o = (col >> 6) * 96 + (col & 63);
#pragma unroll
               for (int j = 0; j < 4; ++j) {
                 QM[(long)(row0 + j) * 1536 + o] = f2bf(f4get(v0, j) * qscale);
                 QM[(long)(row0 + j) * 1536 + o + 32] = f2bf(f4get(v1, j) * qscale);
               }
             } else {
               const int sp = (col - 1024) >> 6, ix = col & 31;
               const int head = sp * 2 + (ix >> 4), i = ix & 15;
               const float invf = exp2f(-(float)i * (13.287712379549449f / 16.f));
#pragma unroll
               for (int j = 0; j < 4; ++j) {
                 const int row = row0 + j;
                 float c, s;
                 rope_cs(pos_of(row), invf, c, s);
                 const float x1 = f4get(v0, j), x2 = f4get(v1, j);
                 QM[(long)row * 1536 + head * 96 + 64 + i] = f2bf((x1 * c - x2 * s) * qscale);
                 QM[(long)row * 1536 + head * 96 + 80 + i] = f2bf((x1 * s + x2 * c) * qscale);
               }
             }
           });
  run_gemm(smem, (const bf16_t*)(big + B_CKV), 128, (const bf16_t*)(p.ws + W_MUKV), 128, 776, 16, 2,
           [=](int row0, int col, float4 v0, float4 v1) {
             if (col < 1024) {
#pragma unroll
               for (int j = 0; j < 4; ++j) {
                 KN[(long)(row0 + j) * 1024 + col] = f2bf(f4get(v0, j));
                 KN[(long)(row0 + j) * 1024 + col + 32] = f2bf(f4get(v1, j));
               }
             } else {
               const int vc = col - 1024;
               long base; int Lk, key;
               if (row0 < NTP) { const int b = row0 >> 13; key = row0 & 8191; Lk = 8192; base = (long)b * 1024 * 8192; }
               else { const int b = (row0 - NTP) / SLK; key = (row0 - NTP) - b * SLK; Lk = SLK; base = 4l * 1024 * 8192 + (long)b * 1024 * SLK; }
               store_t4(VT + base + (long)vc * Lk + key, v0);
               store_t4(VT + base + (long)(vc + 32) * Lk + key, v1);
             }
           });
}

DI void phase_sgu_in(const P& p, bf16_t* smem) {
  unsigned char* big = p.ws + W_BIG;
  bf16_t* U = (bf16_t*)(big + B_U);
  bf16_t* VR = (bf16_t*)(big + B_VRAW);
  run_gemm(smem, (const bf16_t*)(p.ws + W_H), 1024, (const bf16_t*)(p.ws + W_SIN), 1024, 264, 32, 16,
           [=](int row0, int col, float4 v0, float4 v1) {
             bf16_t* dst = (col < 2048) ? U + col : VR + (col - 2048);
#pragma unroll
             for (int j = 0; j < 4; ++j) {
               dst[(long)(row0 + j) * 2048] = f2bf(gelu_t(f4get(v0, j)));
               dst[(long)(row0 + j) * 2048 + 32] = f2bf(gelu_t(f4get(v1, j)));
             }
           });
}

DI void phase_sgu_norm(const P& p, float* smf) {
  unsigned char* big = p.ws + W_BIG;
  const bf16_t* VR = (const bf16_t*)(big + B_VRAW);
  bf16_t* VTS = (bf16_t*)(big + B_VTS);
  const float* gv = p.in[43];
  const int lane = threadIdx.x & 63, wave = threadIdx.x >> 6;
  for (int c64 = blockIdx.x; c64 < 528; c64 += gridDim.x) {
    __syncthreads();
    for (int s = wave; s < 64; s += 4) {
      const bf16_t* rowp = VR + (long)(c64 * 64 + s) * 2048;
      float ss = 0.f;
#pragma unroll
      for (int i = 0; i < 4; ++i) {
        const uint4 q = *(const uint4*)(rowp + lane * 8 + 512 * i);
        const unsigned w[4] = {q.x, q.y, q.z, q.w};
#pragma unroll
        for (int e = 0; e < 4; ++e) {
          const float a = __uint_as_float(w[e] << 16), b = __uint_as_float(w[e] & 0xffff0000u);
          ss += a * a + b * b;
        }
      }
      ss = wave_sum(ss);
      if (lane == 0) smf[s] = rsqrtf(ss * (1.f / 2048.f) + NORM_EPS);
    }
    __syncthreads();
    for (int task = threadIdx.x; task < 512 * 8; task += 256) {
      const int d4 = (task & 511) * 4, sg = task >> 9;
      const float4 g4 = *(const float4*)(gv + d4);
      float v[8][4];
#pragma unroll
      for (int j = 0; j < 8; ++j) {
        const int s = sg * 8 + j;
        const uint2 q = *(const uint2*)(VR + (long)(c64 * 64 + s) * 2048 + d4);
        const float rs = smf[s];
        v[j][0] = __uint_as_float(q.x << 16) * rs * g4.x;
        v[j][1] = __uint_as_float(q.x & 0xffff0000u) * rs * g4.y;
        v[j][2] = __uint_as_float(q.y << 16) * rs * g4.z;
        v[j][3] = __uint_as_float(q.y & 0xffff0000u) * rs * g4.w;
        if (c64 >= 512) *(float4*)(p.out + O_SGV + (long)((c64 - 512) * 64 + s) * 2048 + d4) = make_float4(v[j][0], v[j][1], v[j][2], v[j][3]);
      }
#pragma unroll
      for (int e = 0; e < 4; ++e) {
        uint4 o = {pack2(v[0][e], v[1][e]), pack2(v[2][e], v[3][e]), pack2(v[4][e], v[5][e]), pack2(v[6][e], v[7][e])};
        *(uint4*)(VTS + ((long)c64 * 2048 + d4 + e) * 64 + sg * 8) = o;
      }
    }
  }
}

DI void phase_sgu_spatial(const P& p, bf16_t* smem) {
  unsigned char* big = p.ws + W_BIG;
  const bf16_t* U = (const bf16_t*)(big + B_U);
  const bf16_t* VTS = (const bf16_t*)(big + B_VTS);
  bf16_t* G = (bf16_t*)(big + B_G);
  const float* bs = p.in[45];
  for (int t = blockIdx.x; t < 264 * 16; t += gridDim.x) {
    const int mt = t >> 4, g = (t >> 1) & 7, dt = t & 1;
    const bf16_t* a0 = (const bf16_t*)(p.ws + (mt < 256 ? W_WS1 : W_WS2)) + g * 128 * 128;
    const bf16_t* b0 = VTS + ((long)mt * 2 * 2048 + g * 256 + dt * 128) * 64;
    const bool prompt = mt < 256;
    gemm_tile(smem, [=](int r, int kt) { return a0 + r * 128 + kt * 64; }, [=](int r, int kt) { return b0 + (long)kt * 2048 * 64 + r * 64; }, 2,
              [=](int row0, int col, float4 v0, float4 v1) {
                const int gc = g * 256 + dt * 128 + col;
#pragma unroll
                for (int j = 0; j < 4; ++j) {
                  const int tr = row0 + j;
                  const float bias = bs[g * 128 + (prompt ? tr : (tr & 63))];
                  const long o = (long)(mt * 128 + tr) * 2048 + gc;
                  G[o] = f2bf(bf2f(U[o]) * (f4get(v0, j) + bias));
                  G[o + 32] = f2bf(bf2f(U[o + 32]) * (f4get(v1, j) + bias));
                }
              });
  }
}

DI void phase_final_norm(const P& p) {
  const int lane = threadIdx.x & 63;
  const int wv = blockIdx.x * 4 + (threadIdx.x >> 6), nwv = gridDim.x * 4;
  const float* gam = p.in[16];
  for (int row = wv; row < NT; row += nwv) {
    float* x = p.out + (long)row * 1024;
    float4 v[4];
    float ss = 0.f;
#pragma unroll
    for (int i = 0; i < 4; ++i) {
      v[i] = *(const float4*)(x + lane * 4 + 256 * i);
      ss += v[i].x * v[i].x + v[i].y * v[i].y + v[i].z * v[i].z + v[i].w * v[i].w;
    }
    ss = wave_sum(ss);
    const float rinv = rsqrtf(ss * (1.f / 1024.f) + NORM_EPS);
#pragma unroll
    for (int i = 0; i < 4; ++i) {
      const int col = lane * 4 + 256 * i;
      const float4 g4 = *(const float4*)(gam + col);
      *(float4*)(x + col) = make_float4(v[i].x * rinv * g4.x, v[i].y * rinv * g4.y, v[i].z * rinv * g4.z, v[i].w * rinv * g4.w);
    }
  }
}

DI bf16x8 pack8(const f32x16& x, int s) {
  unsigned a = pack2(x[8 * s], x[8 * s + 1]), b = pack2(x[8 * s + 2], x[8 * s + 3]), c = pack2(x[8 * s + 4], x[8 * s + 5]), d = pack2(x[8 * s + 6], x[8 * s + 7]);
  uint4 u = {a, b, c, d};
  return __builtin_bit_cast(bf16x8, u);
}

template <bool MLA>
DI void phase_attn(const P& p, bf16_t* smem) {
  constexpr int NKS = MLA ? 6 : 4;
  constexpr int NDT = MLA ? 2 : 4;
  constexpr int NLD = MLA ? 9 : 8;
  unsigned char* big = p.ws + W_BIG;
  const bf16_t* Q = (const bf16_t*)(big + (MLA ? B_QM : B_QB));
  const bf16_t* KK = (const bf16_t*)(big + (MLA ? B_KN : B_KB));
  const bf16_t* KR = (const bf16_t*)(big + B_KR);
  const bf16_t* VT = (const bf16_t*)(big + (MLA ? B_VTM : B_VTD));
  bf16_t* OB = (bf16_t*)(big + (MLA ? B_OBM : B_OB));
  const float lam = *(const float*)(p.ws + W_LAM);
  const float* gsub = p.in[32];
  const int tid = threadIdx.x, lane = tid & 63, wave = tid >> 6;
  const int wp = wave >> 1, wq = wave & 1, r = lane & 31, hh = lane >> 5;
  constexpr int L_K0 = 0, L_K1 = 4608, L_KR = 9216, L_V0 = MLA ? 11776 : 9216, L_V1 = 16384;
  for (int it = blockIdx.x; it < 4224; it += gridDim.x) {
    int b, hx, qrow0, ntiles, Lk; long R0, vbase;
    if (it < 128) {
      b = it >> 3; hx = it & 7; qrow0 = NTP + b * 64; ntiles = 65; Lk = SLK;
      R0 = (long)NTP + (long)b * SLK; vbase = 4l * 1024 * 8192 + (long)b * 1024 * SLK;
    } else {
      const int i = it - 128; const int qc = 127 - (i >> 5); b = (i & 31) >> 3; hx = i & 7;
      qrow0 = b * 8192 + qc * 64; ntiles = qc + 1; Lk = 8192; R0 = (long)b * 8192; vbase = (long)b * 1024 * 8192;
    }
    bf16x8 qf[NKS];
    {
      const long qr = (long)(qrow0 + wq * 32 + r);
      const bf16_t* qp = MLA ? Q + qr * 1536 + (hx * 2 + wp) * 96 + 8 * hh : Q + qr * 1024 + (hx * 2 + wp) * 64 + 8 * hh;
#pragma unroll
      for (int ks = 0; ks < NKS; ++ks) qf[ks] = *(const bf16x8*)(qp + ks * 16);
    }
    f32x16 O[NDT];
#pragma unroll
    for (int d = 0; d < NDT; ++d)
#pragma unroll
      for (int i = 0; i < 16; ++i) O[d][i] = 0.f;
    float m_run = -1e30f, l_run = 0.f;
    u32x4 ld[NLD];
#define ATT_GLOAD(KT)                                                                                                   \
  {                                                                                                                     \
    const long kr0 = R0 + (long)(KT) * 64;                                                                              \
    _Pragma("unroll") for (int j = 0; j < 4; ++j) {                                                                     \
      const int c = j >> 1, id = tid + 256 * (j & 1), key = id >> 3, ch = id & 7;                                       \
      ld[j] = *(const u32x4*)(KK + (kr0 + key) * 1024 + (hx * 2 + c) * 64 + ch * 8);                                    \
    }                                                                                                                   \
    if (!MLA) {                                                                                                         \
      _Pragma("unroll") for (int i = 0; i < 4; ++i) {                                                                   \
        const int id = tid + 256 * i, dv = id >> 3, ch = id & 7;                                                        \
        ld[4 + i] = *(const u32x4*)(VT + vbase + (long)(hx * 128 + dv) * Lk + (KT) * 64 + ch * 8);                      \
      }                                                                                                                 \
    } else {                                                                                                            \
      _Pragma("unroll") for (int j = 0; j < 4; ++j) {                                                                   \
        const int c = j >> 1, id = tid + 256 * (j & 1), dv = id >> 3, ch = id & 7;                                      \
        ld[4 + j] = *(const u32x4*)(VT + vbase + (long)((hx * 2 + c) * 64 + dv) * Lk + (KT) * 64 + ch * 8);             \
      }                                                                                                                 \
      ld[NLD - 1] = *(const u32x4*)(KR + (kr0 + (tid >> 2)) * 32 + (tid & 3) * 8);                                      \
    }                                                                                                                   \
  }
#define ATT_SWRITE()                                                                                                    \
  {                                                                                                                     \
    _Pragma("unroll") for (int j = 0; j < 4; ++j) {                                                                     \
      const int c = j >> 1, id = tid + 256 * (j & 1), key = id >> 3, ch = id & 7;                                       \
      *(u32x4*)(smem + (c ? L_K1 : L_K0) + key * LST + ch * 8) = ld[j];                                                 \
    }                                                                                                                   \
    if (!MLA) {                                                                                                         \
      _Pragma("unroll") for (int i = 0; i < 4; ++i) {                                                                   \
        const int id = tid + 256 * i, dv = id >> 3, ch = id & 7;                                                        \
        *(u32x4*)(smem + L_V0 + dv * LST + ch * 8) = ld[4 + i];                                                         \
      }                                                                                                                 \
    } else {                                                                                                            \
      _Pragma("unroll") for (int j = 0; j < 4; ++j) {                                                                   \
        const int c = j >> 1, id = tid + 256 * (j & 1), dv = id >> 3, ch = id & 7;                                      \
        *(u32x4*)(smem + (c ? L_V1 : L_V0) + dv * LST + ch * 8) = ld[4 + j];                                            \
      }                                                                                                                 \
      *(u32x4*)(smem + L_KR + (tid >> 2) * 40 + (tid & 3) * 8) = ld[NLD - 1];                                           \
    }                                                                                                                   \
  }
    ATT_GLOAD(0)
    const bf16_t* sK = smem + (wp ? L_K1 : L_K0);
    const bf16_t* sV = smem + ((MLA && wp) ? L_V1 : L_V0);
    for (int kt = 0; kt < ntiles; ++kt) {
      __syncthreads();
      ATT_SWRITE()
      __syncthreads();
      if (kt + 1 < ntiles) ATT_GLOAD(kt + 1)
      f32x16 st[2];
#pragma unroll
      for (int mt = 0; mt < 2; ++mt) {
#pragma unroll
        for (int i = 0; i < 16; ++i) st[mt][i] = 0.f;
#pragma unroll
        for (int ks = 0; ks < NKS; ++ks) {
          bf16x8 a;
          if (ks < 4) a = *(const bf16x8*)(sK + (mt * 32 + r) * LST + ks * 16 + 8 * hh);
          else a = *(const bf16x8*)(smem + L_KR + (mt * 32 + r) * 40 + (ks - 4) * 16 + 8 * hh);
          st[mt] = MFMA(a, qf[ks], st[mt]);
        }
      }
      float mloc = st[0][0];
#pragma unroll
      for (int i = 1; i < 16; ++i) mloc = fmaxf(mloc, st[0][i]);
#pragma unroll
      for (int i = 0; i < 16; ++i) mloc = fmaxf(mloc, st[1][i]);
      mloc = fmaxf(mloc, __shfl_xor(mloc, 32));
      const float mnew = fmaxf(m_run, mloc);
      const float alpha = exp2f(m_run - mnew);
      m_run = mnew;
      float ps = 0.f;
#pragma unroll
      for (int mt = 0; mt < 2; ++mt)
#pragma unroll
        for (int i = 0; i < 16; ++i) { const float e = exp2f(st[mt][i] - mnew); st[mt][i] = e; ps += e; }
      l_run = l_run * alpha + ps;
#pragma unroll
      for (int d = 0; d < NDT; ++d)
#pragma unroll
        for (int i = 0; i < 16; ++i) O[d][i] *= alpha;
#pragma unroll
      for (int k2 = 0; k2 < 4; ++k2) {
        const bf16x8 pf = pack8(st[k2 >> 1], k2 & 1);
#pragma unroll
        for (int d = 0; d < NDT; ++d) {
          const bf16_t* vp = sV + (d * 32 + r) * LST + 16 * k2 + 4 * hh;
          const s16x4 lo = *(const s16x4*)vp;
          const s16x4 hi = *(const s16x4*)(vp + 8);
          const bf16x8 va = __builtin_shufflevector(lo, hi, 0, 1, 2, 3, 4, 5, 6, 7);
          O[d] = MFMA(va, pf, O[d]);
        }
      }
    }
    const float ltot = l_run + __shfl_xor(l_run, 32);
    const float linv = 1.f / ltot;
    const long orow = (long)(qrow0 + wq * 32 + r);
    if (MLA) {
#pragma unroll
      for (int d = 0; d < NDT; ++d)
#pragma unroll
        for (int g = 0; g < 4; ++g) {
          uint2 o = {pack2(O[d][4 * g] * linv, O[d][4 * g + 1] * linv), pack2(O[d][4 * g + 2] * linv, O[d][4 * g + 3] * linv)};
          *(uint2*)(OB + orow * 1024 + (hx * 2 + wp) * 64 + d * 32 + 8 * g + 4 * hh) = o;
        }
    } else {
      float* xs = (float*)smem;
      __syncthreads();
      if (wp == 1) {
#pragma unroll
        for (int d = 0; d < NDT; ++d)
#pragma unroll
          for (int i = 0; i < 16; ++i) xs[(wq * 64 + d * 16 + i) * 64 + lane] = O[d][i] * linv;
      }
      __syncthreads();
      if (wp == 0) {
        float ss = 0.f;
#pragma unroll
        for (int d = 0; d < NDT; ++d)
#pragma unroll
          for (int i = 0; i < 16; ++i) {
            const float o = O[d][i] * linv - lam * xs[(wq * 64 + d * 16 + i) * 64 + lane];
            O[d][i] = o; ss += o * o;
          }
        ss += __shfl_xor(ss, 32);
        const float rinv = rsqrtf(ss * (1.f / 128.f) + NORM_EPS) * (1.f - LAMBDA_INIT);
#pragma unroll
        for (int d = 0; d < NDT; ++d)
#pragma unroll
          for (int g = 0; g < 4; ++g) {
            const int dv = d * 32 + 8 * g + 4 * hh;
            const float4 gs4 = *(const float4*)(gsub + dv);
            uint2 o = {pack2(O[d][4 * g] * rinv * gs4.x, O[d][4 * g + 1] * rinv * gs4.y), pack2(O[d][4 * g + 2] * rinv * gs4.z, O[d][4 * g + 3] * rinv * gs4.w)};
            *(uint2*)(OB + orow * 1024 + hx * 128 + dv) = o;
          }
      }
    }
  }
}


#define XB_TMO      128
#define XB_XCNT(j)  (256  + 64 * (j))
#define XB_XSUB(j)  (1280 + 64 * (j))
#define XB_XGEN(j)  (2304 + 64 * (j))
#define XB_TOP      3328
#define XB_TOPGEN   3392
#define XCD_BAR_WORDS 3456
#define XB_SPIN_CAP (1u << 22)
#define LAS __attribute__((address_space(3)))
DI unsigned xb_ld(unsigned* p) { return __hip_atomic_load(p, __ATOMIC_RELAXED, __HIP_MEMORY_SCOPE_AGENT); }
DI unsigned xb_add(unsigned* p, unsigned v) { return __hip_atomic_fetch_add(p, v, __ATOMIC_RELAXED, __HIP_MEMORY_SCOPE_AGENT); }
DI unsigned xb_xcc_id() { return (unsigned)__builtin_amdgcn_s_getreg((3 << 11) | 20) & 0xFu; }
#define XB_SPIN(cond, bar) do { unsigned _sp = 0; while (cond) { __builtin_amdgcn_s_sleep(1); \
    if ((++_sp & 255u) == 0u) { if (xb_ld(&(bar)[XB_TMO])) break; if (_sp > XB_SPIN_CAP) { atomicAdd(&(bar)[XB_TMO], 1u); break; } } } } while (0)
struct XcdBarrier { unsigned* bar; unsigned x; volatile LAS unsigned* st; };
DI XcdBarrier xcd_barrier_post(unsigned* bar, volatile LAS unsigned* st) {
  XcdBarrier b; b.bar = bar; b.x = xb_xcc_id(); b.st = st;
  if (threadIdx.x == 0) (void)xb_add(&bar[XB_XCNT(b.x)], 1u);
  return b;
}
DI void xcd_barrier_complete(unsigned* bar, unsigned x, unsigned& nloc, unsigned& nx) {
  const unsigned G = gridDim.x * gridDim.y * gridDim.z;
  unsigned sum, cnt, mine, sp = 0u;
  for (;;) {
    sum = 0u; cnt = 0u; mine = 0u;
#pragma unroll
    for (unsigned j = 0; j < 16; ++j) { const unsigned c = xb_ld(&bar[XB_XCNT(j)]); sum += c; cnt += (c > 0u) ? 1u : 0u; mine = (j == x) ? c : mine; }
    if (sum == G) break;
    __builtin_amdgcn_s_sleep(1);
    if ((++sp & 255u) == 0u) { if (xb_ld(&bar[XB_TMO])) break; if (sp > XB_SPIN_CAP) { atomicAdd(&bar[XB_TMO], 1u); break; } }
  }
  nloc = mine > 0u ? mine : 1u; nx = cnt > 0u ? cnt : 1u;
}
DI void xcd_barrier(const XcdBarrier& b) {
  asm volatile("s_waitcnt vmcnt(0)" ::: "memory");
  __syncthreads();
  if (threadIdx.x == 0) {
    unsigned* bar = b.bar;
    __builtin_amdgcn_s_waitcnt(0);
    unsigned nloc = b.st[0], nx = b.st[1];
    if (nloc == 0u) { xcd_barrier_complete(bar, b.x, nloc, nx); b.st[0] = nloc; b.st[1] = nx; }
    const unsigned old = xb_add(&bar[XB_XSUB(b.x)], 1u);
    const unsigned gen = old / nloc;
    if (old + 1u == (gen + 1u) * nloc) {
      __builtin_amdgcn_fence(__ATOMIC_RELEASE, "agent");
      asm volatile("s_waitcnt vmcnt(0)" ::: "memory");
      const unsigned og = xb_add(&bar[XB_TOP], 1u);
      const unsigned tg = og / nx;
      if (og + 1u == (tg + 1u) * nx) xb_add(&bar[XB_TOPGEN], 1u);
      else XB_SPIN(xb_ld(&bar[XB_TOPGEN]) == tg, bar);
      __builtin_amdgcn_fence(__ATOMIC_ACQUIRE, "agent");
      xb_add(&bar[XB_XGEN(b.x)], 1u);
      asm volatile("s_waitcnt vmcnt(0)" ::: "memory");
    } else {
      XB_SPIN(xb_ld(&bar[XB_XGEN(b.x)]) == gen, bar);
      __builtin_amdgcn_fence(__ATOMIC_ACQUIRE, "agent");
      asm volatile("s_waitcnt vmcnt(0)" ::: "memory");
    }
  }
  __syncthreads();
}

constexpr int NPH = 35;
__global__ void __launch_bounds__(256, 2) mk_forward(P p) {
  __shared__ __attribute__((aligned(16))) unsigned char smem_raw[73728];
  cg::grid_group grid = cg::this_grid();
  __shared__ uint4 xb_words;
  if (threadIdx.x == 0) xb_words = make_uint4(0u, 0u, 0u, 0u);
  __syncthreads();
  XcdBarrier xb;
  xb.bar = (unsigned*)(p.ws + W_CTRL); xb.x = 0; xb.st = (volatile LAS unsigned*)&xb_words;
  if (p.hi - p.lo > 1) xb = xcd_barrier_post((unsigned*)(p.ws + W_CTRL), (volatile LAS unsigned*)&xb_words);
  bf16_t* smem = (bf16_t*)smem_raw;
  float* smf = (float*)smem_raw;
  unsigned char* big = p.ws + W_BIG;
  int ph = 0;
#ifdef PROBE_DUP_UP
#define PROBE_UP(l) __syncthreads(); phase_mlp_up(p, smem, l)
#else
#define PROBE_UP(l)
#endif
#ifdef PROBE_DUP_ATTN
#define PROBE_AT(m) __syncthreads(); phase_attn<m>(p, smem)
#else
#define PROBE_AT(m)
#endif
#ifndef ONLY_PH
#define ONLY_PH -1
#endif
#define PH(...) { if ((ONLY_PH < 0 || ph == ONLY_PH) && ph >= p.lo && ph < p.hi) { __VA_ARGS__; } ++ph; if (ph > p.lo && ph < p.hi) { if (ph == 1) grid.sync(); else xcd_barrier(xb); } }
  PH(phase0(p, smf))
  PH(phase1(p))
  PH(phase_modulate<1>(p, 0, 0))
  PH(phase_s5a(p, smem))
  PH(phase_s5_carry(p))
  PH(phase_s5b(p, smem))
  PH(phase_glu(p, smem))
  PH(phase_modulate<0>(p, 0, 1))
  PH(phase_mlp_up(p, smem, 0); PROBE_UP(0))
  PH(phase_mlp_down(p, smem, 0))
  PH(phase_modulate<0>(p, 1, 0))
  PH(phase_qkv(p, smem))
  PH(phase_attn<false>(p, smem); PROBE_AT(false))
  PH(phase_proj_resid(p, smem, (const bf16_t*)(big + B_OB), 1024, (const bf16_t*)(p.ws + W_DWO), 1))
  PH(phase_modulate<0>(p, 1, 1))
  PH(phase_mlp_up(p, smem, 1); PROBE_UP(1))
  PH(phase_mlp_down(p, smem, 1))
  PH(phase_modulate<0>(p, 2, 0))
  PH(phase_mla_down(p, smem))
  PH(phase_mla_norm(p))
  PH(phase_mla_up(p, smem))
  PH(phase_attn<true>(p, smem); PROBE_AT(true))
  PH(phase_proj_resid(p, smem, (const bf16_t*)(big + B_OBM), 1024, (const bf16_t*)(p.ws + W_MWO), 2))
  PH(phase_modulate<0>(p, 2, 1))
  PH(phase_mlp_up(p, smem, 2); PROBE_UP(2))
  PH(phase_mlp_down(p, smem, 2))
  PH(phase_modulate<0>(p, 3, 0))
  PH(phase_sgu_in(p, smem))
  PH(phase_sgu_norm(p, smf))
  PH(phase_sgu_spatial(p, smem))
  PH(phase_proj_resid(p, smem, (const bf16_t*)(big + B_G), 2048, (const bf16_t*)(p.ws + W_SOUT), 3))
  PH(phase_modulate<0>(p, 3, 1))
  PH(phase_mlp_up(p, smem, 3); PROBE_UP(3))
  PH(phase_mlp_down(p, smem, 3))
  PH(phase_final_norm(p))
#undef PH
}

extern "C" void kernel_launch(void* const* d_in, const int* in_sizes, int n_in, void* d_out, int out_size, void* d_ws, size_t ws_size,
                              hipStream_t stream) {
  static int grid_blocks = 0;
  if (!grid_blocks) {
    int dev = 0, cus = 0, per_cu = 0;
    hipGetDevice(&dev);
    hipDeviceGetAttribute(&cus, hipDeviceAttributeMultiprocessorCount, dev);
    hipOccupancyMaxActiveBlocksPerMultiprocessor(&per_cu, mk_forward, 256, 0);
    if (per_cu < 1) per_cu = 1;
    if (per_cu > 2) per_cu = 2;
    grid_blocks = cus * per_cu;
    if (ws_size < WS_NEED) fprintf(stderr, "kernel_launch: workspace too small: %zu < %zu\n", ws_size, (size_t)WS_NEED);
  }
  P p{};
  for (int i = 0; i < 47; ++i) p.in[i] = (const float*)d_in[i];
  p.out = (float*)d_out;
  p.ws = (unsigned char*)d_ws;
#if MK_SINGLE
  (void)hipMemsetAsync(d_ws, 0, 16384, stream);
  p.lo = 0; p.hi = NPH;
  void* args[] = {&p};
  hipError_t e = hipLaunchCooperativeKernel((void*)mk_forward, dim3(grid_blocks), dim3(256), args, 0, stream);
  if (e != hipSuccess) fprintf(stderr, "cooperative launch failed: %s (grid %d)\n", hipGetErrorString(e), grid_blocks);
#else
  for (int ph = 0; ph < NPH; ++ph) {
    p.lo = ph; p.hi = ph + 1;
    hipLaunchKernelGGL(mk_forward, dim3(grid_blocks), dim3(256), 0, stream, p);
  }
#endif
}
```

```cpp
#include <hip/hip_runtime.h>
#include <hip/hip_cooperative_groups.h>
#include <stdint.h>
#include <stdio.h>
namespace cg = cooperative_groups;

#ifndef MK_SINGLE
#define MK_SINGLE 1
#endif

typedef unsigned short bf16_t;
typedef __attribute__((ext_vector_type(8))) short bf16x8;
typedef __attribute__((ext_vector_type(4))) short s16x4;
typedef __attribute__((ext_vector_type(4))) unsigned u32x4;
typedef __attribute__((ext_vector_type(16))) float f32x16;
typedef __bf16 bf2_t __attribute__((ext_vector_type(2)));
typedef float fl2_t __attribute__((ext_vector_type(2)));
#define DI __device__ __forceinline__
#define MFMA(a, b, c) __builtin_amdgcn_mfma_f32_32x32x16_bf16((a), (b), (c), 0, 0, 0)

constexpr int NTP = 32768, NTS = 1024, NT = 33792;
constexpr int SLK = 4160;
constexpr int KROWS = 99328;
constexpr float NORM_EPS = 1e-6f;
constexpr float LAMBDA_INIT = 0.35550906759096933f;
constexpr float L2E = 1.4426950408889634f;

constexpr size_t O_S5RP = (size_t)NT * 1024, O_S5IP = O_S5RP + 16384, O_S5RS = O_S5IP + 16384, O_S5IS = O_S5RS + 65536,
                 O_DKP = O_S5IS + 65536, O_DVP = O_DKP + (size_t)NTP * 1024, O_DKS = O_DVP + (size_t)NTP * 1024,
                 O_DVS = O_DKS + (size_t)NTS * 1024, O_CKP = O_DVS + (size_t)NTS * 1024, O_KRP = O_CKP + (size_t)NTP * 128,
                 O_CKS = O_KRP + (size_t)NTP * 32, O_KRS = O_CKS + (size_t)NTS * 128, O_SGV = O_KRS + (size_t)NTS * 32;

constexpr size_t W_CTRL = 0;
constexpr size_t W_LAM = 16384;
constexpr size_t W_MODP = W_LAM + 256;
constexpr size_t W_MOD = W_MODP + 8ull * 20 * 24576 * 4;
constexpr size_t W_AP = W_MOD + 20ull * 24576 * 4;
constexpr size_t W_BBAR = W_AP + 64ull * 65 * 64 * 8;
constexpr size_t W_E = W_BBAR + 64ull * 64 * 16 * 8;
constexpr size_t W_CH = W_E + 64ull * 16 * 2048 * 2;
constexpr size_t W_MEND = W_CH + 64ull * 1024 * 128 * 2;
constexpr size_t W_WS1 = W_MEND + 64ull * 128 * 1024 * 2;
constexpr size_t W_WS2 = W_WS1 + 8ull * 128 * 128 * 2;
constexpr size_t W_WUP = W_WS2 + 8ull * 128 * 128 * 2;
constexpr size_t W_WDN = W_WUP + 4ull * 4096 * 1024 * 2;
constexpr size_t W_GLU = W_WDN + 4ull * 4096 * 1024 * 2;
constexpr size_t W_QKV = W_GLU + 2048ull * 1024 * 2;
constexpr size_t W_DWO = W_QKV + 3072ull * 1024 * 2;
constexpr size_t W_MD = W_DWO + 1024ull * 1024 * 2;
constexpr size_t W_MUQ = W_MD + 512ull * 1024 * 2;
constexpr size_t W_MUKV = W_MUQ + 1536ull * 256 * 2;
constexpr size_t W_MWO = W_MUKV + 2048ull * 128 * 2;
constexpr size_t W_SIN = W_MWO + 1024ull * 1024 * 2;
constexpr size_t W_SOUT = W_SIN + 4096ull * 1024 * 2;
constexpr size_t W_H = W_SOUT + 1024ull * 2048 * 2;
constexpr size_t W_BIG = W_H + (size_t)NT * 1024 * 2;
constexpr size_t B_HG = 0, B_SLOC = 94371840ull, B_Z = 115343360ull;
constexpr size_t B_ACT = 0;
constexpr size_t B_QB = 0, B_KB = 69206016ull, B_VTD = 272629760ull, B_OB = 476053504ull;
constexpr size_t B_RAW = 0, B_CQ = 51904512ull, B_OBM = 0, B_CKV = 69206016ull, B_KR = 94633984ull, B_QM = 100990976ull,
                 B_KN = 204800000ull, B_VTM = 408223744ull;
constexpr size_t B_U = 0, B_VRAW = 138412032ull, B_VTS = 276824064ull, B_G = 415236096ull;
constexpr size_t WS_NEED = W_BIG + 611647488ull;

struct P {
  const float* in[47];
  float* out;
  unsigned char* ws;
  int lo, hi;
};

DI unsigned pack2(float a, float b) {
  fl2_t f = {a, b};
  bf2_t r = __builtin_convertvector(f, bf2_t);
  return __builtin_bit_cast(unsigned, r);
}
DI bf16_t f2bf(float a) { return (bf16_t)(pack2(a, 0.f) & 0xffffu); }
DI float bf2f(bf16_t v) { return __uint_as_float(((unsigned)v) << 16); }
DI float gelu_t(float x) {
  float u = 0.7978845608028654f * (x + 0.044715f * x * x * x);
  float t = 1.f - 2.f / (__expf(2.f * u) + 1.f);
  return 0.5f * x * (1.f + t);
}
DI float sigmoid_f(float x) { return 1.f / (1.f + __expf(-x)); }
DI int batch_of(int row) { return row < NTP ? (row >> 13) : 4 + ((row - NTP) >> 6); }
DI int pos_of(int row) { return row < NTP ? (row & 8191) : 4096 + ((row - NTP) & 63); }
DI int krow_of(int row) { return row < NTP ? row : NTP + ((row - NTP) >> 6) * SLK + 4096 + ((row - NTP) & 63); }
DI void rope_cs(int pos, float invf, float& c, float& s) {
  double t = (double)pos * (double)invf * 0.15915494309189535;
  t -= __builtin_rint(t);
  float ft = (float)t;
  c = __builtin_amdgcn_cosf(ft);
  s = __builtin_amdgcn_sinf(ft);
}
DI float wave_sum(float v) {
#pragma unroll
  for (int o = 32; o > 0; o >>= 1) v += __shfl_xor(v, o);
  return v;
}

constexpr int LST = 72;
template <class AF, class BF, class EPI>
DI void gemm_tile(bf16_t* smem, AF af, BF bf, int nkt, EPI epi) {
  const int tid = threadIdx.x, lane = tid & 63, wave = tid >> 6;
  const int wm = wave >> 1, wn = wave & 1, r = lane & 31, h = lane >> 5;
  bf16_t* sA = smem;
  bf16_t* sB = smem + 2 * 128 * LST;
  f32x16 acc[2][2];
#pragma unroll
  for (int a = 0; a < 2; ++a)
#pragma unroll
    for (int b = 0; b < 2; ++b)
#pragma unroll
      for (int i = 0; i < 16; ++i) acc[a][b][i] = 0.f;
  const int lr = tid >> 3, lc = (tid & 7) * 8;
  uint4 ra[4], rb[4];
#pragma unroll
  for (int i = 0; i < 4; ++i) {
    ra[i] = *(const uint4*)(af(lr + 32 * i, 0) + lc);
    rb[i] = *(const uint4*)(bf(lr + 32 * i, 0) + lc);
  }
#pragma unroll
  for (int i = 0; i < 4; ++i) {
    *(uint4*)(sA + (lr + 32 * i) * LST + lc) = ra[i];
    *(uint4*)(sB + (lr + 32 * i) * LST + lc) = rb[i];
  }
  __syncthreads();
  for (int kt = 0; kt < nkt; ++kt) {
    const bool more = (kt + 1 < nkt);
    if (more) {
#pragma unroll
      for (int i = 0; i < 4; ++i) {
        ra[i] = *(const uint4*)(af(lr + 32 * i, kt + 1) + lc);
        rb[i] = *(const uint4*)(bf(lr + 32 * i, kt + 1) + lc);
      }
    }
    const bf16_t* pa = sA + (kt & 1) * 128 * LST + (wm * 64 + r) * LST + h * 8;
    const bf16_t* pb = sB + (kt & 1) * 128 * LST + (wn * 64 + r) * LST + h * 8;
#pragma unroll
    for (int ks = 0; ks < 4; ++ks) {
      bf16x8 a0 = *(const bf16x8*)(pa + ks * 16);
      bf16x8 a1 = *(const bf16x8*)(pa + 32 * LST + ks * 16);
      bf16x8 b0 = *(const bf16x8*)(pb + ks * 16);
      bf16x8 b1 = *(const bf16x8*)(pb + 32 * LST + ks * 16);
      acc[0][0] = MFMA(a0, b0, acc[0][0]);
      acc[0][1] = MFMA(a0, b1, acc[0][1]);
      acc[1][0] = MFMA(a1, b0, acc[1][0]);
      acc[1][1] = MFMA(a1, b1, acc[1][1]);
    }
    if (more) {
      const int nb = ((kt + 1) & 1) * 128 * LST;
#pragma unroll
      for (int i = 0; i < 4; ++i) {
        *(uint4*)(sA + nb + (lr + 32 * i) * LST + lc) = ra[i];
        *(uint4*)(sB + nb + (lr + 32 * i) * LST + lc) = rb[i];
      }
    }
    __syncthreads();
  }
#pragma unroll
  for (int mi = 0; mi < 2; ++mi)
#pragma unroll
    for (int g = 0; g < 4; ++g) {
      float4 v0 = {acc[mi][0][4 * g], acc[mi][0][4 * g + 1], acc[mi][0][4 * g + 2], acc[mi][0][4 * g + 3]};
      float4 v1 = {acc[mi][1][4 * g], acc[mi][1][4 * g + 1], acc[mi][1][4 * g + 2], acc[mi][1][4 * g + 3]};
      epi(wm * 64 + mi * 32 + 8 * g + 4 * h, wn * 64 + r, v0, v1);
      __builtin_amdgcn_sched_barrier(0);
    }
}


template <class AF, class BF, class EPI>
DI void gemm_tile256(bf16_t* smem, AF af, BF bf, int nkt, EPI epi) {
  const int tid = threadIdx.x, lane = tid & 63, wave = tid >> 6;
  const int wm = wave >> 1, wn = wave & 1, r = lane & 31, h = lane >> 5;
  bf16_t* sA = smem;
  bf16_t* sB = smem + 256 * LST;
  f32x16 acc[4][2];
#pragma unroll
  for (int a = 0; a < 4; ++a)
#pragma unroll
    for (int b = 0; b < 2; ++b)
#pragma unroll
      for (int i = 0; i < 16; ++i) acc[a][b][i] = 0.f;
  const int lr = tid >> 3, lc = (tid & 7) * 8;
  u32x4 rg[12];
#pragma unroll
  for (int i = 0; i < 8; ++i) rg[i] = *(const u32x4*)(af(lr + 32 * i, 0) + lc);
#pragma unroll
  for (int i = 0; i < 4; ++i) rg[8 + i] = *(const u32x4*)(bf(lr + 32 * i, 0) + lc);
  for (int kt = 0; kt < nkt; ++kt) {
    __syncthreads();
#pragma unroll
    for (int i = 0; i < 8; ++i) *(u32x4*)(sA + (lr + 32 * i) * LST + lc) = rg[i];
#pragma unroll
    for (int i = 0; i < 4; ++i) *(u32x4*)(sB + (lr + 32 * i) * LST + lc) = rg[8 + i];
    __syncthreads();
    if (kt + 1 < nkt) {
#pragma unroll
      for (int i = 0; i < 8; ++i) rg[i] = *(const u32x4*)(af(lr + 32 * i, kt + 1) + lc);
#pragma unroll
      for (int i = 0; i < 4; ++i) rg[8 + i] = *(const u32x4*)(bf(lr + 32 * i, kt + 1) + lc);
    }
    const bf16_t* pa = sA + (wm * 128 + r) * LST + h * 8;
    const bf16_t* pb = sB + (wn * 64 + r) * LST + h * 8;
#pragma unroll
    for (int ks = 0; ks < 4; ++ks) {
      const bf16x8 b0 = *(const bf16x8*)(pb + ks * 16);
      const bf16x8 b1 = *(const bf16x8*)(pb + 32 * LST + ks * 16);
#pragma unroll
      for (int mi = 0; mi < 4; ++mi) {
        const bf16x8 a = *(const bf16x8*)(pa + mi * 32 * LST + ks * 16);
        acc[mi][0] = MFMA(a, b0, acc[mi][0]);
        acc[mi][1] = MFMA(a, b1, acc[mi][1]);
      }
    }
  }
  __syncthreads();
#pragma unroll
  for (int mi = 0; mi < 4; ++mi)
#pragma unroll
    for (int g = 0; g < 4; ++g) {
      float4 v0 = {acc[mi][0][4 * g], acc[mi][0][4 * g + 1], acc[mi][0][4 * g + 2], acc[mi][0][4 * g + 3]};
      float4 v1 = {acc[mi][1][4 * g], acc[mi][1][4 * g + 1], acc[mi][1][4 * g + 2], acc[mi][1][4 * g + 3]};
      epi(wm * 128 + mi * 32 + 8 * g + 4 * h, wn * 64 + r, v0, v1);
      __builtin_amdgcn_sched_barrier(0);
    }
}

template <bool SPLIT, class EPI>
DI void run_gemm256(bf16_t* smem, const bf16_t* A, int lda, const bf16_t* B, int ldb, int mtiles, int ntiles, int nkt, EPI epi) {
  const int T = mtiles * ntiles, G = gridDim.x;
  int full = T, S = 1;
  if (SPLIT) {
    const int R = T % G;
    if (R > 0) {
      full = T - R;
      S = 16;
      while (S > 1 && (S * R > G || S > nkt)) S >>= 1;
    }
  }
  const int items = full + (T - full) * S;
  for (int it = blockIdx.x; it < items; it += G) {
    int t = it, k0 = 0, nk = nkt; bool part = false;
    if (it >= full) { const int j = it - full; t = full + j / S; nk = nkt / S; k0 = (j % S) * nk; part = (S > 1); }
    const int mt = t / ntiles, nt = t % ntiles;
    const bf16_t* a0 = A + (long)mt * 256 * lda + k0 * 64;
    const bf16_t* b0 = B + (long)nt * 128 * ldb + k0 * 64;
    gemm_tile256(smem, [=](int r, int kt) { return a0 + (long)r * lda + kt * 64; }, [=](int r, int kt) { return b0 + (long)r * ldb + kt * 64; }, nk,
                 [=](int row0, int col, float4 v0, float4 v1) { epi(mt * 256 + row0, nt * 128 + col, v0, v1, part); });
  }
}

DI float f4get(const float4& v, int j) { return j == 0 ? v.x : (j == 1 ? v.y : (j == 2 ? v.z : v.w)); }

template <class F>
DI void prep_w(bf16_t* dst, int K, int N, int ld, F colsrc) {
  const long total = (long)N * (K / 8);
  for (long idx = (long)blockIdx.x * 256 + threadIdx.x; idx < total; idx += (long)gridDim.x * 256) {
    const int n = (int)(idx % N);
    const int kg = (int)(idx / N);
    const float* s = colsrc(n);
    uint4 o = {0u, 0u, 0u, 0u};
    if (s) {
      s += (long)kg * 8 * ld;
      float v0 = s[0], v1 = s[(long)ld], v2 = s[2l * ld], v3 = s[3l * ld], v4 = s[4l * ld], v5 = s[5l * ld], v6 = s[6l * ld], v7 = s[7l * ld];
      o.x = pack2(v0, v1); o.y = pack2(v2, v3); o.z = pack2(v4, v5); o.w = pack2(v6, v7);
    }
    *(uint4*)(dst + (long)n * K + kg * 8) = o;
  }
}

DI void phase0(const P& p, float* smf) {
  unsigned char* ws = p.ws;
  const int gt = blockIdx.x * 256 + threadIdx.x, gs = gridDim.x * 256;
  {
    float* modp = (float*)(ws + W_MODP);
    for (int it = blockIdx.x; it < 768; it += gridDim.x) {
      const int kc = it / 96, ch = it % 96;
      __syncthreads();
      for (int e = threadIdx.x; e < 20 * 128; e += 256) {
        const int m = e >> 7, k = e & 127;
        const float c = (m < 4) ? p.in[2][m * 1024 + kc * 128 + k] : p.in[3][(m - 4) * 1024 + kc * 128 + k];
        smf[k * 20 + m] = c / (1.f + __expf(-c));
      }
      __syncthreads();
      const int n = ch * 256 + threadIdx.x;
      const int layer = n / 6144, col = n % 6144;
      const float* w = p.in[10] + ((long)(layer * 1024 + kc * 128)) * 6144 + col;
      float acc[20];
#pragma unroll
      for (int m = 0; m < 20; ++m) acc[m] = 0.f;
      for (int k = 0; k < 128; ++k) {
        const float wv = w[(long)k * 6144];
#pragma unroll
        for (int m = 0; m < 20; ++m) acc[m] += smf[k * 20 + m] * wv;
      }
#pragma unroll
      for (int m = 0; m < 20; ++m) modp[(long)(kc * 20 + m) * 24576 + n] = acc[m];
    }
  }
  {
    float2* ap = (float2*)(ws + W_AP);
    for (int idx = gt; idx < 64 * 65 * 64; idx += gs) {
      const int g = idx / (65 * 64), tau = (idx / 64) % 65, pp = idx & 63;
      const float dt = expf(p.in[24][g]);
      const float are = p.in[17][g * 64 + pp], aim = p.in[18][g * 64 + pp];
      const float mag = expf(are * dt * (float)tau);
      double t = (double)aim * (double)dt * (double)tau * 0.15915494309189535;
      t -= __builtin_rint(t);
      const float ft = (float)t;
      ap[idx] = make_float2(mag * __builtin_amdgcn_cosf(ft), mag * __builtin_amdgcn_sinf(ft));
    }
    float2* bb = (float2*)(ws + W_BBAR);
    for (int idx = gt; idx < 64 * 64 * 16; idx += gs) {
      const int g = idx / 1024, pp = (idx >> 4) & 63;
      const float dt = expf(p.in[24][g]);
      const float are = p.in[17][g * 64 + pp], aim = p.in[18][g * 64 + pp];
      const float mag = expf(are * dt);
      double t = (double)aim * (double)dt * 0.15915494309189535;
      t -= __builtin_rint(t);
      const float ft = (float)t;
      const float nr = mag * __builtin_amdgcn_cosf(ft) - 1.f, ni = mag * __builtin_amdgcn_sinf(ft);
      const float den = are * are + aim * aim;
      const float qr = (nr * are + ni * aim) / den, qi = (ni * are - nr * aim) / den;
      const float br = p.in[19][idx], bi = p.in[20][idx];
      bb[idx] = make_float2(qr * br - qi * bi, qr * bi + qi * br);
    }
  }
  if (gt == 0) {
    float s1 = 0.f, s2 = 0.f;
    for (int i = 0; i < 64; ++i) { s1 += p.in[28][i] * p.in[29][i]; s2 += p.in[30][i] * p.in[31][i]; }
    *(float*)(ws + W_LAM) = expf(s1) - expf(s2) + LAMBDA_INIT;
  }
  {
    bf16_t* w1 = (bf16_t*)(ws + W_WS1);
    bf16_t* w2 = (bf16_t*)(ws + W_WS2);
    const float* wsrc = p.in[44];
    for (int idx = gt; idx < 8 * 128 * 128; idx += gs) {
      const int g = idx >> 14, t = (idx >> 7) & 127, s = idx & 127;
      w1[idx] = f2bf(s <= t ? wsrc[idx] : 0.f);
      const int tt = t & 63, ss = s & 63;
      w2[idx] = f2bf(((t >> 6) == (s >> 6) && ss <= tt) ? wsrc[(g * 128 + tt) * 128 + ss] : 0.f);
    }
  }
  for (int l = 0; l < 4; ++l) {
    const float* up = p.in[14] + (long)l * 1024 * 4096;
    prep_w((bf16_t*)(ws + W_WUP) + (long)l * 4096 * 1024, 1024, 4096, 4096, [=](int n) { return up + n; });
    const float* dn = p.in[15] + (long)l * 4096 * 1024;
    prep_w((bf16_t*)(ws + W_WDN) + (long)l * 1024 * 4096, 4096, 1024, 1024, [=](int n) { return dn + n; });
  }
  {
    const float* ga = p.in[25]; const float* gb = p.in[26];
    prep_w((bf16_t*)(ws + W_GLU), 1024, 2048, 1024, [=](int n) { const int sp = n >> 6, w = n & 63; return ((w < 32) ? ga : gb) + sp * 32 + (w & 31); });
    const float* s = p.in[27];
    prep_w((bf16_t*)(ws + W_QKV), 1024, 3072, 3072, [=](int n) { return s + n; });
    const float* s2 = p.in[33];
    prep_w((bf16_t*)(ws + W_DWO), 1024, 1024, 1024, [=](int n) { return s2 + n; });
    const float* dq = p.in[34];
    prep_w((bf16_t*)(ws + W_MD), 1024, 256, 256, [=](int n) { return dq + n; });
    const float* dkv = p.in[37];
    prep_w((bf16_t*)(ws + W_MD) + 256 * 1024, 1024, 256, 160, [=](int n) -> const float* {
      if (n < 128) return dkv + n;
      const int w = n - 128;
      if (w < 16) return dkv + 128 + w;
      if (w >= 32 && w < 48) return dkv + 144 + (w - 32);
      return nullptr;
    });
    const float* uq = p.in[36];
    prep_w((bf16_t*)(ws + W_MUQ), 256, 1536, 1536, [=](int n) {
      if (n < 1024) return uq + (n >> 6) * 96 + (n & 63);
      const int sp = (n - 1024) >> 6, w = (n - 1024) & 63, half = w >> 5, ix = w & 31;
      const int head = sp * 2 + (ix >> 4), i = ix & 15;
      return uq + head * 96 + 64 + half * 16 + i;
    });
    const float* uk = p.in[39]; const float* uv = p.in[40];
    prep_w((bf16_t*)(ws + W_MUKV), 128, 2048, 1024, [=](int n) { return n < 1024 ? uk + n : uv + (n - 1024); });
    const float* mwo = p.in[41];
    prep_w((bf16_t*)(ws + W_MWO), 1024, 1024, 1024, [=](int n) { return mwo + n; });
    const float* sin_ = p.in[42];
    prep_w((bf16_t*)(ws + W_SIN), 1024, 4096, 4096, [=](int n) { return sin_ + n; });
    const float* sout = p.in[46];
    prep_w((bf16_t*)(ws + W_SOUT), 2048, 1024, 1024, [=](int n) { return sout + n; });
  }
}

DI void phase1(const P& p) {
  unsigned char* ws = p.ws;
  const int gt = blockIdx.x * 256 + threadIdx.x, gs = gridDim.x * 256;
  {
    const float* modp = (const float*)(ws + W_MODP);
    float* mod = (float*)(ws + W_MOD);
    for (int idx = gt; idx < 20 * 24576; idx += gs) {
      const int n = idx % 24576;
      float s = p.in[11][n];
#pragma unroll
      for (int kc = 0; kc < 8; ++kc) s += modp[(long)kc * 20 * 24576 + idx];
      mod[idx] = s;
    }
  }
  const float2* ap = (const float2*)(ws + W_AP);
  const float2* bb = (const float2*)(ws + W_BBAR);
  const float* cre = p.in[21]; const float* cim = p.in[22];
  {
    bf16_t* E = (bf16_t*)(ws + W_E);
    for (int idx = gt; idx < 64 * 16 * 2048; idx += gs) {
      const int g = idx >> 15, co = (idx >> 11) & 15, j = idx & 2047;
      float v = 0.f;
      if (j < 1024) {
        const int tau = 63 - (j >> 4), ci = j & 15;
        for (int pp = 0; pp < 64; ++pp) {
          const float2 a = ap[(g * 65 + tau) * 64 + pp];
          const float2 b = bb[(g * 64 + pp) * 16 + ci];
          const float cr = cre[(g * 16 + co) * 64 + pp], cimv = cim[(g * 16 + co) * 64 + pp];
          const float abr = a.x * b.x - a.y * b.y, abi = a.x * b.y + a.y * b.x;
          v += cr * abr - cimv * abi;
        }
        if (tau == 0 && co == ci) v += p.in[23][g * 16 + co];
      }
      E[idx] = f2bf(v);
    }
    bf16_t* CH = (bf16_t*)(ws + W_CH);
    for (int idx = gt; idx < 64 * 1024 * 128; idx += gs) {
      const int g = idx >> 17, m = (idx >> 7) & 1023, q = idx & 127;
      const int t = m >> 4, co = m & 15, pp = q & 63;
      const float2 a = ap[(g * 65 + t + 1) * 64 + pp];
      const float cr = cre[(g * 16 + co) * 64 + pp], cimv = cim[(g * 16 + co) * 64 + pp];
      const float zr = cr * a.x - cimv * a.y, zi = cr * a.y + cimv * a.x;
      CH[idx] = f2bf(q < 64 ? zr : -zi);
    }
    bf16_t* ME = (bf16_t*)(ws + W_MEND);
    for (int idx = gt; idx < 64 * 128 * 1024; idx += gs) {
      const int g = idx >> 17, q = (idx >> 10) & 127, k = idx & 1023;
      const int s = k >> 4, c = k & 15, pp = q & 63;
      const float2 a = ap[(g * 65 + 63 - s) * 64 + pp];
      const float2 b = bb[(g * 64 + pp) * 16 + c];
      ME[idx] = f2bf(q < 64 ? (a.x * b.x - a.y * b.y) : (a.x * b.y + a.y * b.x));
    }
  }
}

template <int MODE>
DI void phase_modulate(const P& p, int layer, int which) {
  unsigned char* ws = p.ws;
  const float* mod = (const float*)(ws + W_MOD);
  const float* gam = (which == 0 ? p.in[12] : p.in[13]) + layer * 1024;
  const int lane = threadIdx.x & 63;
  const int wv = blockIdx.x * 4 + (threadIdx.x >> 6), nwv = gridDim.x * 4;
  bf16_t* H = (bf16_t*)(ws + W_H);
  bf16_t* HG = (bf16_t*)(ws + W_BIG + B_HG);
  for (int row = wv; row < NT; row += nwv) {
    const float* x = (MODE == 1) ? (row < NTP ? p.in[0] + (long)row * 1024 : p.in[1] + (long)(row - NTP) * 1024) : p.out + (long)row * 1024;
    float4 v[4];
    float ss = 0.f;
#pragma unroll
    for (int i = 0; i < 4; ++i) {
      v[i] = *(const float4*)(x + lane * 4 + 256 * i);
      ss += v[i].x * v[i].x + v[i].y * v[i].y + v[i].z * v[i].z + v[i].w * v[i].w;
    }
    ss = wave_sum(ss);
    const float rinv = rsqrtf(ss * (1.f / 1024.f) + NORM_EPS);
    const int b = batch_of(row);
    const float* sh = mod + (long)b * 24576 + layer * 6144 + (which * 3) * 1024;
    const float* sc = sh + 1024;
#pragma unroll
    for (int i = 0; i < 4; ++i) {
      const int col = lane * 4 + 256 * i;
      const float4 g4 = *(const float4*)(gam + col), sh4 = *(const float4*)(sh + col), sc4 = *(const float4*)(sc + col);
      const float h0 = v[i].x * rinv * g4.x * (1.f + sc4.x) + sh4.x;
      const float h1 = v[i].y * rinv * g4.y * (1.f + sc4.y) + sh4.y;
      const float h2 = v[i].z * rinv * g4.z * (1.f + sc4.z) + sh4.z;
      const float h3 = v[i].w * rinv * g4.w * (1.f + sc4.w) + sh4.w;
      uint2 o = {pack2(h0, h1), pack2(h2, h3)};
      if (MODE == 1) {
        *(float4*)(p.out + (long)row * 1024 + col) = v[i];
        const int g = col >> 4, c = col & 15, n = row >> 6, s = row & 63;
        *(uint2*)(HG + ((long)(g * 640 + n)) * 1152 + s * 16 + c) = o;
      } else {
        *(uint2*)(H + (long)row * 1024 + col) = o;
      }
    }
  }
}

DI void phase_s5_carry(const P& p) {
  unsigned char* ws = p.ws;
  const float2* ap = (const float2*)(ws + W_AP);
  const float* sloc = (const float*)(ws + W_BIG + B_SLOC);
  bf16_t* HG = (bf16_t*)(ws + W_BIG + B_HG);
  const int gt = blockIdx.x * 256 + threadIdx.x, gs = gridDim.x * 256;
  for (int idx = gt; idx < 64 * 20 * 64; idx += gs) {
    const int g = idx / 1280, bb = (idx >> 6) % 20, pp = idx & 63;
    const float2 a = ap[(g * 65 + 64) * 64 + pp];
    if (bb < 4) {
      float hr = 0.f, hi = 0.f;
#pragma unroll 8
      for (int k = 0; k < 128; ++k) {
        const long n = (long)g * 640 + bb * 128 + k;
        HG[n * 1152 + 1024 + pp] = f2bf(hr);
        HG[n * 1152 + 1088 + pp] = f2bf(hi);
        const float sr = sloc[n * 128 + pp], si = sloc[n * 128 + 64 + pp];
        const float nr = a.x * hr - a.y * hi + sr, ni = a.x * hi + a.y * hr + si;
        hr = nr; hi = ni;
      }
      p.out[O_S5RP + (bb * 64 + g) * 64 + pp] = hr;
      p.out[O_S5IP + (bb * 64 + g) * 64 + pp] = hi;
    } else {
      const int b = bb - 4;
      const long n = (long)g * 640 + 512 + b;
      float hr = p.in[4][(b * 64 + g) * 64 + pp], hi = p.in[5][(b * 64 + g) * 64 + pp];
      HG[n * 1152 + 1024 + pp] = f2bf(hr);
      HG[n * 1152 + 1088 + pp] = f2bf(hi);
      const float sr = sloc[n * 128 + pp], si = sloc[n * 128 + 64 + pp];
      p.out[O_S5RS + (b * 64 + g) * 64 + pp] = a.x * hr - a.y * hi + sr;
      p.out[O_S5IS + (b * 64 + g) * 64 + pp] = a.x * hi + a.y * hr + si;
    }
  }
}

DI const float* mod_ptr(const P& p, int layer, int k) { return (const float*)(p.ws + W_MOD) + layer * 6144 + k * 1024; }

DI void phase_s5a(const P& p, bf16_t* smem) {
  const bf16_t* HG = (const bf16_t*)(p.ws + W_BIG + B_HG);
  const bf16_t* ME = (const bf16_t*)(p.ws + W_MEND);
  float* sloc = (float*)(p.ws + W_BIG + B_SLOC);
  for (int t = blockIdx.x; t < 64 * 5; t += gridDim.x) {
    const int g = t / 5, mi = t % 5;
    const bf16_t* a0 = HG + (long)(g * 640 + mi * 128) * 1152;
    const bf16_t* b0 = ME + (long)g * 128 * 1024;
    float* o = sloc + (long)(g * 640 + mi * 128) * 128;
    gemm_tile(smem, [=](int r, int kt) { return a0 + (long)r * 1152 + kt * 64; }, [=](int r, int kt) { return b0 + (long)r * 1024 + kt * 64; }, 16,
              [=](int row0, int col, float4 v0, float4 v1) {
#pragma unroll
                for (int j = 0; j < 4; ++j) {
                  o[(long)(row0 + j) * 128 + col] = f4get(v0, j);
                  o[(long)(row0 + j) * 128 + col + 32] = f4get(v1, j);
                }
              });
  }
}

DI void phase_s5b(const P& p, bf16_t* smem) {
  const bf16_t* HG = (const bf16_t*)(p.ws + W_BIG + B_HG);
  const bf16_t* E = (const bf16_t*)(p.ws + W_E);
  const bf16_t* CH = (const bf16_t*)(p.ws + W_CH);
  bf16_t* Z = (bf16_t*)(p.ws + W_BIG + B_Z);
  for (int t = blockIdx.x; t < 64 * 5 * 8; t += gridDim.x) {
    const int g = t / 40, mi = (t % 40) >> 3, j = 7 - (t & 7);
    const int nE = 2 * j + 2;
    const bf16_t* a0 = HG + (long)(g * 640 + mi * 128) * 1152;
    const bf16_t* e0 = E + (long)g * 16 * 2048;
    const bf16_t* c0 = CH + ((long)g * 1024 + j * 128) * 128;
    gemm_tile(smem,
              [=](int r, int kt) { const int k = kt < nE ? kt : 16 + kt - nE; return a0 + (long)r * 1152 + k * 64; },
              [=](int r, int kt) -> const bf16_t* {
                if (kt < nE) { const int tt = 8 * j + (r >> 4), co = r & 15; return e0 + co * 2048 + (63 - tt) * 16 + kt * 64; }
                return c0 + (long)r * 128 + (kt - nE) * 64;
              },
              nE + 2,
              [=](int row0, int col, float4 v0, float4 v1) {
#pragma unroll
                for (int q = 0; q < 4; ++q) {
                  const int n = mi * 128 + row0 + q;
                  if (n < 528) {
                    const int c0_ = col, c1_ = col + 32;
                    const long tok0 = (long)n * 64 + 8 * j + (c0_ >> 4), tok1 = (long)n * 64 + 8 * j + (c1_ >> 4);
                    Z[tok0 * 1024 + g * 16 + (c0_ & 15)] = f2bf(gelu_t(f4get(v0, q)));
                    Z[tok1 * 1024 + g * 16 + (c1_ & 15)] = f2bf(gelu_t(f4get(v1, q)));
                  }
                }
              });
  }
}

template <class EPI>
DI void run_gemm(bf16_t* smem, const bf16_t* A, int lda, const bf16_t* B, int ldb, int mtiles, int ntiles, int nkt, EPI epi) {
  for (int t = blockIdx.x; t < mtiles * ntiles; t += gridDim.x) {
    const int mt = t / ntiles, nt = t % ntiles;
    const bf16_t* a0 = A + (long)mt * 128 * lda;
    const bf16_t* b0 = B + (long)nt * 128 * ldb;
    gemm_tile(smem, [=](int r, int kt) { return a0 + (long)r * lda + kt * 64; }, [=](int r, int kt) { return b0 + (long)r * ldb + kt * 64; }, nkt,
              [=](int row0, int col, float4 v0, float4 v1) { epi(mt * 128 + row0, nt * 128 + col, v0, v1); });
  }
}

DI void resid_add(const P& p, const float* gate, int row0, int col, float4 v0, float4 v1, bool part) {
  const float* gb = gate + (long)batch_of(row0) * 24576;
  const float g0 = 1.f + gb[col], g1 = 1.f + gb[col + 32];
  if (part) {
#pragma unroll
    for (int j = 0; j < 4; ++j) {
      float* x = p.out + (long)(row0 + j) * 1024;
      atomicAdd(x + col, g0 * f4get(v0, j));
      atomicAdd(x + col + 32, g1 * f4get(v1, j));
    }
  } else {
#pragma unroll
    for (int j = 0; j < 4; ++j) {
      float* x = p.out + (long)(row0 + j) * 1024;
      x[col] += g0 * f4get(v0, j);
      x[col + 32] += g1 * f4get(v1, j);
    }
  }
}

DI void phase_glu(const P& p, bf16_t* smem) {
  const float* gate = mod_ptr(p, 0, 2);
  run_gemm256<false>(smem, (const bf16_t*)(p.ws + W_BIG + B_Z), 1024, (const bf16_t*)(p.ws + W_GLU), 1024, 132, 16, 16,
           [=](int row0, int col, float4 v0, float4 v1, bool) {
             const int oc = (col >> 6) * 32 + (col & 31);
             const float g0 = 1.f + gate[(long)batch_of(row0) * 24576 + oc];
#pragma unroll
             for (int j = 0; j < 4; ++j) {
               float* x = p.out + (long)(row0 + j) * 1024 + oc;
               *x += g0 * f4get(v0, j) * sigmoid_f(f4get(v1, j));
             }
           });
}

DI void phase_mlp_up(const P& p, bf16_t* smem, int layer) {
  bf16_t* act = (bf16_t*)(p.ws + W_BIG + B_ACT);
  run_gemm256<false>(smem, (const bf16_t*)(p.ws + W_H), 1024, (const bf16_t*)(p.ws + W_WUP) + (long)layer * 4096 * 1024, 1024, 132, 32, 16,
           [=](int row0, int col, float4 v0, float4 v1, bool) {
#pragma unroll
             for (int j = 0; j < 4; ++j) {
               const float a = fmaxf(f4get(v0, j), 0.f), b = fmaxf(f4get(v1, j), 0.f);
               act[(long)(row0 + j) * 4096 + col] = f2bf(a * a);
               act[(long)(row0 + j) * 4096 + col + 32] = f2bf(b * b);
             }
           });
}

DI void phase_mlp_down(const P& p, bf16_t* smem, int layer) {
  const float* gate = mod_ptr(p, layer, 5);
  run_gemm256<true>(smem, (const bf16_t*)(p.ws + W_BIG + B_ACT), 4096, (const bf16_t*)(p.ws + W_WDN) + (long)layer * 1024 * 4096, 4096, 132, 8, 64,
           [=](int row0, int col, float4 v0, float4 v1, bool part) { resid_add(p, gate, row0, col, v0, v1, part); });
}

DI void phase_proj_resid(const P& p, bf16_t* smem, const bf16_t* A, int K, const bf16_t* B, int layer) {
  const float* gate = mod_ptr(p, layer, 2);
  run_gemm256<true>(smem, A, K, B, K, 132, 8, K / 64, [=](int row0, int col, float4 v0, float4 v1, bool part) { resid_add(p, gate, row0, col, v0, v1, part); });
}

DI int vperm_key(int key) { const int q = (key >> 2) & 3; const int q2 = ((q & 1) << 1) | (q >> 1); return (key & ~15) | (q2 << 2); }
DI void store_t4(bf16_t* dst, float4 v) { *(uint2*)dst = make_uint2(pack2(v.x, v.y), pack2(v.z, v.w)); }

DI void phase_qkv(const P& p, bf16_t* smem) {
  unsigned char* big = p.ws + W_BIG;
  bf16_t* Qb = (bf16_t*)(big + B_QB);
  bf16_t* Kb = (bf16_t*)(big + B_KB);
  bf16_t* VT = (bf16_t*)(big + B_VTD);
  const float qscale = 0.125f * L2E;
  run_gemm(smem, (const bf16_t*)(p.ws + W_H), 1024, (const bf16_t*)(p.ws + W_QKV), 1024, 264, 24, 16,
           [=](int row0, int col, float4 v0, float4 v1) {
             const int region = col >> 10;
             if (region < 2) {
               const int d = col & 31;
               const float invf = exp2f(-(float)d * (13.287712379549449f / 32.f));
#pragma unroll
               for (int j = 0; j < 4; ++j) {
                 const int row = row0 + j;
                 float c, s;
                 rope_cs(pos_of(row), invf, c, s);
                 const float x1 = f4get(v0, j), x2 = f4get(v1, j);
                 const float o1 = x1 * c - x2 * s, o2 = x1 * s + x2 * c;
                 if (region == 0) {
                   Qb[(long)row * 1024 + col] = f2bf(o1 * qscale);
                   Qb[(long)row * 1024 + col + 32] = f2bf(o2 * qscale);
                 } else {
                   const int kc = col - 1024;
                   float* ko = (row < NTP) ? p.out + O_DKP + (long)row * 1024 : p.out + O_DKS + (long)(row - NTP) * 1024;
                   ko[kc] = o1; ko[kc + 32] = o2;
                   const long kr = krow_of(row);
                   Kb[kr * 1024 + kc] = f2bf(o1);
                   Kb[kr * 1024 + kc + 32] = f2bf(o2);
                 }
               }
             } else {
               const int vc = col - 2048;
#pragma unroll
               for (int j = 0; j < 4; ++j) {
                 const int row = row0 + j;
                 float* vo = (row < NTP) ? p.out + O_DVP + (long)row * 1024 : p.out + O_DVS + (long)(row - NTP) * 1024;
                 vo[vc] = f4get(v0, j); vo[vc + 32] = f4get(v1, j);
               }
               long base; int Lk, key;
               if (row0 < NTP) { const int b = row0 >> 13; key = row0 & 8191; Lk = 8192; base = (long)b * 1024 * 8192; }
               else { const int b = (row0 - NTP) >> 6; key = 4096 + ((row0 - NTP) & 63); Lk = SLK; base = 4l * 1024 * 8192 + (long)b * 1024 * SLK; }
               store_t4(VT + base + (long)vc * Lk + vperm_key(key), v0);
               store_t4(VT + base + (long)(vc + 32) * Lk + vperm_key(key), v1);
             }
           });
  {
    const float* ck = p.in[6]; const float* cv = p.in[7];
    const long gt = (long)blockIdx.x * 256 + threadIdx.x, gs = (long)gridDim.x * 256;
    for (long idx = gt; idx < 16l * 4096 * 128; idx += gs) {
      const long rowc = idx >> 7; const int c8 = (int)(idx & 127) * 8;
      const int b = (int)(rowc >> 12), jk = (int)(rowc & 4095);
      const float4 a = *(const float4*)(ck + rowc * 1024 + c8), bq = *(const float4*)(ck + rowc * 1024 + c8 + 4);
      uint4 o = {pack2(a.x, a.y), pack2(a.z, a.w), pack2(bq.x, bq.y), pack2(bq.z, bq.w)};
      *(uint4*)(Kb + ((long)NTP + (long)b * SLK + jk) * 1024 + c8) = o;
    }
    for (long idx = gt; idx < 16l * 512 * 1024; idx += gs) {
      const int hd = (int)(idx & 1023); const long t = idx >> 10;
      const int kg = (int)(t & 511), b = (int)(t >> 9);
      const float* src = cv + ((long)b * 4096 + kg * 8) * 1024 + hd;
      const float v0 = src[0], v1 = src[1024], v2 = src[2048], v3 = src[3072], v4 = src[4096], v5 = src[5120], v6 = src[6144], v7 = src[7168];
      bf16_t* vd = VT + 4l * 1024 * 8192 + (long)b * 1024 * SLK + (long)hd * SLK;
      *(uint2*)(vd + vperm_key(kg * 8)) = make_uint2(pack2(v0, v1), pack2(v2, v3));
      *(uint2*)(vd + vperm_key(kg * 8 + 4)) = make_uint2(pack2(v4, v5), pack2(v6, v7));
    }
  }
}

DI void phase_mla_down(const P& p, bf16_t* smem) {
  unsigned char* big = p.ws + W_BIG;
  float* raw = (float*)(big + B_RAW);
  bf16_t* KR = (bf16_t*)(big + B_KR);
  run_gemm(smem, (const bf16_t*)(p.ws + W_H), 1024, (const bf16_t*)(p.ws + W_MD), 1024, 264, 4, 16,
           [=](int row0, int col, float4 v0, float4 v1) {
             if (col < 384) {
#pragma unroll
               for (int j = 0; j < 4; ++j) {
                 raw[(long)(row0 + j) * 384 + col] = f4get(v0, j);
                 raw[(long)(row0 + j) * 384 + col + 32] = f4get(v1, j);
               }
             } else if (col < 400) {
               const int i = col - 384;
               const float invf = exp2f(-(float)i * (13.287712379549449f / 16.f));
#pragma unroll
               for (int j = 0; j < 4; ++j) {
                 const int row = row0 + j;
                 float c, s;
                 rope_cs(pos_of(row), invf, c, s);
                 const float x1 = f4get(v0, j), x2 = f4get(v1, j);
                 const float o1 = x1 * c - x2 * s, o2 = x1 * s + x2 * c;
                 float* ko = (row < NTP) ? p.out + O_KRP + (long)row * 32 : p.out + O_KRS + (long)(row - NTP) * 32;
                 ko[i] = o1; ko[16 + i] = o2;
                 const long kr = krow_of(row);
                 KR[kr * 32 + i] = f2bf(o1); KR[kr * 32 + 16 + i] = f2bf(o2);
               }
             }
           });
  {
    bf16_t* CKV = (bf16_t*)(big + B_CKV);
    const float* cc = p.in[8]; const float* cr = p.in[9];
    const long gt = (long)blockIdx.x * 256 + threadIdx.x, gs = (long)gridDim.x * 256;
    for (long idx = gt; idx < 16l * 4096 * 16; idx += gs) {
      const long rowc = idx >> 4; const int c8 = (int)(idx & 15) * 8;
      const int b = (int)(rowc >> 12), jk = (int)(rowc & 4095);
      const float4 a = *(const float4*)(cc + rowc * 128 + c8), bq = *(const float4*)(cc + rowc * 128 + c8 + 4);
      uint4 o = {pack2(a.x, a.y), pack2(a.z, a.w), pack2(bq.x, bq.y), pack2(bq.z, bq.w)};
      *(uint4*)(CKV + ((long)NTP + (long)b * SLK + jk) * 128 + c8) = o;
    }
    for (long idx = gt; idx < 16l * 4096 * 4; idx += gs) {
      const long rowc = idx >> 2; const int c8 = (int)(idx & 3) * 8;
      const int b = (int)(rowc >> 12), jk = (int)(rowc & 4095);
      const float4 a = *(const float4*)(cr + rowc * 32 + c8), bq = *(const float4*)(cr + rowc * 32 + c8 + 4);
      uint4 o = {pack2(a.x, a.y), pack2(a.z, a.w), pack2(bq.x, bq.y), pack2(bq.z, bq.w)};
      *(uint4*)(KR + ((long)NTP + (long)b * SLK + jk) * 32 + c8) = o;
    }
  }
}

DI void phase_mla_norm(const P& p) {
  unsigned char* big = p.ws + W_BIG;
  const float* raw = (const float*)(big + B_RAW);
  bf16_t* CQ = (bf16_t*)(big + B_CQ);
  bf16_t* CKV = (bf16_t*)(big + B_CKV);
  const int lane = threadIdx.x & 63;
  const int wv = blockIdx.x * 4 + (threadIdx.x >> 6), nwv = gridDim.x * 4;
  const float4 gq = *(const float4*)(p.in[35] + lane * 4);
  const float2 gk = *(const float2*)(p.in[38] + lane * 2);
  for (int row = wv; row < NT; row += nwv) {
    const float4 q = *(const float4*)(raw + (long)row * 384 + lane * 4);
    const float2 k = *(const float2*)(raw + (long)row * 384 + 256 + lane * 2);
    const float sq = wave_sum(q.x * q.x + q.y * q.y + q.z * q.z + q.w * q.w);
    const float sk = wave_sum(k.x * k.x + k.y * k.y);
    const float rq = rsqrtf(sq * (1.f / 256.f) + NORM_EPS), rk = rsqrtf(sk * (1.f / 128.f) + NORM_EPS);
    *(uint2*)(CQ + (long)row * 256 + lane * 4) = make_uint2(pack2(q.x * rq * gq.x, q.y * rq * gq.y), pack2(q.z * rq * gq.z, q.w * rq * gq.w));
    const float c0 = k.x * rk * gk.x, c1 = k.y * rk * gk.y;
    float* co = (row < NTP) ? p.out + O_CKP + (long)row * 128 : p.out + O_CKS + (long)(row - NTP) * 128;
    *(float2*)(co + lane * 2) = make_float2(c0, c1);
    *(unsigned*)(CKV + (long)krow_of(row) * 128 + lane * 2) = pack2(c0, c1);
  }
}

DI void phase_mla_up(const P& p, bf16_t* smem) {
  unsigned char* big = p.ws + W_BIG;
  bf16_t* QM = (bf16_t*)(big + B_QM);
  bf16_t* KN = (bf16_t*)(big + B_KN);
  bf16_t* VT = (bf16_t*)(big + B_VTM);
  const float qscale = 0.10206207261596577f * L2E;
  run_gemm(smem, (const bf16_t*)(big + B_CQ), 256, (const bf16_t*)(p.ws + W_MUQ), 256, 264, 12, 4,
           [=](int row0, int col, float4 v0, float4 v1) {
             if (col < 1024) {
               const int o = (col >> 6) * 96 + (col & 63);
#pragma unroll
               for (int j = 0; j < 4; ++j) {
                 QM[(long)(row0 + j) * 1536 + o] = f2bf(f4get(v0, j) * qscale);
                 QM[(long)(row0 + j) * 1536 + o + 32] = f2bf(f4get(v1, j) * qscale);
               }
             } else {
               const int sp = (col - 1024) >> 6, ix = col & 31;
               const int head = sp * 2 + (ix >> 4), i = ix & 15;
               const float invf = exp2f(-(float)i * (13.287712379549449f / 16.f));
#pragma unroll
               for (int j = 0; j < 4; ++j) {
                 const int row = row0 + j;
                 float c, s;
                 rope_cs(pos_of(row), invf, c, s);
                 const float x1 = f4get(v0, j), x2 = f4get(v1, j);
                 QM[(long)row * 1536 + head * 96 + 64 + i] = f2bf((x1 * c - x2 * s) * qscale);
                 QM[(long)row * 1536 + head * 96 + 80 + i] = f2bf((x1 * s + x2 * c) * qscale);
               }
             }
           });
  run_gemm(smem, (const bf16_t*)(big + B_CKV), 128, (const bf16_t*)(p.ws + W_MUKV), 128, 776, 16, 2,
           [=](int row0, int col, float4 v0, float4 v1) {
             if (col < 1024) {
#pragma unroll
               for (int j = 0; j < 4; ++j) {
                 KN[(long)(row0 + j) * 1024 + col] = f2bf(f4get(v0, j));
                 KN[(long)(row0 + j) * 1024 + col + 32] = f2bf(f4get(v1, j));
               }
             } else {
               const int vc = col - 1024;
               long base; int Lk, key;
               if (row0 < NTP) { const int b = row0 >> 13; key = row0 & 8191; Lk = 8192; base = (long)b * 1024 * 8192; }
               else { const int b = (row0 - NTP) / SLK; key = (row0 - NTP) - b * SLK; Lk = SLK; base = 4l * 1024 * 8192 + (long)b * 1024 * SLK; }
               store_t4(VT + base + (long)vc * Lk + vperm_key(key), v0);
               store_t4(VT + base + (long)(vc + 32) * Lk + vperm_key(key), v1);
             }
           });
}

DI void phase_sgu_in(const P& p, bf16_t* smem) {
  unsigned char* big = p.ws + W_BIG;
  bf16_t* U = (bf16_t*)(big + B_U);
  bf16_t* VR = (bf16_t*)(big + B_VRAW);
  run_gemm256<false>(smem, (const bf16_t*)(p.ws + W_H), 1024, (const bf16_t*)(p.ws + W_SIN), 1024, 132, 32, 16,
           [=](int row0, int col, float4 v0, float4 v1, bool) {
             bf16_t* dst = (col < 2048) ? U + col : VR + (col - 2048);
#pragma unroll
             for (int j = 0; j < 4; ++j) {
               dst[(long)(row0 + j) * 2048] = f2bf(gelu_t(f4get(v0, j)));
               dst[(long)(row0 + j) * 2048 + 32] = f2bf(gelu_t(f4get(v1, j)));
             }
           });
}

DI void phase_sgu_norm(const P& p, float* smf) {
  unsigned char* big = p.ws + W_BIG;
  const bf16_t* VR = (const bf16_t*)(big + B_VRAW);
  bf16_t* VTS = (bf16_t*)(big + B_VTS);
  const float* gv = p.in[43];
  const int lane = threadIdx.x & 63, wave = threadIdx.x >> 6;
  for (int c64 = blockIdx.x; c64 < 528; c64 += gridDim.x) {
    __syncthreads();
    for (int s = wave; s < 64; s += 4) {
      const bf16_t* rowp = VR + (long)(c64 * 64 + s) * 2048;
      float ss = 0.f;
#pragma unroll
      for (int i = 0; i < 4; ++i) {
        const uint4 q = *(const uint4*)(rowp + lane * 8 + 512 * i);
        const unsigned w[4] = {q.x, q.y, q.z, q.w};
#pragma unroll
        for (int e = 0; e < 4; ++e) {
          const float a = __uint_as_float(w[e] << 16), b = __uint_as_float(w[e] & 0xffff0000u);
          ss += a * a + b * b;
        }
      }
      ss = wave_sum(ss);
      if (lane == 0) smf[s] = rsqrtf(ss * (1.f / 2048.f) + NORM_EPS);
    }
    __syncthreads();
    for (int task = threadIdx.x; task < 512 * 8; task += 256) {
      const int d4 = (task & 511) * 4, sg = task >> 9;
      const float4 g4 = *(const float4*)(gv + d4);
      float v[8][4];
#pragma unroll
      for (int j = 0; j < 8; ++j) {
        const int s = sg * 8 + j;
        const uint2 q = *(const uint2*)(VR + (long)(c64 * 64 + s) * 2048 + d4);
        const float rs = smf[s];
        v[j][0] = __uint_as_float(q.x << 16) * rs * g4.x;
        v[j][1] = __uint_as_float(q.x & 0xffff0000u) * rs * g4.y;
        v[j][2] = __uint_as_float(q.y << 16) * rs * g4.z;
        v[j][3] = __uint_as_float(q.y & 0xffff0000u) * rs * g4.w;
        if (c64 >= 512) *(float4*)(p.out + O_SGV + (long)((c64 - 512) * 64 + s) * 2048 + d4) = make_float4(v[j][0], v[j][1], v[j][2], v[j][3]);
      }
#pragma unroll
      for (int e = 0; e < 4; ++e) {
        uint4 o = {pack2(v[0][e], v[1][e]), pack2(v[2][e], v[3][e]), pack2(v[4][e], v[5][e]), pack2(v[6][e], v[7][e])};
        *(uint4*)(VTS + ((long)c64 * 2048 + d4 + e) * 64 + sg * 8) = o;
      }
    }
  }
}

DI void phase_sgu_spatial(const P& p, bf16_t* smem) {
  unsigned char* big = p.ws + W_BIG;
  const bf16_t* U = (const bf16_t*)(big + B_U);
  const bf16_t* VTS = (const bf16_t*)(big + B_VTS);
  bf16_t* G = (bf16_t*)(big + B_G);
  const float* bs = p.in[45];
  for (int t = blockIdx.x; t < 264 * 16; t += gridDim.x) {
    const int mt = t >> 4, g = (t >> 1) & 7, dt = t & 1;
    const bf16_t* a0 = (const bf16_t*)(p.ws + (mt < 256 ? W_WS1 : W_WS2)) + g * 128 * 128;
    const bf16_t* b0 = VTS + ((long)mt * 2 * 2048 + g * 256 + dt * 128) * 64;
    const bool prompt = mt < 256;
    gemm_tile(smem, [=](int r, int kt) { return a0 + r * 128 + kt * 64; }, [=](int r, int kt) { return b0 + (long)kt * 2048 * 64 + r * 64; }, 2,
              [=](int row0, int col, float4 v0, float4 v1) {
                const int gc = g * 256 + dt * 128 + col;
#pragma unroll
                for (int j = 0; j < 4; ++j) {
                  const int tr = row0 + j;
                  const float bias = bs[g * 128 + (prompt ? tr : (tr & 63))];
                  const long o = (long)(mt * 128 + tr) * 2048 + gc;
                  G[o] = f2bf(bf2f(U[o]) * (f4get(v0, j) + bias));
                  G[o + 32] = f2bf(bf2f(U[o + 32]) * (f4get(v1, j) + bias));
                }
              });
  }
}

DI void phase_final_norm(const P& p) {
  const int lane = threadIdx.x & 63;
  const int wv = blockIdx.x * 4 + (threadIdx.x >> 6), nwv = gridDim.x * 4;
  const float* gam = p.in[16];
  for (int row = wv; row < NT; row += nwv) {
    float* x = p.out + (long)row * 1024;
    float4 v[4];
    float ss = 0.f;
#pragma unroll
    for (int i = 0; i < 4; ++i) {
      v[i] = *(const float4*)(x + lane * 4 + 256 * i);
      ss += v[i].x * v[i].x + v[i].y * v[i].y + v[i].z * v[i].z + v[i].w * v[i].w;
    }
    ss = wave_sum(ss);
    const float rinv = rsqrtf(ss * (1.f / 1024.f) + NORM_EPS);
#pragma unroll
    for (int i = 0; i < 4; ++i) {
      const int col = lane * 4 + 256 * i;
      const float4 g4 = *(const float4*)(gam + col);
      *(float4*)(x + col) = make_float4(v[i].x * rinv * g4.x, v[i].y * rinv * g4.y, v[i].z * rinv * g4.z, v[i].w * rinv * g4.w);
    }
  }
}

DI bf16x8 pack8(const f32x16& x, int s) {
  unsigned a = pack2(x[8 * s], x[8 * s + 1]), b = pack2(x[8 * s + 2], x[8 * s + 3]), c = pack2(x[8 * s + 4], x[8 * s + 5]), d = pack2(x[8 * s + 6], x[8 * s + 7]);
  uint4 u = {a, b, c, d};
  return __builtin_bit_cast(bf16x8, u);
}

template <bool MLA>
DI void phase_attn(const P& p, bf16_t* smem) {
  constexpr int NKS = MLA ? 6 : 4;
  constexpr int NDT = MLA ? 2 : 4;
  constexpr int NLD = MLA ? 9 : 8;
  unsigned char* big = p.ws + W_BIG;
  const bf16_t* Q = (const bf16_t*)(big + (MLA ? B_QM : B_QB));
  const bf16_t* KK = (const bf16_t*)(big + (MLA ? B_KN : B_KB));
  const bf16_t* KR = (const bf16_t*)(big + B_KR);
  const bf16_t* VT = (const bf16_t*)(big + (MLA ? B_VTM : B_VTD));
  bf16_t* OB = (bf16_t*)(big + (MLA ? B_OBM : B_OB));
  const float lam = *(const float*)(p.ws + W_LAM);
  const float* gsub = p.in[32];
  const int tid = threadIdx.x, lane = tid & 63, wave = tid >> 6;
  const int wp = wave >> 1, wq = wave & 1, r = lane & 31, hh = lane >> 5;
  constexpr int L_K0 = 0, L_K1 = 4608, L_KR = 9216, L_V0 = MLA ? 11776 : 9216, L_V1 = 16384;
  for (int it = blockIdx.x; it < 4224; it += gridDim.x) {
    int b, hx, qrow0, ntiles, Lk; long R0, vbase;
    if (it < 128) {
      b = it >> 3; hx = it & 7; qrow0 = NTP + b * 64; ntiles = 65; Lk = SLK;
      R0 = (long)NTP + (long)b * SLK; vbase = 4l * 1024 * 8192 + (long)b * 1024 * SLK;
    } else {
      const int i = it - 128; const int qc = 127 - (i >> 5); b = (i & 31) >> 3; hx = i & 7;
      qrow0 = b * 8192 + qc * 64; ntiles = qc + 1; Lk = 8192; R0 = (long)b * 8192; vbase = (long)b * 1024 * 8192;
    }
    bf16x8 qf[NKS];
    {
      const long qr = (long)(qrow0 + wq * 32 + r);
      const bf16_t* qp = MLA ? Q + qr * 1536 + (hx * 2 + wp) * 96 + 8 * hh : Q + qr * 1024 + (hx * 2 + wp) * 64 + 8 * hh;
#pragma unroll
      for (int ks = 0; ks < NKS; ++ks) qf[ks] = *(const bf16x8*)(qp + ks * 16);
    }
    f32x16 O[NDT];
#pragma unroll
    for (int d = 0; d < NDT; ++d)
#pragma unroll
      for (int i = 0; i < 16; ++i) O[d][i] = 0.f;
    float m_run = -1e30f, l_run = 0.f;
    u32x4 ld[NLD];
#define ATT_GLOAD(KT)                                                                                                   \
  {                                                                                                                     \
    const long kr0 = R0 + (long)(KT) * 64;                                                                              \
    _Pragma("unroll") for (int j = 0; j < 4; ++j) {                                                                     \
      const int c = j >> 1, id = tid + 256 * (j & 1), key = id >> 3, ch = id & 7;                                       \
      ld[j] = *(const u32x4*)(KK + (kr0 + key) * 1024 + (hx * 2 + c) * 64 + ch * 8);                                    \
    }                                                                                                                   \
    if (!MLA) {                                                                                                         \
      _Pragma("unroll") for (int i = 0; i < 4; ++i) {                                                                   \
        const int id = tid + 256 * i, dv = id >> 3, ch = id & 7;                                                        \
        ld[4 + i] = *(const u32x4*)(VT + vbase + (long)(hx * 128 + dv) * Lk + (KT) * 64 + ch * 8);                      \
      }                                                                                                                 \
    } else {                                                                                                            \
      _Pragma("unroll") for (int j = 0; j < 4; ++j) {                                                                   \
        const int c = j >> 1, id = tid + 256 * (j & 1), dv = id >> 3, ch = id & 7;                                      \
        ld[4 + j] = *(const u32x4*)(VT + vbase + (long)((hx * 2 + c) * 64 + dv) * Lk + (KT) * 64 + ch * 8);             \
      }                                                                                                                 \
      ld[NLD - 1] = *(const u32x4*)(KR + (kr0 + (tid >> 2)) * 32 + (tid & 3) * 8);                                      \
    }                                                                                                                   \
  }
#define ATT_SWRITE()                                                                                                    \
  {                                                                                                                     \
    _Pragma("unroll") for (int j = 0; j < 4; ++j) {                                                                     \
      const int c = j >> 1, id = tid + 256 * (j & 1), key = id >> 3, ch = id & 7;                                       \
      *(u32x4*)(smem + (c ? L_K1 : L_K0) + key * LST + ch * 8) = ld[j];                                                 \
    }                                                                                                                   \
    if (!MLA) {                                                                                                         \
      _Pragma("unroll") for (int i = 0; i < 4; ++i) {                                                                   \
        const int id = tid + 256 * i, dv = id >> 3, ch = id & 7;                                                        \
        *(u32x4*)(smem + L_V0 + dv * LST + ch * 8) = ld[4 + i];                                                         \
      }                                                                                                                 \
    } else {                                                                                                            \
      _Pragma("unroll") for (int j = 0; j < 4; ++j) {                                                                   \
        const int c = j >> 1, id = tid + 256 * (j & 1), dv = id >> 3, ch = id & 7;                                      \
        *(u32x4*)(smem + (c ? L_V1 : L_V0) + dv * LST + ch * 8) = ld[4 + j];                                            \
      }                                                                                                                 \
      *(u32x4*)(smem + L_KR + (tid >> 2) * 40 + (tid & 3) * 8) = ld[NLD - 1];                                           \
    }                                                                                                                   \
  }
    ATT_GLOAD(0)
    const bf16_t* sK = smem + (wp ? L_K1 : L_K0);
    const bf16_t* sV = smem + ((MLA && wp) ? L_V1 : L_V0);
    for (int kt = 0; kt < ntiles; ++kt) {
      __syncthreads();
      ATT_SWRITE()
      __syncthreads();
      if (kt + 1 < ntiles) ATT_GLOAD(kt + 1)
      f32x16 st[2];
#pragma unroll
      for (int mt = 0; mt < 2; ++mt) {
#pragma unroll
        for (int i = 0; i < 16; ++i) st[mt][i] = 0.f;
#pragma unroll
        for (int ks = 0; ks < NKS; ++ks) {
          bf16x8 a;
          if (ks < 4) a = *(const bf16x8*)(sK + (mt * 32 + r) * LST + ks * 16 + 8 * hh);
          else a = *(const bf16x8*)(smem + L_KR + (mt * 32 + r) * 40 + (ks - 4) * 16 + 8 * hh);
          st[mt] = MFMA(a, qf[ks], st[mt]);
        }
      }
      float mloc = st[0][0];
#pragma unroll
      for (int i = 1; i < 16; ++i) mloc = fmaxf(mloc, st[0][i]);
#pragma unroll
      for (int i = 0; i < 16; ++i) mloc = fmaxf(mloc, st[1][i]);
      mloc = fmaxf(mloc, __shfl_xor(mloc, 32));
      const bool need = mloc > m_run + 8.f;
      if (__any(need)) {
        const float mnew = need ? mloc : m_run;
        const float alpha = __builtin_amdgcn_exp2f(m_run - mnew);
        m_run = mnew;
        l_run *= alpha;
#pragma unroll
        for (int d = 0; d < NDT; ++d)
#pragma unroll
          for (int i = 0; i < 16; ++i) O[d][i] *= alpha;
      }
      float ps = 0.f;
#pragma unroll
      for (int mt = 0; mt < 2; ++mt)
#pragma unroll
        for (int i = 0; i < 16; ++i) { const float e = __builtin_amdgcn_exp2f(st[mt][i] - m_run); st[mt][i] = e; ps += e; }
      l_run += ps;
#pragma unroll
      for (int k2 = 0; k2 < 4; ++k2) {
        const bf16x8 pf = pack8(st[k2 >> 1], k2 & 1);
#pragma unroll
        for (int d = 0; d < NDT; ++d) {
          const bf16x8 va = *(const bf16x8*)(sV + (d * 32 + r) * LST + 16 * k2 + 8 * hh);
          O[d] = MFMA(va, pf, O[d]);
        }
      }
    }
    const float ltot = l_run + __shfl_xor(l_run, 32);
    const float linv = 1.f / ltot;
    const long orow = (long)(qrow0 + wq * 32 + r);
    if (MLA) {
#pragma unroll
      for (int d = 0; d < NDT; ++d)
#pragma unroll
        for (int g = 0; g < 4; ++g) {
          uint2 o = {pack2(O[d][4 * g] * linv, O[d][4 * g + 1] * linv), pack2(O[d][4 * g + 2] * linv, O[d][4 * g + 3] * linv)};
          *(uint2*)(OB + orow * 1024 + (hx * 2 + wp) * 64 + d * 32 + 8 * g + 4 * hh) = o;
        }
    } else {
      float* xs = (float*)smem;
      __syncthreads();
      if (wp == 1) {
#pragma unroll
        for (int d = 0; d < NDT; ++d)
#pragma unroll
          for (int i = 0; i < 16; ++i) xs[(wq * 64 + d * 16 + i) * 64 + lane] = O[d][i] * linv;
      }
      __syncthreads();
      if (wp == 0) {
        float ss = 0.f;
#pragma unroll
        for (int d = 0; d < NDT; ++d)
#pragma unroll
          for (int i = 0; i < 16; ++i) {
            const float o = O[d][i] * linv - lam * xs[(wq * 64 + d * 16 + i) * 64 + lane];
            O[d][i] = o; ss += o * o;
          }
        ss += __shfl_xor(ss, 32);
        const float rinv = rsqrtf(ss * (1.f / 128.f) + NORM_EPS) * (1.f - LAMBDA_INIT);
#pragma unroll
        for (int d = 0; d < NDT; ++d)
#pragma unroll
          for (int g = 0; g < 4; ++g) {
            const int dv = d * 32 + 8 * g + 4 * hh;
            const float4 gs4 = *(const float4*)(gsub + dv);
            uint2 o = {pack2(O[d][4 * g] * rinv * gs4.x, O[d][4 * g + 1] * rinv * gs4.y), pack2(O[d][4 * g + 2] * rinv * gs4.z, O[d][4 * g + 3] * rinv * gs4.w)};
            *(uint2*)(OB + orow * 1024 + hx * 128 + dv) = o;
          }
      }
    }
  }
}


#define XB_TMO      128
#define XB_XCNT(j)  (256  + 64 * (j))
#define XB_XSUB(j)  (1280 + 64 * (j))
#define XB_XGEN(j)  (2304 + 64 * (j))
#define XB_TOP      3328
#define XB_TOPGEN   3392
#define XCD_BAR_WORDS 3456
#define XB_SPIN_CAP (1u << 22)
#define LAS __attribute__((address_space(3)))
DI unsigned xb_ld(unsigned* p) { return __hip_atomic_load(p, __ATOMIC_RELAXED, __HIP_MEMORY_SCOPE_AGENT); }
DI unsigned xb_add(unsigned* p, unsigned v) { return __hip_atomic_fetch_add(p, v, __ATOMIC_RELAXED, __HIP_MEMORY_SCOPE_AGENT); }
DI unsigned xb_xcc_id() { return (unsigned)__builtin_amdgcn_s_getreg((3 << 11) | 20) & 0xFu; }
#define XB_SPIN(cond, bar) do { unsigned _sp = 0; while (cond) { __builtin_amdgcn_s_sleep(1); \
    if ((++_sp & 255u) == 0u) { if (xb_ld(&(bar)[XB_TMO])) break; if (_sp > XB_SPIN_CAP) { atomicAdd(&(bar)[XB_TMO], 1u); break; } } } } while (0)
struct XcdBarrier { unsigned* bar; unsigned x; volatile LAS unsigned* st; };
DI XcdBarrier xcd_barrier_post(unsigned* bar, volatile LAS unsigned* st) {
  XcdBarrier b; b.bar = bar; b.x = xb_xcc_id(); b.st = st;
  if (threadIdx.x == 0) (void)xb_add(&bar[XB_XCNT(b.x)], 1u);
  return b;
}
DI void xcd_barrier_complete(unsigned* bar, unsigned x, unsigned& nloc, unsigned& nx) {
  const unsigned G = gridDim.x * gridDim.y * gridDim.z;
  unsigned sum, cnt, mine, sp = 0u;
  for (;;) {
    sum = 0u; cnt = 0u; mine = 0u;
#pragma unroll
    for (unsigned j = 0; j < 16; ++j) { const unsigned c = xb_ld(&bar[XB_XCNT(j)]); sum += c; cnt += (c > 0u) ? 1u : 0u; mine = (j == x) ? c : mine; }
    if (sum == G) break;
    __builtin_amdgcn_s_sleep(1);
    if ((++sp & 255u) == 0u) { if (xb_ld(&bar[XB_TMO])) break; if (sp > XB_SPIN_CAP) { atomicAdd(&bar[XB_TMO], 1u); break; } }
  }
  nloc = mine > 0u ? mine : 1u; nx = cnt > 0u ? cnt : 1u;
}
DI void xcd_barrier(const XcdBarrier& b) {
  asm volatile("s_waitcnt vmcnt(0)" ::: "memory");
  __syncthreads();
  if (threadIdx.x == 0) {
    unsigned* bar = b.bar;
    __builtin_amdgcn_s_waitcnt(0);
    unsigned nloc = b.st[0], nx = b.st[1];
    if (nloc == 0u) { xcd_barrier_complete(bar, b.x, nloc, nx); b.st[0] = nloc; b.st[1] = nx; }
    const unsigned old = xb_add(&bar[XB_XSUB(b.x)], 1u);
    const unsigned gen = old / nloc;
    if (old + 1u == (gen + 1u) * nloc) {
      __builtin_amdgcn_fence(__ATOMIC_RELEASE, "agent");
      asm volatile("s_waitcnt vmcnt(0)" ::: "memory");
      const unsigned og = xb_add(&bar[XB_TOP], 1u);
      const unsigned tg = og / nx;
      if (og + 1u == (tg + 1u) * nx) xb_add(&bar[XB_TOPGEN], 1u);
      else XB_SPIN(xb_ld(&bar[XB_TOPGEN]) == tg, bar);
      __builtin_amdgcn_fence(__ATOMIC_ACQUIRE, "agent");
      xb_add(&bar[XB_XGEN(b.x)], 1u);
      asm volatile("s_waitcnt vmcnt(0)" ::: "memory");
    } else {
      XB_SPIN(xb_ld(&bar[XB_XGEN(b.x)]) == gen, bar);
      __builtin_amdgcn_fence(__ATOMIC_ACQUIRE, "agent");
      asm volatile("s_waitcnt vmcnt(0)" ::: "memory");
    }
  }
  __syncthreads();
}

constexpr int NPH = 35;
__global__ void __launch_bounds__(256, 2) mk_forward(P p) {
  __shared__ __attribute__((aligned(16))) unsigned char smem_raw[73728];
  cg::grid_group grid = cg::this_grid();
  __shared__ uint4 xb_words;
  if (threadIdx.x == 0) xb_words = make_uint4(0u, 0u, 0u, 0u);
  __syncthreads();
  XcdBarrier xb;
  xb.bar = (unsigned*)(p.ws + W_CTRL); xb.x = 0; xb.st = (volatile LAS unsigned*)&xb_words;
  if (p.hi - p.lo > 1) xb = xcd_barrier_post((unsigned*)(p.ws + W_CTRL), (volatile LAS unsigned*)&xb_words);
  bf16_t* smem = (bf16_t*)smem_raw;
  float* smf = (float*)smem_raw;
  unsigned char* big = p.ws + W_BIG;
  int ph = 0;
#ifdef PROBE_DUP_UP
#define PROBE_UP(l) __syncthreads(); phase_mlp_up(p, smem, l)
#else
#define PROBE_UP(l)
#endif
#ifdef PROBE_DUP_ATTN
#define PROBE_AT(m) __syncthreads(); phase_attn<m>(p, smem)
#else
#define PROBE_AT(m)
#endif
#ifndef ONLY_PH
#define ONLY_PH -1
#endif
#define PH(...) { if ((ONLY_PH < 0 || ph == ONLY_PH) && ph >= p.lo && ph < p.hi) { __VA_ARGS__; } ++ph; if (ph > p.lo && ph < p.hi) { if (ph == 1) grid.sync(); else xcd_barrier(xb); } }
  PH(phase0(p, smf))
  PH(phase1(p))
  PH(phase_modulate<1>(p, 0, 0))
  PH(phase_s5a(p, smem))
  PH(phase_s5_carry(p))
  PH(phase_s5b(p, smem))
  PH(phase_glu(p, smem))
  PH(phase_modulate<0>(p, 0, 1))
  PH(phase_mlp_up(p, smem, 0); PROBE_UP(0))
  PH(phase_mlp_down(p, smem, 0))
  PH(phase_modulate<0>(p, 1, 0))
  PH(phase_qkv(p, smem))
  PH(phase_attn<false>(p, smem); PROBE_AT(false))
  PH(phase_proj_resid(p, smem, (const bf16_t*)(big + B_OB), 1024, (const bf16_t*)(p.ws + W_DWO), 1))
  PH(phase_modulate<0>(p, 1, 1))
  PH(phase_mlp_up(p, smem, 1); PROBE_UP(1))
  PH(phase_mlp_down(p, smem, 1))
  PH(phase_modulate<0>(p, 2, 0))
  PH(phase_mla_down(p, smem))
  PH(phase_mla_norm(p))
  PH(phase_mla_up(p, smem))
  PH(phase_attn<true>(p, smem); PROBE_AT(true))
  PH(phase_proj_resid(p, smem, (const bf16_t*)(big + B_OBM), 1024, (const bf16_t*)(p.ws + W_MWO), 2))
  PH(phase_modulate<0>(p, 2, 1))
  PH(phase_mlp_up(p, smem, 2); PROBE_UP(2))
  PH(phase_mlp_down(p, smem, 2))
  PH(phase_modulate<0>(p, 3, 0))
  PH(phase_sgu_in(p, smem))
  PH(phase_sgu_norm(p, smf))
  PH(phase_sgu_spatial(p, smem))
  PH(phase_proj_resid(p, smem, (const bf16_t*)(big + B_G), 2048, (const bf16_t*)(p.ws + W_SOUT), 3))
  PH(phase_modulate<0>(p, 3, 1))
  PH(phase_mlp_up(p, smem, 3); PROBE_UP(3))
  PH(phase_mlp_down(p, smem, 3))
  PH(phase_final_norm(p))
#undef PH
}

extern "C" void kernel_launch(void* const* d_in, const int* in_sizes, int n_in, void* d_out, int out_size, void* d_ws, size_t ws_size,
                              hipStream_t stream) {
  static int grid_blocks = 0;
  if (!grid_blocks) {
    int dev = 0, cus = 0, per_cu = 0;
    hipGetDevice(&dev);
    hipDeviceGetAttribute(&cus, hipDeviceAttributeMultiprocessorCount, dev);
    hipOccupancyMaxActiveBlocksPerMultiprocessor(&per_cu, mk_forward, 256, 0);
    if (per_cu < 1) per_cu = 1;
    if (per_cu > 2) per_cu = 2;
    grid_blocks = cus * per_cu;
    if (ws_size < WS_NEED) fprintf(stderr, "kernel_launch: workspace too small: %zu < %zu\n", ws_size, (size_t)WS_NEED);
  }
  P p{};
  for (int i = 0; i < 47; ++i) p.in[i] = (const float*)d_in[i];
  p.out = (float*)d_out;
  p.ws = (unsigned char*)d_ws;
#if MK_SINGLE
  (void)hipMemsetAsync(d_ws, 0, 16384, stream);
  p.lo = 0; p.hi = NPH;
  void* args[] = {&p};
  hipError_t e = hipLaunchCooperativeKernel((void*)mk_forward, dim3(grid_blocks), dim3(256), args, 0, stream);
  if (e != hipSuccess) fprintf(stderr, "cooperative launch failed: %s (grid %d)\n", hipGetErrorString(e), grid_blocks);
#else
  for (int ph = 0; ph < NPH; ++ph) {
    p.lo = ph; p.hi = ph + 1;
    hipLaunchKernelGGL(mk_forward, dim3(grid_blocks), dim3(256), 0, stream, p);
  }
#endif
}
```

```cpp
#include <hip/hip_runtime.h>
#include <hip/hip_cooperative_groups.h>
#include <stdint.h>
#include <stdio.h>
namespace cg = cooperative_groups;

#ifndef MK_SINGLE
#define MK_SINGLE 1
#endif

typedef unsigned short bf16_t;
typedef __attribute__((ext_vector_type(8))) short bf16x8;
typedef __attribute__((ext_vector_type(4))) short s16x4;
typedef __attribute__((ext_vector_type(4))) unsigned u32x4;
typedef __attribute__((ext_vector_type(16))) float f32x16;
typedef __bf16 bf2_t __attribute__((ext_vector_type(2)));
typedef float fl2_t __attribute__((ext_vector_type(2)));
#define DI __device__ __forceinline__
#define MFMA(a, b, c) __builtin_amdgcn_mfma_f32_32x32x16_bf16((a), (b), (c), 0, 0, 0)

constexpr int NTP = 32768, NTS = 1024, NT = 33792;
constexpr int SLK = 4160;
constexpr int KROWS = 99328;
constexpr float NORM_EPS = 1e-6f;
constexpr float LAMBDA_INIT = 0.35550906759096933f;
constexpr float L2E = 1.4426950408889634f;

constexpr size_t O_S5RP = (size_t)NT * 1024, O_S5IP = O_S5RP + 16384, O_S5RS = O_S5IP + 16384, O_S5IS = O_S5RS + 65536,
                 O_DKP = O_S5IS + 65536, O_DVP = O_DKP + (size_t)NTP * 1024, O_DKS = O_DVP + (size_t)NTP * 1024,
                 O_DVS = O_DKS + (size_t)NTS * 1024, O_CKP = O_DVS + (size_t)NTS * 1024, O_KRP = O_CKP + (size_t)NTP * 128,
                 O_CKS = O_KRP + (size_t)NTP * 32, O_KRS = O_CKS + (size_t)NTS * 128, O_SGV = O_KRS + (size_t)NTS * 32;

constexpr size_t W_CTRL = 0;
constexpr size_t W_LAM = 16384;
constexpr size_t W_MODP = W_LAM + 256;
constexpr size_t W_MOD = W_MODP + 8ull * 20 * 24576 * 4;
constexpr size_t W_AP = W_MOD + 20ull * 24576 * 4;
constexpr size_t W_BBAR = W_AP + 64ull * 65 * 64 * 8;
constexpr size_t W_E = W_BBAR + 64ull * 64 * 16 * 8;
constexpr size_t W_CH = W_E + 64ull * 16 * 2048 * 2;
constexpr size_t W_MEND = W_CH + 64ull * 1024 * 128 * 2;
constexpr size_t W_WS1 = W_MEND + 64ull * 128 * 1024 * 2;
constexpr size_t W_WS2 = W_WS1 + 8ull * 128 * 128 * 2;
constexpr size_t W_WUP = W_WS2 + 8ull * 128 * 128 * 2;
constexpr size_t W_WDN = W_WUP + 4ull * 4096 * 1024 * 2;
constexpr size_t W_GLU = W_WDN + 4ull * 4096 * 1024 * 2;
constexpr size_t W_QKV = W_GLU + 2048ull * 1024 * 2;
constexpr size_t W_DWO = W_QKV + 3072ull * 1024 * 2;
constexpr size_t W_MD = W_DWO + 1024ull * 1024 * 2;
constexpr size_t W_MUQ = W_MD + 512ull * 1024 * 2;
constexpr size_t W_MUKV = W_MUQ + 1536ull * 256 * 2;
constexpr size_t W_MWO = W_MUKV + 2048ull * 128 * 2;
constexpr size_t W_SIN = W_MWO + 1024ull * 1024 * 2;
constexpr size_t W_SOUT = W_SIN + 4096ull * 1024 * 2;
constexpr size_t W_H = W_SOUT + 1024ull * 2048 * 2;
constexpr size_t W_BIG = W_H + (size_t)NT * 1024 * 2;
constexpr size_t B_HG = 0, B_SLOC = 94371840ull, B_Z = 115343360ull;
constexpr size_t B_ACT = 0;
constexpr size_t B_QB = 0, B_KB = 69206016ull, B_VTD = 272629760ull, B_OB = 476053504ull;
constexpr size_t B_RAW = 0, B_CQ = 51904512ull, B_OBM = 0, B_CKV = 69206016ull, B_KR = 94633984ull, B_QM = 100990976ull,
                 B_KN = 204800000ull, B_VTM = 408223744ull;
constexpr size_t B_U = 0, B_VRAW = 138412032ull, B_VTS = 276824064ull, B_G = 415236096ull;
constexpr size_t WS_NEED = W_BIG + 611647488ull;

struct P {
  const float* in[47];
  float* out;
  unsigned char* ws;
  int lo, hi;
};

DI unsigned pack2(float a, float b) {
  fl2_t f = {a, b};
  bf2_t r = __builtin_convertvector(f, bf2_t);
  return __builtin_bit_cast(unsigned, r);
}
DI bf16_t f2bf(float a) { return (bf16_t)(pack2(a, 0.f) & 0xffffu); }
DI float bf2f(bf16_t v) { return __uint_as_float(((unsigned)v) << 16); }
DI float gelu_t(float x) {
  float u = 0.7978845608028654f * (x + 0.044715f * x * x * x);
  float t = 1.f - 2.f / (__expf(2.f * u) + 1.f);
  return 0.5f * x * (1.f + t);
}
DI float sigmoid_f(float x) { return 1.f / (1.f + __expf(-x)); }
DI int batch_of(int row) { return row < NTP ? (row >> 13) : 4 + ((row - NTP) >> 6); }
DI int pos_of(int row) { return row < NTP ? (row & 8191) : 4096 + ((row - NTP) & 63); }
DI int krow_of(int row) { return row < NTP ? row : NTP + ((row - NTP) >> 6) * SLK + 4096 + ((row - NTP) & 63); }
DI void rope_cs(int pos, float invf, float& c, float& s) {
  double t = (double)pos * (double)invf * 0.15915494309189535;
  t -= __builtin_rint(t);
  float ft = (float)t;
  c = __builtin_amdgcn_cosf(ft);
  s = __builtin_amdgcn_sinf(ft);
}
DI float wave_sum(float v) {
#pragma unroll
  for (int o = 32; o > 0; o >>= 1) v += __shfl_xor(v, o);
  return v;
}

constexpr int LST = 72;
template <class AF, class BF, class EPI>
DI void gemm_tile(bf16_t* smem, AF af, BF bf, int nkt, EPI epi) {
  const int tid = threadIdx.x, lane = tid & 63, wave = tid >> 6;
  const int wm = wave >> 1, wn = wave & 1, r = lane & 31, h = lane >> 5;
  bf16_t* sA = smem;
  bf16_t* sB = smem + 2 * 128 * LST;
  f32x16 acc[2][2];
#pragma unroll
  for (int a = 0; a < 2; ++a)
#pragma unroll
    for (int b = 0; b < 2; ++b)
#pragma unroll
      for (int i = 0; i < 16; ++i) acc[a][b][i] = 0.f;
  const int lr = tid >> 3, lc = (tid & 7) * 8;
  uint4 ra[4], rb[4];
#pragma unroll
  for (int i = 0; i < 4; ++i) {
    ra[i] = *(const uint4*)(af(lr + 32 * i, 0) + lc);
    rb[i] = *(const uint4*)(bf(lr + 32 * i, 0) + lc);
  }
#pragma unroll
  for (int i = 0; i < 4; ++i) {
    *(uint4*)(sA + (lr + 32 * i) * LST + lc) = ra[i];
    *(uint4*)(sB + (lr + 32 * i) * LST + lc) = rb[i];
  }
  __syncthreads();
  for (int kt = 0; kt < nkt; ++kt) {
    const bool more = (kt + 1 < nkt);
    if (more) {
#pragma unroll
      for (int i = 0; i < 4; ++i) {
        ra[i] = *(const uint4*)(af(lr + 32 * i, kt + 1) + lc);
        rb[i] = *(const uint4*)(bf(lr + 32 * i, kt + 1) + lc);
      }
    }
    const bf16_t* pa = sA + (kt & 1) * 128 * LST + (wm * 64 + r) * LST + h * 8;
    const bf16_t* pb = sB + (kt & 1) * 128 * LST + (wn * 64 + r) * LST + h * 8;
#pragma unroll
    for (int ks = 0; ks < 4; ++ks) {
      bf16x8 a0 = *(const bf16x8*)(pa + ks * 16);
      bf16x8 a1 = *(const bf16x8*)(pa + 32 * LST + ks * 16);
      bf16x8 b0 = *(const bf16x8*)(pb + ks * 16);
      bf16x8 b1 = *(const bf16x8*)(pb + 32 * LST + ks * 16);
      acc[0][0] = MFMA(a0, b0, acc[0][0]);
      acc[0][1] = MFMA(a0, b1, acc[0][1]);
      acc[1][0] = MFMA(a1, b0, acc[1][0]);
      acc[1][1] = MFMA(a1, b1, acc[1][1]);
    }
    if (more) {
      const int nb = ((kt + 1) & 1) * 128 * LST;
#pragma unroll
      for (int i = 0; i < 4; ++i) {
        *(uint4*)(sA + nb + (lr + 32 * i) * LST + lc) = ra[i];
        *(uint4*)(sB + nb + (lr + 32 * i) * LST + lc) = rb[i];
      }
    }
    __syncthreads();
  }
#pragma unroll
  for (int mi = 0; mi < 2; ++mi)
#pragma unroll
    for (int g = 0; g < 4; ++g) {
      float4 v0 = {acc[mi][0][4 * g], acc[mi][0][4 * g + 1], acc[mi][0][4 * g + 2], acc[mi][0][4 * g + 3]};
      float4 v1 = {acc[mi][1][4 * g], acc[mi][1][4 * g + 1], acc[mi][1][4 * g + 2], acc[mi][1][4 * g + 3]};
      epi(wm * 64 + mi * 32 + 8 * g + 4 * h, wn * 64 + r, v0, v1);
      __builtin_amdgcn_sched_barrier(0);
    }
}


template <class EPI>
DI void gemm_tile256(bf16_t* smem, const bf16_t* __restrict__ Ab, int lda, const bf16_t* __restrict__ Bb, int ldb, int nkt, EPI epi) {
  const int tid = threadIdx.x, lane = tid & 63, wave = tid >> 6;
  const int wm = wave >> 1, wn = wave & 1, r = lane & 31, h = lane >> 5;
  bf16_t* sA = smem;
  bf16_t* sB = smem + 256 * LST;
  f32x16 acc[4][2];
#pragma unroll
  for (int a = 0; a < 4; ++a)
#pragma unroll
    for (int b = 0; b < 2; ++b)
#pragma unroll
      for (int i = 0; i < 16; ++i) acc[a][b][i] = 0.f;
  const int lr = tid >> 3, lc = (tid & 7) * 8;
  u32x4 rg[12];
  unsigned offa = (unsigned)(lr * lda + lc), offb = (unsigned)(lr * ldb + lc);
  const unsigned sta = 32u * lda, stb = 32u * ldb;
#pragma unroll
  for (int i = 0; i < 8; ++i) rg[i] = *(const u32x4*)(Ab + (offa + i * sta));
#pragma unroll
  for (int i = 0; i < 4; ++i) rg[8 + i] = *(const u32x4*)(Bb + (offb + i * stb));
  for (int kt = 0; kt < nkt; ++kt) {
    __syncthreads();
#pragma unroll
    for (int i = 0; i < 8; ++i) *(u32x4*)(sA + (lr + 32 * i) * LST + lc) = rg[i];
#pragma unroll
    for (int i = 0; i < 4; ++i) *(u32x4*)(sB + (lr + 32 * i) * LST + lc) = rg[8 + i];
    __syncthreads();
    if (kt + 1 < nkt) {
      offa += 64u; offb += 64u;
#pragma unroll
      for (int i = 0; i < 8; ++i) rg[i] = *(const u32x4*)(Ab + (offa + i * sta));
#pragma unroll
      for (int i = 0; i < 4; ++i) rg[8 + i] = *(const u32x4*)(Bb + (offb + i * stb));
    }
    const bf16_t* pa = sA + (wm * 128 + r) * LST + h * 8;
    const bf16_t* pb = sB + (wn * 64 + r) * LST + h * 8;
#pragma unroll
    for (int ks = 0; ks < 4; ++ks) {
      const bf16x8 b0 = *(const bf16x8*)(pb + ks * 16);
      const bf16x8 b1 = *(const bf16x8*)(pb + 32 * LST + ks * 16);
#pragma unroll
      for (int mi = 0; mi < 4; ++mi) {
        const bf16x8 a = *(const bf16x8*)(pa + mi * 32 * LST + ks * 16);
        acc[mi][0] = MFMA(a, b0, acc[mi][0]);
        acc[mi][1] = MFMA(a, b1, acc[mi][1]);
      }
    }
  }
  __syncthreads();
#pragma unroll
  for (int mi = 0; mi < 4; ++mi)
#pragma unroll
    for (int g = 0; g < 4; ++g) {
      float4 v0 = {acc[mi][0][4 * g], acc[mi][0][4 * g + 1], acc[mi][0][4 * g + 2], acc[mi][0][4 * g + 3]};
      float4 v1 = {acc[mi][1][4 * g], acc[mi][1][4 * g + 1], acc[mi][1][4 * g + 2], acc[mi][1][4 * g + 3]};
      epi(wm * 128 + mi * 32 + 8 * g + 4 * h, wn * 64 + r, v0, v1);
      __builtin_amdgcn_sched_barrier(0);
    }
}

template <bool SPLIT, class EPI>
DI void run_gemm256(bf16_t* smem, const bf16_t* A, int lda, const bf16_t* B, int ldb, int mtiles, int ntiles, int nkt, EPI epi) {
  const int T = mtiles * ntiles, G = gridDim.x;
  int full = T, S = 1;
  if (SPLIT) {
    const int R = T % G;
    if (R > 0) {
      full = T - R;
      S = 16;
      while (S > 1 && (S * R > G || S > nkt)) S >>= 1;
    }
  }
  const int items = full + (T - full) * S;
  const int vb = ((G & 7) == 0) ? (int)((blockIdx.x & 7) * (G >> 3) + (blockIdx.x >> 3)) : (int)blockIdx.x;
  for (int it = vb; it < items; it += G) {
    int t = it, k0 = 0, nk = nkt; bool part = false;
    if (it >= full) { const int j = it - full; t = full + j / S; nk = nkt / S; k0 = (j % S) * nk; part = (S > 1); }
    const int mt = t / ntiles, nt = t % ntiles;
    const bf16_t* a0 = A + (long)mt * 256 * lda + k0 * 64;
    const bf16_t* b0 = B + (long)nt * 128 * ldb + k0 * 64;
    gemm_tile256(smem, a0, lda, b0, ldb, nk,
                 [=](int row0, int col, float4 v0, float4 v1) { epi(mt * 256 + row0, nt * 128 + col, v0, v1, part); });
  }
}

DI float f4get(const float4& v, int j) { return j == 0 ? v.x : (j == 1 ? v.y : (j == 2 ? v.z : v.w)); }

template <class F>
DI void prep_w(bf16_t* dst, int K, int N, int ld, F colsrc) {
  const long total = (long)N * (K / 8);
  for (long idx = (long)blockIdx.x * 256 + threadIdx.x; idx < total; idx += (long)gridDim.x * 256) {
    const int n = (int)(idx % N);
    const int kg = (int)(idx / N);
    const float* s = colsrc(n);
    uint4 o = {0u, 0u, 0u, 0u};
    if (s) {
      s += (long)kg * 8 * ld;
      float v0 = s[0], v1 = s[(long)ld], v2 = s[2l * ld], v3 = s[3l * ld], v4 = s[4l * ld], v5 = s[5l * ld], v6 = s[6l * ld], v7 = s[7l * ld];
      o.x = pack2(v0, v1); o.y = pack2(v2, v3); o.z = pack2(v4, v5); o.w = pack2(v6, v7);
    }
    *(uint4*)(dst + (long)n * K + kg * 8) = o;
  }
}

DI void phase0(const P& p, float* smf) {
  unsigned char* ws = p.ws;
  const int gt = blockIdx.x * 256 + threadIdx.x, gs = gridDim.x * 256;
  {
    float* modp = (float*)(ws + W_MODP);
#ifndef REP_M
#define REP_M 1
#endif
#pragma unroll 1
    for (int rep = 0; rep < REP_M; ++rep)
    for (int it = blockIdx.x; it < 768; it += gridDim.x) {
      const int kc = it / 96, ch = it % 96;
      __syncthreads();
      for (int e = threadIdx.x; e < 20 * 128; e += 256) {
        const int m = e >> 7, k = e & 127;
        const float c = (m < 4) ? p.in[2][m * 1024 + kc * 128 + k] : p.in[3][(m - 4) * 1024 + kc * 128 + k];
        smf[k * 20 + m] = c / (1.f + __expf(-c));
      }
      __syncthreads();
      const int n = ch * 256 + threadIdx.x;
      const int layer = n / 6144, col = n % 6144;
      const float* w = p.in[10] + ((long)(layer * 1024 + kc * 128)) * 6144 + col;
      float acc[20];
#pragma unroll
      for (int m = 0; m < 20; ++m) acc[m] = 0.f;
      for (int k = 0; k < 128; ++k) {
        const float wv = w[(long)k * 6144];
#pragma unroll
        for (int m = 0; m < 20; ++m) acc[m] += smf[k * 20 + m] * wv;
      }
#pragma unroll
      for (int m = 0; m < 20; ++m) modp[(long)(kc * 20 + m) * 24576 + n] = acc[m];
    }
  }
  {
    float2* ap = (float2*)(ws + W_AP);
    for (int idx = gt; idx < 64 * 65 * 64; idx += gs) {
      const int g = idx / (65 * 64), tau = (idx / 64) % 65, pp = idx & 63;
      const float dt = expf(p.in[24][g]);
      const float are = p.in[17][g * 64 + pp], aim = p.in[18][g * 64 + pp];
      const float mag = expf(are * dt * (float)tau);
      double t = (double)aim * (double)dt * (double)tau * 0.15915494309189535;
      t -= __builtin_rint(t);
      const float ft = (float)t;
      ap[idx] = make_float2(mag * __builtin_amdgcn_cosf(ft), mag * __builtin_amdgcn_sinf(ft));
    }
    float2* bb = (float2*)(ws + W_BBAR);
    for (int idx = gt; idx < 64 * 64 * 16; idx += gs) {
      const int g = idx / 1024, pp = (idx >> 4) & 63;
      const float dt = expf(p.in[24][g]);
      const float are = p.in[17][g * 64 + pp], aim = p.in[18][g * 64 + pp];
      const float mag = expf(are * dt);
      double t = (double)aim * (double)dt * 0.15915494309189535;
      t -= __builtin_rint(t);
      const float ft = (float)t;
      const float nr = mag * __builtin_amdgcn_cosf(ft) - 1.f, ni = mag * __builtin_amdgcn_sinf(ft);
      const float den = are * are + aim * aim;
      const float qr = (nr * are + ni * aim) / den, qi = (ni * are - nr * aim) / den;
      const float br = p.in[19][idx], bi = p.in[20][idx];
      bb[idx] = make_float2(qr * br - qi * bi, qr * bi + qi * br);
    }
  }
  if (gt == 0) {
    float s1 = 0.f, s2 = 0.f;
    for (int i = 0; i < 64; ++i) { s1 += p.in[28][i] * p.in[29][i]; s2 += p.in[30][i] * p.in[31][i]; }
    *(float*)(ws + W_LAM) = expf(s1) - expf(s2) + LAMBDA_INIT;
  }
  {
    bf16_t* w1 = (bf16_t*)(ws + W_WS1);
    bf16_t* w2 = (bf16_t*)(ws + W_WS2);
    const float* wsrc = p.in[44];
    for (int idx = gt; idx < 8 * 128 * 128; idx += gs) {
      const int g = idx >> 14, t = (idx >> 7) & 127, s = idx & 127;
      w1[idx] = f2bf(s <= t ? wsrc[idx] : 0.f);
      const int tt = t & 63, ss = s & 63;
      w2[idx] = f2bf(((t >> 6) == (s >> 6) && ss <= tt) ? wsrc[(g * 128 + tt) * 128 + ss] : 0.f);
    }
  }
#ifndef REP_W
#define REP_W 1
#endif
#pragma unroll 1
  for (int rep = 0; rep < REP_W; ++rep) {
  for (int l = 0; l < 4; ++l) {
    const float* up = p.in[14] + (long)l * 1024 * 4096;
    prep_w((bf16_t*)(ws + W_WUP) + (long)l * 4096 * 1024, 1024, 4096, 4096, [=](int n) { return up + n; });
    const float* dn = p.in[15] + (long)l * 4096 * 1024;
    prep_w((bf16_t*)(ws + W_WDN) + (long)l * 1024 * 4096, 4096, 1024, 1024, [=](int n) { return dn + n; });
  }
  {
    const float* ga = p.in[25]; const float* gb = p.in[26];
    prep_w((bf16_t*)(ws + W_GLU), 1024, 2048, 1024, [=](int n) { const int sp = n >> 6, w = n & 63; return ((w < 32) ? ga : gb) + sp * 32 + (w & 31); });
    const float* s = p.in[27];
    prep_w((bf16_t*)(ws + W_QKV), 1024, 3072, 3072, [=](int n) { return s + n; });
    const float* s2 = p.in[33];
    prep_w((bf16_t*)(ws + W_DWO), 1024, 1024, 1024, [=](int n) { return s2 + n; });
    const float* dq = p.in[34];
    prep_w((bf16_t*)(ws + W_MD), 1024, 256, 256, [=](int n) { return dq + n; });
    const float* dkv = p.in[37];
    prep_w((bf16_t*)(ws + W_MD) + 256 * 1024, 1024, 256, 160, [=](int n) -> const float* {
      if (n < 128) return dkv + n;
      const int w = n - 128;
      if (w < 16) return dkv + 128 + w;
      if (w >= 32 && w < 48) return dkv + 144 + (w - 32);
      return nullptr;
    });
    const float* uq = p.in[36];
    prep_w((bf16_t*)(ws + W_MUQ), 256, 1536, 1536, [=](int n) {
      if (n < 1024) return uq + (n >> 6) * 96 + (n & 63);
      const int sp = (n - 1024) >> 6, w = (n - 1024) & 63, half = w >> 5, ix = w & 31;
      const int head = sp * 2 + (ix >> 4), i = ix & 15;
      return uq + head * 96 + 64 + half * 16 + i;
    });
    const float* uk = p.in[39]; const float* uv = p.in[40];
    prep_w((bf16_t*)(ws + W_MUKV), 128, 2048, 1024, [=](int n) { return n < 1024 ? uk + n : uv + (n - 1024); });
    const float* mwo = p.in[41];
    prep_w((bf16_t*)(ws + W_MWO), 1024, 1024, 1024, [=](int n) { return mwo + n; });
    const float* sin_ = p.in[42];
    prep_w((bf16_t*)(ws + W_SIN), 1024, 4096, 4096, [=](int n) { return sin_ + n; });
    const float* sout = p.in[46];
    prep_w((bf16_t*)(ws + W_SOUT), 2048, 1024, 1024, [=](int n) { return sout + n; });
  }
  }
}

DI void phase1(const P& p) {
  unsigned char* ws = p.ws;
  const int gt = blockIdx.x * 256 + threadIdx.x, gs = gridDim.x * 256;
  {
    const float* modp = (const float*)(ws + W_MODP);
    float* mod = (float*)(ws + W_MOD);
    for (int idx = gt; idx < 20 * 24576; idx += gs) {
      const int n = idx % 24576;
      float s = p.in[11][n];
#pragma unroll
      for (int kc = 0; kc < 8; ++kc) s += modp[(long)kc * 20 * 24576 + idx];
      mod[idx] = s;
    }
  }
  const float2* ap = (const float2*)(ws + W_AP);
  const float2* bb = (const float2*)(ws + W_BBAR);
  const float* cre = p.in[21]; const float* cim = p.in[22];
  {
    bf16_t* E = (bf16_t*)(ws + W_E);
    for (int idx = gt; idx < 64 * 16 * 2048; idx += gs) {
      const int g = idx >> 15, co = (idx >> 11) & 15, j = idx & 2047;
      float v = 0.f;
      if (j < 1024) {
        const int tau = 63 - (j >> 4), ci = j & 15;
        for (int pp = 0; pp < 64; ++pp) {
          const float2 a = ap[(g * 65 + tau) * 64 + pp];
          const float2 b = bb[(g * 64 + pp) * 16 + ci];
          const float cr = cre[(g * 16 + co) * 64 + pp], cimv = cim[(g * 16 + co) * 64 + pp];
          const float abr = a.x * b.x - a.y * b.y, abi = a.x * b.y + a.y * b.x;
          v += cr * abr - cimv * abi;
        }
        if (tau == 0 && co == ci) v += p.in[23][g * 16 + co];
      }
      E[idx] = f2bf(v);
    }
    bf16_t* CH = (bf16_t*)(ws + W_CH);
    for (int idx = gt; idx < 64 * 1024 * 128; idx += gs) {
      const int g = idx >> 17, m = (idx >> 7) & 1023, q = idx & 127;
      const int t = m >> 4, co = m & 15, pp = q & 63;
      const float2 a = ap[(g * 65 + t + 1) * 64 + pp];
      const float cr = cre[(g * 16 + co) * 64 + pp], cimv = cim[(g * 16 + co) * 64 + pp];
      const float zr = cr * a.x - cimv * a.y, zi = cr * a.y + cimv * a.x;
      CH[idx] = f2bf(q < 64 ? zr : -zi);
    }
    bf16_t* ME = (bf16_t*)(ws + W_MEND);
    for (int idx = gt; idx < 64 * 128 * 1024; idx += gs) {
      const int g = idx >> 17, q = (idx >> 10) & 127, k = idx & 1023;
      const int s = k >> 4, c = k & 15, pp = q & 63;
      const float2 a = ap[(g * 65 + 63 - s) * 64 + pp];
      const float2 b = bb[(g * 64 + pp) * 16 + c];
      ME[idx] = f2bf(q < 64 ? (a.x * b.x - a.y * b.y) : (a.x * b.y + a.y * b.x));
    }
  }
}

template <int MODE>
DI void phase_modulate(const P& p, int layer, int which) {
  unsigned char* ws = p.ws;
  const float* mod = (const float*)(ws + W_MOD);
  const float* gam = (which == 0 ? p.in[12] : p.in[13]) + layer * 1024;
  const int lane = threadIdx.x & 63;
  const int wv = blockIdx.x * 4 + (threadIdx.x >> 6), nwv = gridDim.x * 4;
  bf16_t* H = (bf16_t*)(ws + W_H);
  bf16_t* HG = (bf16_t*)(ws + W_BIG + B_HG);
  for (int row = wv; row < NT; row += nwv) {
    const float* x = (MODE == 1) ? (row < NTP ? p.in[0] + (long)row * 1024 : p.in[1] + (long)(row - NTP) * 1024) : p.out + (long)row * 1024;
    float4 v[4];
    float ss = 0.f;
#pragma unroll
    for (int i = 0; i < 4; ++i) {
      v[i] = *(const float4*)(x + lane * 4 + 256 * i);
      ss += v[i].x * v[i].x + v[i].y * v[i].y + v[i].z * v[i].z + v[i].w * v[i].w;
    }
    ss = wave_sum(ss);
    const float rinv = rsqrtf(ss * (1.f / 1024.f) + NORM_EPS);
    const int b = batch_of(row);
    const float* sh = mod + (long)b * 24576 + layer * 6144 + (which * 3) * 1024;
    const float* sc = sh + 1024;
#pragma unroll
    for (int i = 0; i < 4; ++i) {
      const int col = lane * 4 + 256 * i;
      const float4 g4 = *(const float4*)(gam + col), sh4 = *(const float4*)(sh + col), sc4 = *(const float4*)(sc + col);
      const float h0 = v[i].x * rinv * g4.x * (1.f + sc4.x) + sh4.x;
      const float h1 = v[i].y * rinv * g4.y * (1.f + sc4.y) + sh4.y;
      const float h2 = v[i].z * rinv * g4.z * (1.f + sc4.z) + sh4.z;
      const float h3 = v[i].w * rinv * g4.w * (1.f + sc4.w) + sh4.w;
      uint2 o = {pack2(h0, h1), pack2(h2, h3)};
      if (MODE == 1) {
        *(float4*)(p.out + (long)row * 1024 + col) = v[i];
        const int g = col >> 4, c = col & 15, n = row >> 6, s = row & 63;
        *(uint2*)(HG + ((long)(g * 640 + n)) * 1152 + s * 16 + c) = o;
      } else {
        *(uint2*)(H + (long)row * 1024 + col) = o;
      }
    }
  }
}

DI void phase_s5_carry(const P& p) {
  unsigned char* ws = p.ws;
  const float2* ap = (const float2*)(ws + W_AP);
  const float* sloc = (const float*)(ws + W_BIG + B_SLOC);
  bf16_t* HG = (bf16_t*)(ws + W_BIG + B_HG);
  const int gt = blockIdx.x * 256 + threadIdx.x, gs = gridDim.x * 256;
  for (int idx = gt; idx < 64 * 20 * 64; idx += gs) {
    const int g = idx / 1280, bb = (idx >> 6) % 20, pp = idx & 63;
    const float2 a = ap[(g * 65 + 64) * 64 + pp];
    if (bb < 4) {
      float hr = 0.f, hi = 0.f;
#pragma unroll 8
      for (int k = 0; k < 128; ++k) {
        const long n = (long)g * 640 + bb * 128 + k;
        HG[n * 1152 + 1024 + pp] = f2bf(hr);
        HG[n * 1152 + 1088 + pp] = f2bf(hi);
        const float sr = sloc[n * 128 + pp], si = sloc[n * 128 + 64 + pp];
        const float nr = a.x * hr - a.y * hi + sr, ni = a.x * hi + a.y * hr + si;
        hr = nr; hi = ni;
      }
      p.out[O_S5RP + (bb * 64 + g) * 64 + pp] = hr;
      p.out[O_S5IP + (bb * 64 + g) * 64 + pp] = hi;
    } else {
      const int b = bb - 4;
      const long n = (long)g * 640 + 512 + b;
      float hr = p.in[4][(b * 64 + g) * 64 + pp], hi = p.in[5][(b * 64 + g) * 64 + pp];
      HG[n * 1152 + 1024 + pp] = f2bf(hr);
      HG[n * 1152 + 1088 + pp] = f2bf(hi);
      const float sr = sloc[n * 128 + pp], si = sloc[n * 128 + 64 + pp];
      p.out[O_S5RS + (b * 64 + g) * 64 + pp] = a.x * hr - a.y * hi + sr;
      p.out[O_S5IS + (b * 64 + g) * 64 + pp] = a.x * hi + a.y * hr + si;
    }
  }
}

DI const float* mod_ptr(const P& p, int layer, int k) { return (const float*)(p.ws + W_MOD) + layer * 6144 + k * 1024; }

DI void phase_s5a(const P& p, bf16_t* smem) {
  const bf16_t* HG = (const bf16_t*)(p.ws + W_BIG + B_HG);
  const bf16_t* ME = (const bf16_t*)(p.ws + W_MEND);
  float* sloc = (float*)(p.ws + W_BIG + B_SLOC);
  for (int t = blockIdx.x; t < 64 * 5; t += gridDim.x) {
    const int g = t / 5, mi = t % 5;
    const bf16_t* a0 = HG + (long)(g * 640 + mi * 128) * 1152;
    const bf16_t* b0 = ME + (long)g * 128 * 1024;
    float* o = sloc + (long)(g * 640 + mi * 128) * 128;
    gemm_tile(smem, [=](int r, int kt) { return a0 + (long)r * 1152 + kt * 64; }, [=](int r, int kt) { return b0 + (long)r * 1024 + kt * 64; }, 16,
              [=](int row0, int col, float4 v0, float4 v1) {
#pragma unroll
                for (int j = 0; j < 4; ++j) {
                  o[(long)(row0 + j) * 128 + col] = f4get(v0, j);
                  o[(long)(row0 + j) * 128 + col + 32] = f4get(v1, j);
                }
              });
  }
}

DI void phase_s5b(const P& p, bf16_t* smem) {
  const bf16_t* HG = (const bf16_t*)(p.ws + W_BIG + B_HG);
  const bf16_t* E = (const bf16_t*)(p.ws + W_E);
  const bf16_t* CH = (const bf16_t*)(p.ws + W_CH);
  bf16_t* Z = (bf16_t*)(p.ws + W_BIG + B_Z);
  for (int t = blockIdx.x; t < 64 * 5 * 8; t += gridDim.x) {
    const int g = t / 40, mi = (t % 40) >> 3, j = 7 - (t & 7);
    const int nE = 2 * j + 2;
    const bf16_t* a0 = HG + (long)(g * 640 + mi * 128) * 1152;
    const bf16_t* e0 = E + (long)g * 16 * 2048;
    const bf16_t* c0 = CH + ((long)g * 1024 + j * 128) * 128;
    gemm_tile(smem,
              [=](int r, int kt) { const int k = kt < nE ? kt : 16 + kt - nE; return a0 + (long)r * 1152 + k * 64; },
              [=](int r, int kt) -> const bf16_t* {
                if (kt < nE) { const int tt = 8 * j + (r >> 4), co = r & 15; return e0 + co * 2048 + (63 - tt) * 16 + kt * 64; }
                return c0 + (long)r * 128 + (kt - nE) * 64;
              },
              nE + 2,
              [=](int row0, int col, float4 v0, float4 v1) {
#pragma unroll
                for (int q = 0; q < 4; ++q) {
                  const int n = mi * 128 + row0 + q;
                  if (n < 528) {
                    const int c0_ = col, c1_ = col + 32;
                    const long tok0 = (long)n * 64 + 8 * j + (c0_ >> 4), tok1 = (long)n * 64 + 8 * j + (c1_ >> 4);
                    Z[tok0 * 1024 + g * 16 + (c0_ & 15)] = f2bf(gelu_t(f4get(v0, q)));
                    Z[tok1 * 1024 + g * 16 + (c1_ & 15)] = f2bf(gelu_t(f4get(v1, q)));
                  }
                }
              });
  }
}

template <class EPI>
DI void run_gemm(bf16_t* smem, const bf16_t* A, int lda, const bf16_t* B, int ldb, int mtiles, int ntiles, int nkt, EPI epi) {
  const int G_ = gridDim.x;
  const int vb_ = ((G_ & 7) == 0) ? (int)((blockIdx.x & 7) * (G_ >> 3) + (blockIdx.x >> 3)) : (int)blockIdx.x;
  for (int t = vb_; t < mtiles * ntiles; t += G_) {
    const int mt = t / ntiles, nt = t % ntiles;
    const bf16_t* a0 = A + (long)mt * 128 * lda;
    const bf16_t* b0 = B + (long)nt * 128 * ldb;
    gemm_tile(smem, [=](int r, int kt) { return a0 + (long)r * lda + kt * 64; }, [=](int r, int kt) { return b0 + (long)r * ldb + kt * 64; }, nkt,
              [=](int row0, int col, float4 v0, float4 v1) { epi(mt * 128 + row0, nt * 128 + col, v0, v1); });
  }
}

DI void resid_add(const P& p, const float* gate, int row0, int col, float4 v0, float4 v1, bool part) {
  const float* gb = gate + (long)batch_of(row0) * 24576;
  const float g0 = 1.f + gb[col], g1 = 1.f + gb[col + 32];
  if (part) {
#pragma unroll
    for (int j = 0; j < 4; ++j) {
      float* x = p.out + (long)(row0 + j) * 1024;
      atomicAdd(x + col, g0 * f4get(v0, j));
      atomicAdd(x + col + 32, g1 * f4get(v1, j));
    }
  } else {
#pragma unroll
    for (int j = 0; j < 4; ++j) {
      float* x = p.out + (long)(row0 + j) * 1024;
      x[col] += g0 * f4get(v0, j);
      x[col + 32] += g1 * f4get(v1, j);
    }
  }
}

DI void phase_glu(const P& p, bf16_t* smem) {
  const float* gate = mod_ptr(p, 0, 2);
  run_gemm256<false>(smem, (const bf16_t*)(p.ws + W_BIG + B_Z), 1024, (const bf16_t*)(p.ws + W_GLU), 1024, 132, 16, 16,
           [=](int row0, int col, float4 v0, float4 v1, bool) {
             const int oc = (col >> 6) * 32 + (col & 31);
             const float g0 = 1.f + gate[(long)batch_of(row0) * 24576 + oc];
#pragma unroll
             for (int j = 0; j < 4; ++j) {
               float* x = p.out + (long)(row0 + j) * 1024 + oc;
               *x += g0 * f4get(v0, j) * sigmoid_f(f4get(v1, j));
             }
           });
}

DI void phase_mlp_up(const P& p, bf16_t* smem, int layer) {
  bf16_t* act = (bf16_t*)(p.ws + W_BIG + B_ACT);
  run_gemm256<false>(smem, (const bf16_t*)(p.ws + W_H), 1024, (const bf16_t*)(p.ws + W_WUP) + (long)layer * 4096 * 1024, 1024, 132, 32, 16,
           [=](int row0, int col, float4 v0, float4 v1, bool) {
#pragma unroll
             for (int j = 0; j < 4; ++j) {
               const float a = fmaxf(f4get(v0, j), 0.f), b = fmaxf(f4get(v1, j), 0.f);
               act[(long)(row0 + j) * 4096 + col] = f2bf(a * a);
               act[(long)(row0 + j) * 4096 + col + 32] = f2bf(b * b);
             }
           });
}

DI void phase_mlp_down(const P& p, bf16_t* smem, int layer) {
  const float* gate = mod_ptr(p, layer, 5);
  run_gemm256<true>(smem, (const bf16_t*)(p.ws + W_BIG + B_ACT), 4096, (const bf16_t*)(p.ws + W_WDN) + (long)layer * 1024 * 4096, 4096, 132, 8, 64,
           [=](int row0, int col, float4 v0, float4 v1, bool part) { resid_add(p, gate, row0, col, v0, v1, part); });
}

DI void phase_proj_resid(const P& p, bf16_t* smem, const bf16_t* A, int K, const bf16_t* B, int layer) {
  const float* gate = mod_ptr(p, layer, 2);
  run_gemm256<true>(smem, A, K, B, K, 132, 8, K / 64, [=](int row0, int col, float4 v0, float4 v1, bool part) { resid_add(p, gate, row0, col, v0, v1, part); });
}

DI int vperm_key(int key) { const int q = (key >> 2) & 3; const int q2 = ((q & 1) << 1) | (q >> 1); return (key & ~15) | (q2 << 2); }
DI void store_t4(bf16_t* dst, float4 v) { *(uint2*)dst = make_uint2(pack2(v.x, v.y), pack2(v.z, v.w)); }

DI void phase_qkv(const P& p, bf16_t* smem) {
  unsigned char* big = p.ws + W_BIG;
  bf16_t* Qb = (bf16_t*)(big + B_QB);
  bf16_t* Kb = (bf16_t*)(big + B_KB);
  bf16_t* VT = (bf16_t*)(big + B_VTD);
  const float qscale = 0.125f * L2E;
  run_gemm(smem, (const bf16_t*)(p.ws + W_H), 1024, (const bf16_t*)(p.ws + W_QKV), 1024, 264, 24, 16,
           [=](int row0, int col, float4 v0, float4 v1) {
             const int region = col >> 10;
             if (region < 2) {
               const int d = col & 31;
               const float invf = exp2f(-(float)d * (13.287712379549449f / 32.f));
#pragma unroll
               for (int j = 0; j < 4; ++j) {
                 const int row = row0 + j;
                 float c, s;
                 rope_cs(pos_of(row), invf, c, s);
                 const float x1 = f4get(v0, j), x2 = f4get(v1, j);
                 const float o1 = x1 * c - x2 * s, o2 = x1 * s + x2 * c;
                 if (region == 0) {
                   Qb[(long)row * 1024 + col] = f2bf(o1 * qscale);
                   Qb[(long)row * 1024 + col + 32] = f2bf(o2 * qscale);
                 } else {
                   const int kc = col - 1024;
                   float* ko = (row < NTP) ? p.out + O_DKP + (long)row * 1024 : p.out + O_DKS + (long)(row - NTP) * 1024;
                   ko[kc] = o1; ko[kc + 32] = o2;
                   const long kr = krow_of(row);
                   Kb[kr * 1024 + kc] = f2bf(o1);
                   Kb[kr * 1024 + kc + 32] = f2bf(o2);
                 }
               }
             } else {
               const int vc = col - 2048;
#pragma unroll
               for (int j = 0; j < 4; ++j) {
                 const int row = row0 + j;
                 float* vo = (row < NTP) ? p.out + O_DVP + (long)row * 1024 : p.out + O_DVS + (long)(row - NTP) * 1024;
                 vo[vc] = f4get(v0, j); vo[vc + 32] = f4get(v1, j);
               }
               long base; int Lk, key;
               if (row0 < NTP) { const int b = row0 >> 13; key = row0 & 8191; Lk = 8192; base = (long)b * 1024 * 8192; }
               else { const int b = (row0 - NTP) >> 6; key = 4096 + ((row0 - NTP) & 63); Lk = SLK; base = 4l * 1024 * 8192 + (long)b * 1024 * SLK; }
               store_t4(VT + base + (long)vc * Lk + vperm_key(key), v0);
               store_t4(VT + base + (long)(vc + 32) * Lk + vperm_key(key), v1);
             }
           });
  {
    const float* ck = p.in[6]; const float* cv = p.in[7];
    const long gt = (long)blockIdx.x * 256 + threadIdx.x, gs = (long)gridDim.x * 256;
    for (long idx = gt; idx < 16l * 4096 * 128; idx += gs) {
      const long rowc = idx >> 7; const int c8 = (int)(idx & 127) * 8;
      const int b = (int)(rowc >> 12), jk = (int)(rowc & 4095);
      const float4 a = *(const float4*)(ck + rowc * 1024 + c8), bq = *(const float4*)(ck + rowc * 1024 + c8 + 4);
      uint4 o = {pack2(a.x, a.y), pack2(a.z, a.w), pack2(bq.x, bq.y), pack2(bq.z, bq.w)};
      *(uint4*)(Kb + ((long)NTP + (long)b * SLK + jk) * 1024 + c8) = o;
    }
    for (long idx = gt; idx < 16l * 512 * 1024; idx += gs) {
      const int hd = (int)(idx & 1023); const long t = idx >> 10;
      const int kg = (int)(t & 511), b = (int)(t >> 9);
      const float* src = cv + ((long)b * 4096 + kg * 8) * 1024 + hd;
      const float v0 = src[0], v1 = src[1024], v2 = src[2048], v3 = src[3072], v4 = src[4096], v5 = src[5120], v6 = src[6144], v7 = src[7168];
      bf16_t* vd = VT + 4l * 1024 * 8192 + (long)b * 1024 * SLK + (long)hd * SLK;
      *(uint2*)(vd + vperm_key(kg * 8)) = make_uint2(pack2(v0, v1), pack2(v2, v3));
      *(uint2*)(vd + vperm_key(kg * 8 + 4)) = make_uint2(pack2(v4, v5), pack2(v6, v7));
    }
  }
}

DI void phase_mla_down(const P& p, bf16_t* smem) {
  unsigned char* big = p.ws + W_BIG;
  float* raw = (float*)(big + B_RAW);
  bf16_t* KR = (bf16_t*)(big + B_KR);
  run_gemm(smem, (const bf16_t*)(p.ws + W_H), 1024, (const bf16_t*)(p.ws + W_MD), 1024, 264, 4, 16,
           [=](int row0, int col, float4 v0, float4 v1) {
             if (col < 384) {
#pragma unroll
               for (int j = 0; j < 4; ++j) {
                 raw[(long)(row0 + j) * 384 + col] = f4get(v0, j);
                 raw[(long)(row0 + j) * 384 + col + 32] = f4get(v1, j);
               }
             } else if (col < 400) {
               const int i = col - 384;
               const float invf = exp2f(-(float)i * (13.287712379549449f / 16.f));
#pragma unroll
               for (int j = 0; j < 4; ++j) {
                 const int row = row0 + j;
                 float c, s;
                 rope_cs(pos_of(row), invf, c, s);
                 const float x1 = f4get(v0, j), x2 = f4get(v1, j);
                 const float o1 = x1 * c - x2 * s, o2 = x1 * s + x2 * c;
                 float* ko = (row < NTP) ? p.out + O_KRP + (long)row * 32 : p.out + O_KRS + (long)(row - NTP) * 32;
                 ko[i] = o1; ko[16 + i] = o2;
                 const long kr = krow_of(row);
                 KR[kr * 32 + i] = f2bf(o1); KR[kr * 32 + 16 + i] = f2bf(o2);
               }
             }
           });
  {
    bf16_t* CKV = (bf16_t*)(big + B_CKV);
    const float* cc = p.in[8]; const float* cr = p.in[9];
    const long gt = (long)blockIdx.x * 256 + threadIdx.x, gs = (long)gridDim.x * 256;
    for (long idx = gt; idx < 16l * 4096 * 16; idx += gs) {
      const long rowc = idx >> 4; const int c8 = (int)(idx & 15) * 8;
      const int b = (int)(rowc >> 12), jk = (int)(rowc & 4095);
      const float4 a = *(const float4*)(cc + rowc * 128 + c8), bq = *(const float4*)(cc + rowc * 128 + c8 + 4);
      uint4 o = {pack2(a.x, a.y), pack2(a.z, a.w), pack2(bq.x, bq.y), pack2(bq.z, bq.w)};
      *(uint4*)(CKV + ((long)NTP + (long)b * SLK + jk) * 128 + c8) = o;
    }
    for (long idx = gt; idx < 16l * 4096 * 4; idx += gs) {
      const long rowc = idx >> 2; const int c8 = (int)(idx & 3) * 8;
      const int b = (int)(rowc >> 12), jk = (int)(rowc & 4095);
      const float4 a = *(const float4*)(cr + rowc * 32 + c8), bq = *(const float4*)(cr + rowc * 32 + c8 + 4);
      uint4 o = {pack2(a.x, a.y), pack2(a.z, a.w), pack2(bq.x, bq.y), pack2(bq.z, bq.w)};
      *(uint4*)(KR + ((long)NTP + (long)b * SLK + jk) * 32 + c8) = o;
    }
  }
}

DI void phase_mla_norm(const P& p) {
  unsigned char* big = p.ws + W_BIG;
  const float* raw = (const float*)(big + B_RAW);
  bf16_t* CQ = (bf16_t*)(big + B_CQ);
  bf16_t* CKV = (bf16_t*)(big + B_CKV);
  const int lane = threadIdx.x & 63;
  const int wv = blockIdx.x * 4 + (threadIdx.x >> 6), nwv = gridDim.x * 4;
  const float4 gq = *(const float4*)(p.in[35] + lane * 4);
  const float2 gk = *(const float2*)(p.in[38] + lane * 2);
  for (int row = wv; row < NT; row += nwv) {
    const float4 q = *(const float4*)(raw + (long)row * 384 + lane * 4);
    const float2 k = *(const float2*)(raw + (long)row * 384 + 256 + lane * 2);
    const float sq = wave_sum(q.x * q.x + q.y * q.y + q.z * q.z + q.w * q.w);
    const float sk = wave_sum(k.x * k.x + k.y * k.y);
    const float rq = rsqrtf(sq * (1.f / 256.f) + NORM_EPS), rk = rsqrtf(sk * (1.f / 128.f) + NORM_EPS);
    *(uint2*)(CQ + (long)row * 256 + lane * 4) = make_uint2(pack2(q.x * rq * gq.x, q.y * rq * gq.y), pack2(q.z * rq * gq.z, q.w * rq * gq.w));
    const float c0 = k.x * rk * gk.x, c1 = k.y * rk * gk.y;
    float* co = (row < NTP) ? p.out + O_CKP + (long)row * 128 : p.out + O_CKS + (long)(row - NTP) * 128;
    *(float2*)(co + lane * 2) = make_float2(c0, c1);
    *(unsigned*)(CKV + (long)krow_of(row) * 128 + lane * 2) = pack2(c0, c1);
  }
}

DI void phase_mla_up(const P& p, bf16_t* smem) {
  unsigned char* big = p.ws + W_BIG;
  bf16_t* QM = (bf16_t*)(big + B_QM);
  bf16_t* KN = (bf16_t*)(big + B_KN);
  bf16_t* VT = (bf16_t*)(big + B_VTM);
  const float qscale = 0.10206207261596577f * L2E;
  run_gemm(smem, (const bf16_t*)(big + B_CQ), 256, (const bf16_t*)(p.ws + W_MUQ), 256, 264, 12, 4,
           [=](int row0, int col, float4 v0, float4 v1) {
             if (col < 1024) {
               const int o = (col >> 6) * 96 + (col & 63);
#pragma unroll
               for (int j = 0; j < 4; ++j) {
                 QM[(long)(row0 + j) * 1536 + o] = f2bf(f4get(v0, j) * qscale);
                 QM[(long)(row0 + j) * 1536 + o + 32] = f2bf(f4get(v1, j) * qscale);
               }
             } else {
               const int sp = (col - 1024) >> 6, ix = col & 31;
               const int head = sp * 2 + (ix >> 4), i = ix & 15;
               const float invf = exp2f(-(float)i * (13.287712379549449f / 16.f));
#pragma unroll
               for (int j = 0; j < 4; ++j) {
                 const int row = row0 + j;
                 float c, s;
                 rope_cs(pos_of(row), invf, c, s);
                 const float x1 = f4get(v0, j), x2 = f4get(v1, j);
                 QM[(long)row * 1536 + head * 96 + 64 + i] = f2bf((x1 * c - x2 * s) * qscale);
                 QM[(long)row * 1536 + head * 96 + 80 + i] = f2bf((x1 * s + x2 * c) * qscale);
               }
             }
           });
  run_gemm(smem, (const bf16_t*)(big + B_CKV), 128, (const bf16_t*)(p.ws + W_MUKV), 128, 776, 16, 2,
           [=](int row0, int col, float4 v0, float4 v1) {
             if (col < 1024) {
#pragma unroll
               for (int j = 0; j < 4; ++j) {
                 KN[(long)(row0 + j) * 1024 + col] = f2bf(f4get(v0, j));
                 KN[(long)(row0 + j) * 1024 + col + 32] = f2bf(f4get(v1, j));
               }
             } else {
               const int vc = col - 1024;
               long base; int Lk, key;
               if (row0 < NTP) { const int b = row0 >> 13; key = row0 & 8191; Lk = 8192; base = (long)b * 1024 * 8192; }
               else { const int b = (row0 - NTP) / SLK; key = (row0 - NTP) - b * SLK; Lk = SLK; base = 4l * 1024 * 8192 + (long)b * 1024 * SLK; }
               store_t4(VT + base + (long)vc * Lk + vperm_key(key), v0);
               store_t4(VT + base + (long)(vc + 32) * Lk + vperm_key(key), v1);
             }
           });
}

DI void phase_sgu_in(const P& p, bf16_t* smem) {
  unsigned char* big = p.ws + W_BIG;
  bf16_t* U = (bf16_t*)(big + B_U);
  bf16_t* VR = (bf16_t*)(big + B_VRAW);
  run_gemm256<false>(smem, (const bf16_t*)(p.ws + W_H), 1024, (const bf16_t*)(p.ws + W_SIN), 1024, 132, 32, 16,
           [=](int row0, int col, float4 v0, float4 v1, bool) {
             bf16_t* dst = (col < 2048) ? U + col : VR + (col - 2048);
#pragma unroll
             for (int j = 0; j < 4; ++j) {
               dst[(long)(row0 + j) * 2048] = f2bf(gelu_t(f4get(v0, j)));
               dst[(long)(row0 + j) * 2048 + 32] = f2bf(gelu_t(f4get(v1, j)));
             }
           });
}

DI void phase_sgu_norm(const P& p, float* smf) {
  unsigned char* big = p.ws + W_BIG;
  const bf16_t* VR = (const bf16_t*)(big + B_VRAW);
  bf16_t* VTS = (bf16_t*)(big + B_VTS);
  const float* gv = p.in[43];
  const int lane = threadIdx.x & 63, wave = threadIdx.x >> 6;
  for (int itq = blockIdx.x; itq < 528 * 4; itq += gridDim.x) {
    const int c64 = itq >> 2, qd = itq & 3;
    __syncthreads();
    for (int s = wave; s < 64; s += 4) {
      const bf16_t* rowp = VR + (long)(c64 * 64 + s) * 2048;
      float ss = 0.f;
#pragma unroll
      for (int i = 0; i < 4; ++i) {
        const uint4 q = *(const uint4*)(rowp + lane * 8 + 512 * i);
        const unsigned w[4] = {q.x, q.y, q.z, q.w};
#pragma unroll
        for (int e = 0; e < 4; ++e) {
          const float a = __uint_as_float(w[e] << 16), b = __uint_as_float(w[e] & 0xffff0000u);
          ss += a * a + b * b;
        }
      }
      ss = wave_sum(ss);
      if (lane == 0) smf[s] = rsqrtf(ss * (1.f / 2048.f) + NORM_EPS);
    }
    __syncthreads();
    for (int task = threadIdx.x; task < 128 * 8; task += 256) {
      const int d4 = (qd * 128 + (task & 127)) * 4, sg = task >> 7;
      const float4 g4 = *(const float4*)(gv + d4);
      float v[8][4];
#pragma unroll
      for (int j = 0; j < 8; ++j) {
        const int s = sg * 8 + j;
        const uint2 q = *(const uint2*)(VR + (long)(c64 * 64 + s) * 2048 + d4);
        const float rs = smf[s];
        v[j][0] = __uint_as_float(q.x << 16) * rs * g4.x;
        v[j][1] = __uint_as_float(q.x & 0xffff0000u) * rs * g4.y;
        v[j][2] = __uint_as_float(q.y << 16) * rs * g4.z;
        v[j][3] = __uint_as_float(q.y & 0xffff0000u) * rs * g4.w;
        if (c64 >= 512) *(float4*)(p.out + O_SGV + (long)((c64 - 512) * 64 + s) * 2048 + d4) = make_float4(v[j][0], v[j][1], v[j][2], v[j][3]);
      }
#pragma unroll
      for (int e = 0; e < 4; ++e) {
        uint4 o = {pack2(v[0][e], v[1][e]), pack2(v[2][e], v[3][e]), pack2(v[4][e], v[5][e]), pack2(v[6][e], v[7][e])};
        *(uint4*)(VTS + ((long)c64 * 2048 + d4 + e) * 64 + sg * 8) = o;
      }
    }
  }
}

DI void phase_sgu_spatial(const P& p, bf16_t* smem) {
  unsigned char* big = p.ws + W_BIG;
  const bf16_t* U = (const bf16_t*)(big + B_U);
  const bf16_t* VTS = (const bf16_t*)(big + B_VTS);
  bf16_t* G = (bf16_t*)(big + B_G);
  const float* bs = p.in[45];
  for (int t = blockIdx.x; t < 264 * 16; t += gridDim.x) {
    const int mt = t >> 4, g = (t >> 1) & 7, dt = t & 1;
    const bf16_t* a0 = (const bf16_t*)(p.ws + (mt < 256 ? W_WS1 : W_WS2)) + g * 128 * 128;
    const bf16_t* b0 = VTS + ((long)mt * 2 * 2048 + g * 256 + dt * 128) * 64;
    const bool prompt = mt < 256;
    gemm_tile(smem, [=](int r, int kt) { return a0 + r * 128 + kt * 64; }, [=](int r, int kt) { return b0 + (long)kt * 2048 * 64 + r * 64; }, 2,
              [=](int row0, int col, float4 v0, float4 v1) {
                const int gc = g * 256 + dt * 128 + col;
#pragma unroll
                for (int j = 0; j < 4; ++j) {
                  const int tr = row0 + j;
                  const float bias = bs[g * 128 + (prompt ? tr : (tr & 63))];
                  const long o = (long)(mt * 128 + tr) * 2048 + gc;
                  G[o] = f2bf(bf2f(U[o]) * (f4get(v0, j) + bias));
                  G[o + 32] = f2bf(bf2f(U[o + 32]) * (f4get(v1, j) + bias));
                }
              });
  }
}

DI void phase_final_norm(const P& p) {
  const int lane = threadIdx.x & 63;
  const int wv = blockIdx.x * 4 + (threadIdx.x >> 6), nwv = gridDim.x * 4;
  const float* gam = p.in[16];
  for (int row = wv; row < NT; row += nwv) {
    float* x = p.out + (long)row * 1024;
    float4 v[4];
    float ss = 0.f;
#pragma unroll
    for (int i = 0; i < 4; ++i) {
      v[i] = *(const float4*)(x + lane * 4 + 256 * i);
      ss += v[i].x * v[i].x + v[i].y * v[i].y + v[i].z * v[i].z + v[i].w * v[i].w;
    }
    ss = wave_sum(ss);
    const float rinv = rsqrtf(ss * (1.f / 1024.f) + NORM_EPS);
#pragma unroll
    for (int i = 0; i < 4; ++i) {
      const int col = lane * 4 + 256 * i;
      const float4 g4 = *(const float4*)(gam + col);
      *(float4*)(x + col) = make_float4(v[i].x * rinv * g4.x, v[i].y * rinv * g4.y, v[i].z * rinv * g4.z, v[i].w * rinv * g4.w);
    }
  }
}

DI bf16x8 pack8(const f32x16& x, int s) {
  unsigned a = pack2(x[8 * s], x[8 * s + 1]), b = pack2(x[8 * s + 2], x[8 * s + 3]), c = pack2(x[8 * s + 4], x[8 * s + 5]), d = pack2(x[8 * s + 6], x[8 * s + 7]);
  uint4 u = {a, b, c, d};
  return __builtin_bit_cast(bf16x8, u);
}

DI unsigned xb_xcc_id_fwd() { return (unsigned)__builtin_amdgcn_s_getreg((3 << 11) | 20) & 0xFu; }
template <bool MLA>
DI void phase_attn(const P& p, bf16_t* smem) {
  constexpr int NKS = MLA ? 6 : 4;
  constexpr int NDT = MLA ? 2 : 4;
  constexpr int NLD = MLA ? 9 : 8;
  unsigned char* big = p.ws + W_BIG;
  const bf16_t* Q = (const bf16_t*)(big + (MLA ? B_QM : B_QB));
  const bf16_t* KK = (const bf16_t*)(big + (MLA ? B_KN : B_KB));
  const bf16_t* KR = (const bf16_t*)(big + B_KR);
  const bf16_t* VT = (const bf16_t*)(big + (MLA ? B_VTM : B_VTD));
  bf16_t* OB = (bf16_t*)(big + (MLA ? B_OBM : B_OB));
  const float lam = *(const float*)(p.ws + W_LAM);
  const float* gsub = p.in[32];
  const int tid = threadIdx.x, lane = tid & 63, wave = tid >> 6;
  const int wp = wave >> 1, wq = wave & 1, r = lane & 31, hh = lane >> 5;
  constexpr int L_K0 = 0, L_K1 = 4608, L_KR = 9216, L_V0 = MLA ? 11776 : 9216, L_V1 = 16384;
  __shared__ int s_item;
  unsigned* qctr = (unsigned*)(p.ws + W_CTRL) + 3584 + (MLA ? 64 : 0);
  const int xs = (int)(xb_xcc_id_fwd() & 7u);
  for (int pass = 0; pass < 8; ++pass) {
  const int hx = (xs + pass) & 7;
  for (;;) {
    if (tid == 0) s_item = (int)atomicAdd(&qctr[hx * 8], 1u);
    __syncthreads();
    const int jq = s_item;
    __syncthreads();
    if (jq >= 528) break;
    int b, qrow0, ntiles, Lk; long R0, vbase;
    if (jq < 16) {
      b = jq; qrow0 = NTP + b * 64; ntiles = 65; Lk = SLK;
      R0 = (long)NTP + (long)b * SLK; vbase = 4l * 1024 * 8192 + (long)b * 1024 * SLK;
    } else {
      const int i = jq - 16; const int qc = 127 - (i >> 2); b = i & 3;
      qrow0 = b * 8192 + qc * 64; ntiles = qc + 1; Lk = 8192; R0 = (long)b * 8192; vbase = (long)b * 1024 * 8192;
    }
    bf16x8 qf[NKS];
    {
      const long qr = (long)(qrow0 + wq * 32 + r);
      const bf16_t* qp = MLA ? Q + qr * 1536 + (hx * 2 + wp) * 96 + 8 * hh : Q + qr * 1024 + (hx * 2 + wp) * 64 + 8 * hh;
#pragma unroll
      for (int ks = 0; ks < NKS; ++ks) qf[ks] = *(const bf16x8*)(qp + ks * 16);
    }
    f32x16 O[NDT];
#pragma unroll
    for (int d = 0; d < NDT; ++d)
#pragma unroll
      for (int i = 0; i < 16; ++i) O[d][i] = 0.f;
    float m_run = -1e30f, l_run = 0.f;
    u32x4 ld[NLD];
#define ATT_GLOAD(KT)                                                                                                   \
  {                                                                                                                     \
    const long kr0 = R0 + (long)(KT) * 64;                                                                              \
    _Pragma("unroll") for (int j = 0; j < 4; ++j) {                                                                     \
      const int c = j >> 1, id = tid + 256 * (j & 1), key = id >> 3, ch = id & 7;                                       \
      ld[j] = *(const u32x4*)(KK + (kr0 + key) * 1024 + (hx * 2 + c) * 64 + ch * 8);                                    \
    }                                                                                                                   \
    if (!MLA) {                                                                                                         \
      _Pragma("unroll") for (int i = 0; i < 4; ++i) {                                                                   \
        const int id = tid + 256 * i, dv = id >> 3, ch = id & 7;                                                        \
        ld[4 + i] = *(const u32x4*)(VT + vbase + (long)(hx * 128 + dv) * Lk + (KT) * 64 + ch * 8);                      \
      }                                                                                                                 \
    } else {                                                                                                            \
      _Pragma("unroll") for (int j = 0; j < 4; ++j) {                                                                   \
        const int c = j >> 1, id = tid + 256 * (j & 1), dv = id >> 3, ch = id & 7;                                      \
        ld[4 + j] = *(const u32x4*)(VT + vbase + (long)((hx * 2 + c) * 64 + dv) * Lk + (KT) * 64 + ch * 8);             \
      }                                                                                                                 \
      ld[NLD - 1] = *(const u32x4*)(KR + (kr0 + (tid >> 2)) * 32 + (tid & 3) * 8);                                      \
    }                                                                                                                   \
  }
#define ATT_SWRITE()                                                                                                    \
  {                                                                                                                     \
    _Pragma("unroll") for (int j = 0; j < 4; ++j) {                                                                     \
      const int c = j >> 1, id = tid + 256 * (j & 1), key = id >> 3, ch = id & 7;                                       \
      *(u32x4*)(smem + (c ? L_K1 : L_K0) + key * LST + ch * 8) = ld[j];                                                 \
    }                                                                                                                   \
    if (!MLA) {                                                                                                         \
      _Pragma("unroll") for (int i = 0; i < 4; ++i) {                                                                   \
        const int id = tid + 256 * i, dv = id >> 3, ch = id & 7;                                                        \
        *(u32x4*)(smem + L_V0 + dv * LST + ch * 8) = ld[4 + i];                                                         \
      }                                                                                                                 \
    } else {                                                                                                            \
      _Pragma("unroll") for (int j = 0; j < 4; ++j) {                                                                   \
        const int c = j >> 1, id = tid + 256 * (j & 1), dv = id >> 3, ch = id & 7;                                      \
        *(u32x4*)(smem + (c ? L_V1 : L_V0) + dv * LST + ch * 8) = ld[4 + j];                                            \
      }                                                                                                                 \
      *(u32x4*)(smem + L_KR + (tid >> 2) * 40 + (tid & 3) * 8) = ld[NLD - 1];                                           \
    }                                                                                                                   \
  }
    ATT_GLOAD(0)
    const bf16_t* sK = smem + (wp ? L_K1 : L_K0);
    const bf16_t* sV = smem + ((MLA && wp) ? L_V1 : L_V0);
    for (int kt = 0; kt < ntiles; ++kt) {
      __syncthreads();
      ATT_SWRITE()
      __syncthreads();
      if (kt + 1 < ntiles) ATT_GLOAD(kt + 1)
      f32x16 st[2];
#pragma unroll
      for (int mt = 0; mt < 2; ++mt) {
#pragma unroll
        for (int i = 0; i < 16; ++i) st[mt][i] = 0.f;
#pragma unroll
        for (int ks = 0; ks < NKS; ++ks) {
          bf16x8 a;
          if (ks < 4) a = *(const bf16x8*)(sK + (mt * 32 + r) * LST + ks * 16 + 8 * hh);
          else a = *(const bf16x8*)(smem + L_KR + (mt * 32 + r) * 40 + (ks - 4) * 16 + 8 * hh);
          st[mt] = MFMA(a, qf[ks], st[mt]);
        }
      }
      float mloc = st[0][0];
#pragma unroll
      for (int i = 1; i < 16; ++i) mloc = fmaxf(mloc, st[0][i]);
#pragma unroll
      for (int i = 0; i < 16; ++i) mloc = fmaxf(mloc, st[1][i]);
      mloc = fmaxf(mloc, __shfl_xor(mloc, 32));
      const bool need = mloc > m_run + 8.f;
      if (__any(need)) {
        const float mnew = need ? mloc : m_run;
        const float alpha = __builtin_amdgcn_exp2f(m_run - mnew);
        m_run = mnew;
        l_run *= alpha;
#pragma unroll
        for (int d = 0; d < NDT; ++d)
#pragma unroll
          for (int i = 0; i < 16; ++i) O[d][i] *= alpha;
      }
      float ps = 0.f;
#pragma unroll
      for (int mt = 0; mt < 2; ++mt)
#pragma unroll
        for (int i = 0; i < 16; ++i) { const float e = __builtin_amdgcn_exp2f(st[mt][i] - m_run); st[mt][i] = e; ps += e; }
      l_run += ps;
#pragma unroll
      for (int k2 = 0; k2 < 4; ++k2) {
        const bf16x8 pf = pack8(st[k2 >> 1], k2 & 1);
#pragma unroll
        for (int d = 0; d < NDT; ++d) {
          const bf16x8 va = *(const bf16x8*)(sV + (d * 32 + r) * LST + 16 * k2 + 8 * hh);
          O[d] = MFMA(va, pf, O[d]);
        }
      }
    }
    const float ltot = l_run + __shfl_xor(l_run, 32);
    const float linv = 1.f / ltot;
    const long orow = (long)(qrow0 + wq * 32 + r);
    if (MLA) {
#pragma unroll
      for (int d = 0; d < NDT; ++d)
#pragma unroll
        for (int g = 0; g < 4; ++g) {
          uint2 o = {pack2(O[d][4 * g] * linv, O[d][4 * g + 1] * linv), pack2(O[d][4 * g + 2] * linv, O[d][4 * g + 3] * linv)};
          *(uint2*)(OB + orow * 1024 + (hx * 2 + wp) * 64 + d * 32 + 8 * g + 4 * hh) = o;
        }
    } else {
      float* xs = (float*)smem;
      __syncthreads();
      if (wp == 1) {
#pragma unroll
        for (int d = 0; d < NDT; ++d)
#pragma unroll
          for (int i = 0; i < 16; ++i) xs[(wq * 64 + d * 16 + i) * 64 + lane] = O[d][i] * linv;
      }
      __syncthreads();
      if (wp == 0) {
        float ss = 0.f;
#pragma unroll
        for (int d = 0; d < NDT; ++d)
#pragma unroll
          for (int i = 0; i < 16; ++i) {
            const float o = O[d][i] * linv - lam * xs[(wq * 64 + d * 16 + i) * 64 + lane];
            O[d][i] = o; ss += o * o;
          }
        ss += __shfl_xor(ss, 32);
        const float rinv = rsqrtf(ss * (1.f / 128.f) + NORM_EPS) * (1.f - LAMBDA_INIT);
#pragma unroll
        for (int d = 0; d < NDT; ++d)
#pragma unroll
          for (int g = 0; g < 4; ++g) {
            const int dv = d * 32 + 8 * g + 4 * hh;
            const float4 gs4 = *(const float4*)(gsub + dv);
            uint2 o = {pack2(O[d][4 * g] * rinv * gs4.x, O[d][4 * g + 1] * rinv * gs4.y), pack2(O[d][4 * g + 2] * rinv * gs4.z, O[d][4 * g + 3] * rinv * gs4.w)};
            *(uint2*)(OB + orow * 1024 + hx * 128 + dv) = o;
          }
      }
    }
  }
  }
}


#define XB_TMO      128
#define XB_XCNT(j)  (256  + 64 * (j))
#define XB_XSUB(j)  (1280 + 64 * (j))
#define XB_XGEN(j)  (2304 + 64 * (j))
#define XB_TOP      3328
#define XB_TOPGEN   3392
#define XCD_BAR_WORDS 3456
#define XB_SPIN_CAP (1u << 22)
#define LAS __attribute__((address_space(3)))
DI unsigned xb_ld(unsigned* p) { return __hip_atomic_load(p, __ATOMIC_RELAXED, __HIP_MEMORY_SCOPE_AGENT); }
DI unsigned xb_add(unsigned* p, unsigned v) { return __hip_atomic_fetch_add(p, v, __ATOMIC_RELAXED, __HIP_MEMORY_SCOPE_AGENT); }
DI unsigned xb_xcc_id() { return (unsigned)__builtin_amdgcn_s_getreg((3 << 11) | 20) & 0xFu; }
#define XB_SPIN(cond, bar) do { unsigned _sp = 0; while (cond) { __builtin_amdgcn_s_sleep(1); \
    if ((++_sp & 255u) == 0u) { if (xb_ld(&(bar)[XB_TMO])) break; if (_sp > XB_SPIN_CAP) { atomicAdd(&(bar)[XB_TMO], 1u); break; } } } } while (0)
struct XcdBarrier { unsigned* bar; unsigned x; volatile LAS unsigned* st; };
DI XcdBarrier xcd_barrier_post(unsigned* bar, volatile LAS unsigned* st) {
  XcdBarrier b; b.bar = bar; b.x = xb_xcc_id(); b.st = st;
  if (threadIdx.x == 0) (void)xb_add(&bar[XB_XCNT(b.x)], 1u);
  return b;
}
DI void xcd_barrier_complete(unsigned* bar, unsigned x, unsigned& nloc, unsigned& nx) {
  const unsigned G = gridDim.x * gridDim.y * gridDim.z;
  unsigned sum, cnt, mine, sp = 0u;
  for (;;) {
    sum = 0u; cnt = 0u; mine = 0u;
#pragma unroll
    for (unsigned j = 0; j < 16; ++j) { const unsigned c = xb_ld(&bar[XB_XCNT(j)]); sum += c; cnt += (c > 0u) ? 1u : 0u; mine = (j == x) ? c : mine; }
    if (sum == G) break;
    __builtin_amdgcn_s_sleep(1);
    if ((++sp & 255u) == 0u) { if (xb_ld(&bar[XB_TMO])) break; if (sp > XB_SPIN_CAP) { atomicAdd(&bar[XB_TMO], 1u); break; } }
  }
  nloc = mine > 0u ? mine : 1u; nx = cnt > 0u ? cnt : 1u;
}
DI void xcd_barrier(const XcdBarrier& b) {
  asm volatile("s_waitcnt vmcnt(0)" ::: "memory");
  __syncthreads();
  if (threadIdx.x == 0) {
    unsigned* bar = b.bar;
    __builtin_amdgcn_s_waitcnt(0);
    unsigned nloc = b.st[0], nx = b.st[1];
    if (nloc == 0u) { xcd_barrier_complete(bar, b.x, nloc, nx); b.st[0] = nloc; b.st[1] = nx; }
    const unsigned old = xb_add(&bar[XB_XSUB(b.x)], 1u);
    const unsigned gen = old / nloc;
    if (old + 1u == (gen + 1u) * nloc) {
      __builtin_amdgcn_fence(__ATOMIC_RELEASE, "agent");
      asm volatile("s_waitcnt vmcnt(0)" ::: "memory");
      const unsigned og = xb_add(&bar[XB_TOP], 1u);
      const unsigned tg = og / nx;
      if (og + 1u == (tg + 1u) * nx) xb_add(&bar[XB_TOPGEN], 1u);
      else XB_SPIN(xb_ld(&bar[XB_TOPGEN]) == tg, bar);
      __builtin_amdgcn_fence(__ATOMIC_ACQUIRE, "agent");
      xb_add(&bar[XB_XGEN(b.x)], 1u);
      asm volatile("s_waitcnt vmcnt(0)" ::: "memory");
    } else {
      XB_SPIN(xb_ld(&bar[XB_XGEN(b.x)]) == gen, bar);
      __builtin_amdgcn_fence(__ATOMIC_ACQUIRE, "agent");
      asm volatile("s_waitcnt vmcnt(0)" ::: "memory");
    }
  }
  __syncthreads();
}

constexpr int NPH = 35;
__global__ void __launch_bounds__(256, 2) mk_forward(P p) {
  __shared__ __attribute__((aligned(16))) unsigned char smem_raw[73728];
  cg::grid_group grid = cg::this_grid();
  __shared__ uint4 xb_words;
  if (threadIdx.x == 0) xb_words = make_uint4(0u, 0u, 0u, 0u);
  __syncthreads();
  XcdBarrier xb;
  xb.bar = (unsigned*)(p.ws + W_CTRL); xb.x = 0; xb.st = (volatile LAS unsigned*)&xb_words;
  if (p.hi - p.lo > 1) xb = xcd_barrier_post((unsigned*)(p.ws + W_CTRL), (volatile LAS unsigned*)&xb_words);
  bf16_t* smem = (bf16_t*)smem_raw;
  float* smf = (float*)smem_raw;
  unsigned char* big = p.ws + W_BIG;
  int ph = 0;
#ifdef PROBE_DUP_UP
#define PROBE_UP(l) __syncthreads(); phase_mlp_up(p, smem, l)
#else
#define PROBE_UP(l)
#endif
#ifdef PROBE_DUP_ATTN
#define PROBE_AT(m) __syncthreads(); phase_attn<m>(p, smem)
#else
#define PROBE_AT(m)
#endif
#ifndef ONLY_PH
#define ONLY_PH -1
#endif
#ifndef DUPMASK
#define DUPMASK 0ull
#endif
#define PH(...) { if ((ONLY_PH < 0 || ph == ONLY_PH) && ph >= p.lo && ph < p.hi) { __VA_ARGS__; if ((DUPMASK >> ph) & 1ull) { __syncthreads(); __VA_ARGS__; } } ++ph; if (ph > p.lo && ph < p.hi) { if (ph == 1) grid.sync(); else xcd_barrier(xb); } }
  PH(phase0(p, smf))
  PH(phase1(p))
  PH(phase_modulate<1>(p, 0, 0))
  PH(phase_s5a(p, smem))
  PH(phase_s5_carry(p))
  PH(phase_s5b(p, smem))
  PH(phase_glu(p, smem))
  PH(phase_modulate<0>(p, 0, 1))
  PH(phase_mlp_up(p, smem, 0); PROBE_UP(0))
  PH(phase_mlp_down(p, smem, 0))
  PH(phase_modulate<0>(p, 1, 0))
  PH(phase_qkv(p, smem))
  PH(phase_attn<false>(p, smem); PROBE_AT(false))
  PH(phase_proj_resid(p, smem, (const bf16_t*)(big + B_OB), 1024, (const bf16_t*)(p.ws + W_DWO), 1))
  PH(phase_modulate<0>(p, 1, 1))
  PH(phase_mlp_up(p, smem, 1); PROBE_UP(1))
  PH(phase_mlp_down(p, smem, 1))
  PH(phase_modulate<0>(p, 2, 0))
  PH(phase_mla_down(p, smem))
  PH(phase_mla_norm(p))
  PH(phase_mla_up(p, smem))
  PH(phase_attn<true>(p, smem); PROBE_AT(true))
  PH(phase_proj_resid(p, smem, (const bf16_t*)(big + B_OBM), 1024, (const bf16_t*)(p.ws + W_MWO), 2))
  PH(phase_modulate<0>(p, 2, 1))
  PH(phase_mlp_up(p, smem, 2); PROBE_UP(2))
  PH(phase_mlp_down(p, smem, 2))
  PH(phase_modulate<0>(p, 3, 0))
  PH(phase_sgu_in(p, smem))
  PH(phase_sgu_norm(p, smf))
  PH(phase_sgu_spatial(p, smem))
  PH(phase_proj_resid(p, smem, (const bf16_t*)(big + B_G), 2048, (const bf16_t*)(p.ws + W_SOUT), 3))
  PH(phase_modulate<0>(p, 3, 1))
  PH(phase_mlp_up(p, smem, 3); PROBE_UP(3))
  PH(phase_mlp_down(p, smem, 3))
  PH(phase_final_norm(p))
#undef PH
}

extern "C" void kernel_launch(void* const* d_in, const int* in_sizes, int n_in, void* d_out, int out_size, void* d_ws, size_t ws_size,
                              hipStream_t stream) {
  static int grid_blocks = 0;
  if (!grid_blocks) {
    int dev = 0, cus = 0, per_cu = 0;
    hipGetDevice(&dev);
    hipDeviceGetAttribute(&cus, hipDeviceAttributeMultiprocessorCount, dev);
    hipOccupancyMaxActiveBlocksPerMultiprocessor(&per_cu, mk_forward, 256, 0);
    if (per_cu < 1) per_cu = 1;
    if (per_cu > 2) per_cu = 2;
    grid_blocks = cus * per_cu;
    if (ws_size < WS_NEED) fprintf(stderr, "kernel_launch: workspace too small: %zu < %zu\n", ws_size, (size_t)WS_NEED);
  }
  P p{};
  for (int i = 0; i < 47; ++i) p.in[i] = (const float*)d_in[i];
  p.out = (float*)d_out;
  p.ws = (unsigned char*)d_ws;
#if MK_SINGLE
  (void)hipMemsetAsync(d_ws, 0, 16384, stream);
  p.lo = 0; p.hi = NPH;
  void* args[] = {&p};
  hipError_t e = hipLaunchCooperativeKernel((void*)mk_forward, dim3(grid_blocks), dim3(256), args, 0, stream);
  if (e != hipSuccess) fprintf(stderr, "cooperative launch failed: %s (grid %d)\n", hipGetErrorString(e), grid_blocks);
#else
  for (int ph = 0; ph < NPH; ++ph) {
    p.lo = ph; p.hi = ph + 1;
    hipLaunchKernelGGL(mk_forward, dim3(grid_blocks), dim3(256), 0, stream, p);
  }
#endif
}
```

```cpp
#include <hip/hip_runtime.h>
#include <hip/hip_cooperative_groups.h>
#include <stdint.h>
#include <stdio.h>
namespace cg = cooperative_groups;

#ifndef MK_SINGLE
#define MK_SINGLE 1
#endif

typedef unsigned short bf16_t;
typedef __attribute__((ext_vector_type(8))) short bf16x8;
typedef __attribute__((ext_vector_type(4))) short s16x4;
typedef __attribute__((ext_vector_type(4))) unsigned u32x4;
typedef __attribute__((ext_vector_type(16))) float f32x16;
typedef __bf16 bf2_t __attribute__((ext_vector_type(2)));
typedef float fl2_t __attribute__((ext_vector_type(2)));
#define DI __device__ __forceinline__
#define MFMA(a, b, c) __builtin_amdgcn_mfma_f32_32x32x16_bf16((a), (b), (c), 0, 0, 0)

constexpr int NTP = 32768, NTS = 1024, NT = 33792;
constexpr int SLK = 4160;
constexpr int KROWS = 99328;
constexpr float NORM_EPS = 1e-6f;
constexpr float LAMBDA_INIT = 0.35550906759096933f;
constexpr float L2E = 1.4426950408889634f;

constexpr size_t O_S5RP = (size_t)NT * 1024, O_S5IP = O_S5RP + 16384, O_S5RS = O_S5IP + 16384, O_S5IS = O_S5RS + 65536,
                 O_DKP = O_S5IS + 65536, O_DVP = O_DKP + (size_t)NTP * 1024, O_DKS = O_DVP + (size_t)NTP * 1024,
                 O_DVS = O_DKS + (size_t)NTS * 1024, O_CKP = O_DVS + (size_t)NTS * 1024, O_KRP = O_CKP + (size_t)NTP * 128,
                 O_CKS = O_KRP + (size_t)NTP * 32, O_KRS = O_CKS + (size_t)NTS * 128, O_SGV = O_KRS + (size_t)NTS * 32;

constexpr size_t W_CTRL = 0;
constexpr size_t W_LAM = 32768;
constexpr size_t W_MODP = W_LAM + 256;
constexpr size_t W_MOD = W_MODP + 8ull * 20 * 24576 * 4;
constexpr size_t W_AP = W_MOD + 20ull * 24576 * 4;
constexpr size_t W_BBAR = W_AP + 64ull * 65 * 64 * 8;
constexpr size_t W_E = W_BBAR + 64ull * 64 * 16 * 8;
constexpr size_t W_CH = W_E + 64ull * 16 * 2048 * 2;
constexpr size_t W_MEND = W_CH + 64ull * 1024 * 128 * 2;
constexpr size_t W_WS1 = W_MEND + 64ull * 128 * 1024 * 2;
constexpr size_t W_WS2 = W_WS1 + 8ull * 128 * 128 * 2;
constexpr size_t W_WUP = W_WS2 + 8ull * 128 * 128 * 2;
constexpr size_t W_WDN = W_WUP + 4ull * 4096 * 1024 * 2;
constexpr size_t W_GLU = W_WDN + 4ull * 4096 * 1024 * 2;
constexpr size_t W_QKV = W_GLU + 2048ull * 1024 * 2;
constexpr size_t W_DWO = W_QKV + 3072ull * 1024 * 2;
constexpr size_t W_MD = W_DWO + 1024ull * 1024 * 2;
constexpr size_t W_MUQ = W_MD + 512ull * 1024 * 2;
constexpr size_t W_MUKV = W_MUQ + 1536ull * 256 * 2;
constexpr size_t W_MWO = W_MUKV + 2048ull * 128 * 2;
constexpr size_t W_SIN = W_MWO + 1024ull * 1024 * 2;
constexpr size_t W_SOUT = W_SIN + 4096ull * 1024 * 2;
constexpr size_t W_H = W_SOUT + 1024ull * 2048 * 2;
constexpr size_t W_BIG = W_H + (size_t)NT * 1024 * 2;
constexpr size_t B_HG = 0, B_SLOC = 94371840ull, B_Z = 115343360ull;
constexpr size_t B_ACT = 0;
constexpr size_t B_QB = 0, B_KB = 545259520ull, B_VTD = 272629760ull, B_OB = 476053504ull;
constexpr size_t B_RAW = 0, B_CQ = 51904512ull, B_OBM = 0, B_CKV = 69206016ull, B_KR = 94633984ull, B_QM = 100990976ull,
                 B_KN = 204800000ull, B_VTM = 408223744ull;
constexpr size_t B_U = 0, B_VRAW = 138412032ull, B_VTS = 276824064ull, B_G = 415236096ull;
constexpr size_t WS_NEED = W_BIG + 748683264ull;

struct P {
  const float* in[47];
  float* out;
  unsigned char* ws;
  int lo, hi;
};

DI unsigned pack2(float a, float b) {
  fl2_t f = {a, b};
  bf2_t r = __builtin_convertvector(f, bf2_t);
  return __builtin_bit_cast(unsigned, r);
}
DI bf16_t f2bf(float a) { return (bf16_t)(pack2(a, 0.f) & 0xffffu); }
DI float bf2f(bf16_t v) { return __uint_as_float(((unsigned)v) << 16); }
DI float gelu_t(float x) {
  float u = 0.7978845608028654f * (x + 0.044715f * x * x * x);
  float t = 1.f - 2.f / (__expf(2.f * u) + 1.f);
  return 0.5f * x * (1.f + t);
}
DI float sigmoid_f(float x) { return 1.f / (1.f + __expf(-x)); }
DI int batch_of(int row) { return row < NTP ? (row >> 13) : 4 + ((row - NTP) >> 6); }
DI int pos_of(int row) { return row < NTP ? (row & 8191) : 4096 + ((row - NTP) & 63); }
DI int krow_of(int row) { return row < NTP ? row : NTP + ((row - NTP) >> 6) * SLK + 4096 + ((row - NTP) & 63); }
DI void rope_cs(int pos, float invf, float& c, float& s) {
  double t = (double)pos * (double)invf * 0.15915494309189535;
  t -= __builtin_rint(t);
  float ft = (float)t;
  c = __builtin_amdgcn_cosf(ft);
  s = __builtin_amdgcn_sinf(ft);
}
DI float wave_sum(float v) {
#pragma unroll
  for (int o = 32; o > 0; o >>= 1) v += __shfl_xor(v, o);
  return v;
}

DI unsigned xcc_id_() { return (unsigned)__builtin_amdgcn_s_getreg((3 << 11) | 20) & 0xFu; }
struct DynQ {
  unsigned* ctr; int G, per, nq, items, x0, pass, x;
};
DI DynQ dynq_init(const P& p, int qid, int items) {
  DynQ q; q.ctr = (unsigned*)(p.ws + W_CTRL) + 4096 + qid * 64; q.G = gridDim.x; q.nq = ((q.G & 7) == 0) ? 8 : 1; q.per = q.G / q.nq;
  q.items = items; q.x0 = (int)(xcc_id_() & 7u) % q.nq; q.pass = 0; q.x = q.x0; return q;
}
DI int dynq_pop(DynQ& q, int* s_slot) {
  for (;;) {
    if (q.pass >= q.nq) return -1;
    if (threadIdx.x == 0) *s_slot = (int)atomicAdd(&q.ctr[q.x * 8], 1u);
    __syncthreads();
    const int j = *s_slot;
    __syncthreads();
    const int it = (j / q.per) * q.G + q.x * q.per + (j % q.per);
    if (it < q.items) return it;
    ++q.pass; q.x = (q.x0 + q.pass) % q.nq;
  }
}


constexpr int LST = 72;
template <class AF, class BF, class EPI>
DI void gemm_tile(bf16_t* smem, AF af, BF bf, int nkt, EPI epi) {
  const int tid = threadIdx.x, lane = tid & 63, wave = tid >> 6;
  const int wm = wave >> 1, wn = wave & 1, r = lane & 31, h = lane >> 5;
  bf16_t* sA = smem;
  bf16_t* sB = smem + 2 * 128 * LST;
  f32x16 acc[2][2];
#pragma unroll
  for (int a = 0; a < 2; ++a)
#pragma unroll
    for (int b = 0; b < 2; ++b)
#pragma unroll
      for (int i = 0; i < 16; ++i) acc[a][b][i] = 0.f;
  const int lr = tid >> 3, lc = (tid & 7) * 8;
  u32x4 ra[4], rb[4];
#pragma unroll
  for (int i = 0; i < 4; ++i) {
    ra[i] = *(const u32x4*)(af(lr + 32 * i, 0) + lc);
    rb[i] = *(const u32x4*)(bf(lr + 32 * i, 0) + lc);
  }
#pragma unroll
  for (int i = 0; i < 4; ++i) {
    *(u32x4*)(sA + (lr + 32 * i) * LST + lc) = ra[i];
    *(u32x4*)(sB + (lr + 32 * i) * LST + lc) = rb[i];
  }
  __syncthreads();
  for (int kt = 0; kt < nkt; ++kt) {
    const bool more = (kt + 1 < nkt);
    if (more) {
#pragma unroll
      for (int i = 0; i < 4; ++i) {
        ra[i] = *(const u32x4*)(af(lr + 32 * i, kt + 1) + lc);
        rb[i] = *(const u32x4*)(bf(lr + 32 * i, kt + 1) + lc);
      }
    }
    __builtin_amdgcn_sched_barrier(0);
    const bf16_t* pa = sA + (kt & 1) * 128 * LST + (wm * 64 + r) * LST + h * 8;
    const bf16_t* pb = sB + (kt & 1) * 128 * LST + (wn * 64 + r) * LST + h * 8;
#pragma unroll
    for (int ks = 0; ks < 4; ++ks) {
      bf16x8 a0 = *(const bf16x8*)(pa + ks * 16);
      bf16x8 a1 = *(const bf16x8*)(pa + 32 * LST + ks * 16);
      bf16x8 b0 = *(const bf16x8*)(pb + ks * 16);
      bf16x8 b1 = *(const bf16x8*)(pb + 32 * LST + ks * 16);
      acc[0][0] = MFMA(a0, b0, acc[0][0]);
      acc[0][1] = MFMA(a0, b1, acc[0][1]);
      acc[1][0] = MFMA(a1, b0, acc[1][0]);
      acc[1][1] = MFMA(a1, b1, acc[1][1]);
    }
    if (more) {
      const int nb = ((kt + 1) & 1) * 128 * LST;
#pragma unroll
      for (int i = 0; i < 4; ++i) {
        *(u32x4*)(sA + nb + (lr + 32 * i) * LST + lc) = ra[i];
        *(u32x4*)(sB + nb + (lr + 32 * i) * LST + lc) = rb[i];
      }
    }
    __syncthreads();
  }
#pragma unroll
  for (int mi = 0; mi < 2; ++mi)
#pragma unroll
    for (int g = 0; g < 4; ++g) {
      float4 v0 = {acc[mi][0][4 * g], acc[mi][0][4 * g + 1], acc[mi][0][4 * g + 2], acc[mi][0][4 * g + 3]};
      float4 v1 = {acc[mi][1][4 * g], acc[mi][1][4 * g + 1], acc[mi][1][4 * g + 2], acc[mi][1][4 * g + 3]};
      epi(wm * 64 + mi * 32 + 8 * g + 4 * h, wn * 64 + r, v0, v1);
      __builtin_amdgcn_sched_barrier(0);
    }
}


DI int vperm_key(int key) { const int q = (key >> 2) & 3; const int q2 = ((q & 1) << 1) | (q >> 1); return (key & ~15) | (q2 << 2); }

DI void conv_k_slice(const P& p, long t0, int n) {
  const float* ck = p.in[6];
  bf16_t* Kb = (bf16_t*)(p.ws + W_BIG + B_KB);
  for (int i = 0; i < n; ++i) {
    const long idx = t0 + (long)i * 256 + threadIdx.x;
    if (idx < 16l * 4096 * 128) {
      const long rowc = idx >> 7; const int c8 = (int)(idx & 127) * 8;
      const int b = (int)(rowc >> 12), jk = (int)(rowc & 4095);
      const float4 a = *(const float4*)(ck + rowc * 1024 + c8), bq = *(const float4*)(ck + rowc * 1024 + c8 + 4);
      uint4 o = {pack2(a.x, a.y), pack2(a.z, a.w), pack2(bq.x, bq.y), pack2(bq.z, bq.w)};
      *(uint4*)(Kb + ((long)NTP + (long)b * SLK + jk) * 1024 + c8) = o;
    }
  }
}
DI void conv_v_slice(const P& p, long t0, int n) {
  const float* cv = p.in[7];
  bf16_t* VT = (bf16_t*)(p.ws + W_BIG + B_VTD);
  for (int i = 0; i < n; ++i) {
    const long idx = t0 + (long)i * 256 + threadIdx.x;
    if (idx < 16l * 512 * 1024) {
      const int hd = (int)(idx & 1023); const long t = idx >> 10;
      const int kg = (int)(t & 511), b = (int)(t >> 9);
      const float* src = cv + ((long)b * 4096 + kg * 8) * 1024 + hd;
      const float v0 = src[0], v1 = src[1024], v2 = src[2048], v3 = src[3072], v4 = src[4096], v5 = src[5120], v6 = src[6144], v7 = src[7168];
      bf16_t* vd = VT + 4l * 1024 * 8192 + (long)b * 1024 * SLK + (long)hd * SLK;
      *(uint2*)(vd + vperm_key(kg * 8)) = make_uint2(pack2(v0, v1), pack2(v2, v3));
      *(uint2*)(vd + vperm_key(kg * 8 + 4)) = make_uint2(pack2(v4, v5), pack2(v6, v7));
    }
  }
}


template <class EPI>
DI void gemm_tile256(bf16_t* smem, const bf16_t* __restrict__ Ab, int lda, const bf16_t* __restrict__ Bb, int ldb, int nkt, EPI epi) {
  const int tid = threadIdx.x, lane = tid & 63, wave = tid >> 6;
  const int wm = wave >> 1, wn = wave & 1, r = lane & 31, h = lane >> 5;
  bf16_t* sA = smem;
  bf16_t* sB = smem + 256 * LST;
  f32x16 acc[4][2];
#pragma unroll
  for (int a = 0; a < 4; ++a)
#pragma unroll
    for (int b = 0; b < 2; ++b)
#pragma unroll
      for (int i = 0; i < 16; ++i) acc[a][b][i] = 0.f;
  const int lr = tid >> 3, lc = (tid & 7) * 8;
  u32x4 rg[12];
  unsigned offa = (unsigned)(lr * lda + lc), offb = (unsigned)(lr * ldb + lc);
  const unsigned sta = 32u * lda, stb = 32u * ldb;
#pragma unroll
  for (int i = 0; i < 8; ++i) rg[i] = *(const u32x4*)(Ab + (offa + i * sta));
#pragma unroll
  for (int i = 0; i < 4; ++i) rg[8 + i] = *(const u32x4*)(Bb + (offb + i * stb));
  for (int kt = 0; kt < nkt; ++kt) {
    __syncthreads();
#pragma unroll
    for (int i = 0; i < 8; ++i) *(u32x4*)(sA + (lr + 32 * i) * LST + lc) = rg[i];
#pragma unroll
    for (int i = 0; i < 4; ++i) *(u32x4*)(sB + (lr + 32 * i) * LST + lc) = rg[8 + i];
    __syncthreads();
    if (kt + 1 < nkt) {
      offa += 64u; offb += 64u;
#pragma unroll
      for (int i = 0; i < 8; ++i) rg[i] = *(const u32x4*)(Ab + (offa + i * sta));
#pragma unroll
      for (int i = 0; i < 4; ++i) rg[8 + i] = *(const u32x4*)(Bb + (offb + i * stb));
    }
    __builtin_amdgcn_sched_barrier(0);
    const bf16_t* pa = sA + (wm * 128 + r) * LST + h * 8;
    const bf16_t* pb = sB + (wn * 64 + r) * LST + h * 8;
#pragma unroll
    for (int ks = 0; ks < 4; ++ks) {
      const bf16x8 b0 = *(const bf16x8*)(pb + ks * 16);
      const bf16x8 b1 = *(const bf16x8*)(pb + 32 * LST + ks * 16);
#pragma unroll
      for (int mi = 0; mi < 4; ++mi) {
        const bf16x8 a = *(const bf16x8*)(pa + mi * 32 * LST + ks * 16);
        acc[mi][0] = MFMA(a, b0, acc[mi][0]);
        acc[mi][1] = MFMA(a, b1, acc[mi][1]);
      }
    }
  }
  __syncthreads();
#pragma unroll
  for (int mi = 0; mi < 4; ++mi)
#pragma unroll
    for (int g = 0; g < 4; ++g) {
      float4 v0 = {acc[mi][0][4 * g], acc[mi][0][4 * g + 1], acc[mi][0][4 * g + 2], acc[mi][0][4 * g + 3]};
      float4 v1 = {acc[mi][1][4 * g], acc[mi][1][4 * g + 1], acc[mi][1][4 * g + 2], acc[mi][1][4 * g + 3]};
      epi(wm * 128 + mi * 32 + 8 * g + 4 * h, wn * 64 + r, v0, v1);
      __builtin_amdgcn_sched_barrier(0);
    }
}

template <bool SPLIT, class EPI>
DI void run_gemm256(const P& p, int qid, bf16_t* smem, const bf16_t* A, int lda, const bf16_t* B, int ldb, int mtiles, int ntiles, int nkt, EPI epi, int sidejob = 0) {
  const int T = mtiles * ntiles, G = gridDim.x;
  int full = T, S = 1;
  if (SPLIT) {
    const int R = T % G;
    if (R > 0) {
      full = T - R;
      S = 16;
      while (S > 1 && (S * R > G || S > nkt)) S >>= 1;
    }
  }
  const int items = full + (T - full) * S;
  __shared__ int s_git;
  DynQ dq = dynq_init(p, qid, items);
  for (;;) {
    const int it = dynq_pop(dq, &s_git);
    if (it < 0) break;
    int t = it, k0 = 0, nk = nkt; bool part = false;
    if (it >= full) { const int j = it - full; t = full + j / S; nk = nkt / S; k0 = (j % S) * nk; part = (S > 1); }
    const int mt = t / ntiles, nt = t % ntiles;
    const bf16_t* a0 = A + (long)mt * 256 * lda + k0 * 64;
    const bf16_t* b0 = B + (long)nt * 128 * ldb + k0 * 64;
    gemm_tile256(smem, a0, lda, b0, ldb, nk,
                 [=](int row0, int col, float4 v0, float4 v1) { epi(mt * 256 + row0, nt * 128 + col, v0, v1, part); });
    if (sidejob == 1) conv_k_slice(p, (long)it * 2048, 8);
    else if (sidejob == 2 && it < 1024) conv_v_slice(p, (long)it * 8192, 32);
  }
}

DI float f4get(const float4& v, int j) { return j == 0 ? v.x : (j == 1 ? v.y : (j == 2 ? v.z : v.w)); }

template <class F>
DI void prep_w(bf16_t* dst, int K, int N, int ld, F colsrc) {
  const long total = (long)N * (K / 8);
  for (long idx = (long)blockIdx.x * 256 + threadIdx.x; idx < total; idx += (long)gridDim.x * 256) {
    const int n = (int)(idx % N);
    const int kg = (int)(idx / N);
    const float* s = colsrc(n);
    uint4 o = {0u, 0u, 0u, 0u};
    if (s) {
      s += (long)kg * 8 * ld;
      float v0 = s[0], v1 = s[(long)ld], v2 = s[2l * ld], v3 = s[3l * ld], v4 = s[4l * ld], v5 = s[5l * ld], v6 = s[6l * ld], v7 = s[7l * ld];
      o.x = pack2(v0, v1); o.y = pack2(v2, v3); o.z = pack2(v4, v5); o.w = pack2(v6, v7);
    }
    *(uint4*)(dst + (long)n * K + kg * 8) = o;
  }
}

DI void phase0(const P& p, float* smf) {
  unsigned char* ws = p.ws;
  const int gt = blockIdx.x * 256 + threadIdx.x, gs = gridDim.x * 256;
  {
    float* modp = (float*)(ws + W_MODP);
    __shared__ int s_qmp;
    DynQ dq = dynq_init(p, 24, 768);
    for (;;) {
      const int it = dynq_pop(dq, &s_qmp);
      if (it < 0) break;
      const int kc = it / 96, ch = it % 96;
      __syncthreads();
      for (int e = threadIdx.x; e < 20 * 128; e += 256) {
        const int m = e >> 7, k = e & 127;
        const float c = (m < 4) ? p.in[2][m * 1024 + kc * 128 + k] : p.in[3][(m - 4) * 1024 + kc * 128 + k];
        smf[k * 20 + m] = c / (1.f + __expf(-c));
      }
      __syncthreads();
      const int n = ch * 256 + threadIdx.x;
      const int layer = n / 6144, col = n % 6144;
      const float* w = p.in[10] + ((long)(layer * 1024 + kc * 128)) * 6144 + col;
      float acc[20];
#pragma unroll
      for (int m = 0; m < 20; ++m) acc[m] = 0.f;
      for (int k = 0; k < 128; ++k) {
        const float wv = w[(long)k * 6144];
#pragma unroll
        for (int m = 0; m < 20; ++m) acc[m] += smf[k * 20 + m] * wv;
      }
#pragma unroll
      for (int m = 0; m < 20; ++m) modp[(long)(kc * 20 + m) * 24576 + n] = acc[m];
    }
  }
  {
    float2* ap = (float2*)(ws + W_AP);
    for (int idx = gt; idx < 64 * 65 * 64; idx += gs) {
      const int g = idx / (65 * 64), tau = (idx / 64) % 65, pp = idx & 63;
      const float dt = expf(p.in[24][g]);
      const float are = p.in[17][g * 64 + pp], aim = p.in[18][g * 64 + pp];
      const float mag = expf(are * dt * (float)tau);
      double t = (double)aim * (double)dt * (double)tau * 0.15915494309189535;
      t -= __builtin_rint(t);
      const float ft = (float)t;
      ap[idx] = make_float2(mag * __builtin_amdgcn_cosf(ft), mag * __builtin_amdgcn_sinf(ft));
    }
    float2* bb = (float2*)(ws + W_BBAR);
    for (int idx = gt; idx < 64 * 64 * 16; idx += gs) {
      const int g = idx / 1024, pp = (idx >> 4) & 63;
      const float dt = expf(p.in[24][g]);
      const float are = p.in[17][g * 64 + pp], aim = p.in[18][g * 64 + pp];
      const float mag = expf(are * dt);
      double t = (double)aim * (double)dt * 0.15915494309189535;
      t -= __builtin_rint(t);
      const float ft = (float)t;
      const float nr = mag * __builtin_amdgcn_cosf(ft) - 1.f, ni = mag * __builtin_amdgcn_sinf(ft);
      const float den = are * are + aim * aim;
      const float qr = (nr * are + ni * aim) / den, qi = (ni * are - nr * aim) / den;
      const float br = p.in[19][idx], bi = p.in[20][idx];
      bb[idx] = make_float2(qr * br - qi * bi, qr * bi + qi * br);
    }
  }
  if (gt == 0) {
    float s1 = 0.f, s2 = 0.f;
    for (int i = 0; i < 64; ++i) { s1 += p.in[28][i] * p.in[29][i]; s2 += p.in[30][i] * p.in[31][i]; }
    *(float*)(ws + W_LAM) = expf(s1) - expf(s2) + LAMBDA_INIT;
  }
  {
    bf16_t* w1 = (bf16_t*)(ws + W_WS1);
    bf16_t* w2 = (bf16_t*)(ws + W_WS2);
    const float* wsrc = p.in[44];
    for (int idx = gt; idx < 8 * 128 * 128; idx += gs) {
      const int g = idx >> 14, t = (idx >> 7) & 127, s = idx & 127;
      w1[idx] = f2bf(s <= t ? wsrc[idx] : 0.f);
      const int tt = t & 63, ss = s & 63;
      w2[idx] = f2bf(((t >> 6) == (s >> 6) && ss <= tt) ? wsrc[(g * 128 + tt) * 128 + ss] : 0.f);
    }
  }
#ifndef REP_W
#define REP_W 1
#endif
#pragma unroll 1
  for (int rep = 0; rep < REP_W; ++rep) {
  for (int l = 0; l < 4; ++l) {
    const float* up = p.in[14] + (long)l * 1024 * 4096;
    prep_w((bf16_t*)(ws + W_WUP) + (long)l * 4096 * 1024, 1024, 4096, 4096, [=](int n) { return up + n; });
    const float* dn = p.in[15] + (long)l * 4096 * 1024;
    prep_w((bf16_t*)(ws + W_WDN) + (long)l * 1024 * 4096, 4096, 1024, 1024, [=](int n) { return dn + n; });
  }
  {
    const float* ga = p.in[25]; const float* gb = p.in[26];
    prep_w((bf16_t*)(ws + W_GLU), 1024, 2048, 1024, [=](int n) { const int sp = n >> 6, w = n & 63; return ((w < 32) ? ga : gb) + sp * 32 + (w & 31); });
    const float* s = p.in[27];
    prep_w((bf16_t*)(ws + W_QKV), 1024, 3072, 3072, [=](int n) { return s + n; });
    const float* s2 = p.in[33];
    prep_w((bf16_t*)(ws + W_DWO), 1024, 1024, 1024, [=](int n) { return s2 + n; });
    const float* dq = p.in[34];
    prep_w((bf16_t*)(ws + W_MD), 1024, 256, 256, [=](int n) { return dq + n; });
    const float* dkv = p.in[37];
    prep_w((bf16_t*)(ws + W_MD) + 256 * 1024, 1024, 256, 160, [=](int n) -> const float* {
      if (n < 128) return dkv + n;
      const int w = n - 128;
      if (w < 16) return dkv + 128 + w;
      if (w >= 32 && w < 48) return dkv + 144 + (w - 32);
      return nullptr;
    });
    const float* uq = p.in[36];
    prep_w((bf16_t*)(ws + W_MUQ), 256, 1536, 1536, [=](int n) {
      if (n < 1024) return uq + (n >> 6) * 96 + (n & 63);
      const int sp = (n - 1024) >> 6, w = (n - 1024) & 63, half = w >> 5, ix = w & 31;
      const int head = sp * 2 + (ix >> 4), i = ix & 15;
      return uq + head * 96 + 64 + half * 16 + i;
    });
    const float* uk = p.in[39]; const float* uv = p.in[40];
    prep_w((bf16_t*)(ws + W_MUKV), 128, 2048, 1024, [=](int n) { return n < 1024 ? uk + n : uv + (n - 1024); });
    const float* mwo = p.in[41];
    prep_w((bf16_t*)(ws + W_MWO), 1024, 1024, 1024, [=](int n) { return mwo + n; });
    const float* sin_ = p.in[42];
    prep_w((bf16_t*)(ws + W_SIN), 1024, 4096, 4096, [=](int n) { return sin_ + n; });
    const float* sout = p.in[46];
    prep_w((bf16_t*)(ws + W_SOUT), 2048, 1024, 1024, [=](int n) { return sout + n; });
  }
  }
}

DI void phase1(const P& p) {
  unsigned char* ws = p.ws;
  const int gt = blockIdx.x * 256 + threadIdx.x, gs = gridDim.x * 256;
  {
    const float* modp = (const float*)(ws + W_MODP);
    float* mod = (float*)(ws + W_MOD);
    for (int idx = gt; idx < 20 * 24576; idx += gs) {
      const int n = idx % 24576;
      float s = p.in[11][n];
#pragma unroll
      for (int kc = 0; kc < 8; ++kc) s += modp[(long)kc * 20 * 24576 + idx];
      mod[idx] = s;
    }
  }
  const float2* ap = (const float2*)(ws + W_AP);
  const float2* bb = (const float2*)(ws + W_BBAR);
  const float* cre = p.in[21]; const float* cim = p.in[22];
  {
    bf16_t* E = (bf16_t*)(ws + W_E);
    for (int idx = gt; idx < 64 * 16 * 2048; idx += gs) {
      const int g = idx >> 15, co = (idx >> 11) & 15, j = idx & 2047;
      float v = 0.f;
      if (j < 1024) {
        const int tau = 63 - (j >> 4), ci = j & 15;
        for (int pp = 0; pp < 64; ++pp) {
          const float2 a = ap[(g * 65 + tau) * 64 + pp];
          const float2 b = bb[(g * 64 + pp) * 16 + ci];
          const float cr = cre[(g * 16 + co) * 64 + pp], cimv = cim[(g * 16 + co) * 64 + pp];
          const float abr = a.x * b.x - a.y * b.y, abi = a.x * b.y + a.y * b.x;
          v += cr * abr - cimv * abi;
        }
        if (tau == 0 && co == ci) v += p.in[23][g * 16 + co];
      }
      E[idx] = f2bf(v);
    }
    bf16_t* CH = (bf16_t*)(ws + W_CH);
    for (int idx = gt; idx < 64 * 1024 * 128; idx += gs) {
      const int g = idx >> 17, m = (idx >> 7) & 1023, q = idx & 127;
      const int t = m >> 4, co = m & 15, pp = q & 63;
      const float2 a = ap[(g * 65 + t + 1) * 64 + pp];
      const float cr = cre[(g * 16 + co) * 64 + pp], cimv = cim[(g * 16 + co) * 64 + pp];
      const float zr = cr * a.x - cimv * a.y, zi = cr * a.y + cimv * a.x;
      CH[idx] = f2bf(q < 64 ? zr : -zi);
    }
    bf16_t* ME = (bf16_t*)(ws + W_MEND);
    for (int idx = gt; idx < 64 * 128 * 1024; idx += gs) {
      const int g = idx >> 17, q = (idx >> 10) & 127, k = idx & 1023;
      const int s = k >> 4, c = k & 15, pp = q & 63;
      const float2 a = ap[(g * 65 + 63 - s) * 64 + pp];
      const float2 b = bb[(g * 64 + pp) * 16 + c];
      ME[idx] = f2bf(q < 64 ? (a.x * b.x - a.y * b.y) : (a.x * b.y + a.y * b.x));
    }
  }
}

template <int MODE>
DI void phase_modulate(const P& p, int layer, int which) {
  unsigned char* ws = p.ws;
  const float* mod = (const float*)(ws + W_MOD);
  const float* gam = (which == 0 ? p.in[12] : p.in[13]) + layer * 1024;
  const int lane = threadIdx.x & 63;
  const int wv = blockIdx.x * 4 + (threadIdx.x >> 6), nwv = gridDim.x * 4;
  bf16_t* H = (bf16_t*)(ws + W_H);
  bf16_t* HG = (bf16_t*)(ws + W_BIG + B_HG);
  for (int row = wv; row < NT; row += nwv) {
    const float* x = (MODE == 1) ? (row < NTP ? p.in[0] + (long)row * 1024 : p.in[1] + (long)(row - NTP) * 1024) : p.out + (long)row * 1024;
    float4 v[4];
    float ss = 0.f;
#pragma unroll
    for (int i = 0; i < 4; ++i) {
      v[i] = *(const float4*)(x + lane * 4 + 256 * i);
      ss += v[i].x * v[i].x + v[i].y * v[i].y + v[i].z * v[i].z + v[i].w * v[i].w;
    }
    ss = wave_sum(ss);
    const float rinv = rsqrtf(ss * (1.f / 1024.f) + NORM_EPS);
    const int b = batch_of(row);
    const float* sh = mod + (long)b * 24576 + layer * 6144 + (which * 3) * 1024;
    const float* sc = sh + 1024;
#pragma unroll
    for (int i = 0; i < 4; ++i) {
      const int col = lane * 4 + 256 * i;
      const float4 g4 = *(const float4*)(gam + col), sh4 = *(const float4*)(sh + col), sc4 = *(const float4*)(sc + col);
      const float h0 = v[i].x * rinv * g4.x * (1.f + sc4.x) + sh4.x;
      const float h1 = v[i].y * rinv * g4.y * (1.f + sc4.y) + sh4.y;
      const float h2 = v[i].z * rinv * g4.z * (1.f + sc4.z) + sh4.z;
      const float h3 = v[i].w * rinv * g4.w * (1.f + sc4.w) + sh4.w;
      uint2 o = {pack2(h0, h1), pack2(h2, h3)};
      if (MODE == 1) {
        *(float4*)(p.out + (long)row * 1024 + col) = v[i];
        const int g = col >> 4, c = col & 15, n = row >> 6, s = row & 63;
        *(uint2*)(HG + ((long)(g * 640 + n)) * 1152 + s * 16 + c) = o;
      } else {
        *(uint2*)(H + (long)row * 1024 + col) = o;
      }
    }
  }
}

DI void phase_s5_carry(const P& p) {
  unsigned char* ws = p.ws;
  const float2* ap = (const float2*)(ws + W_AP);
  const float* sloc = (const float*)(ws + W_BIG + B_SLOC);
  bf16_t* HG = (bf16_t*)(ws + W_BIG + B_HG);
  const int gt = blockIdx.x * 256 + threadIdx.x, gs = gridDim.x * 256;
  for (int idx = gt; idx < 64 * 20 * 64; idx += gs) {
    const int g = idx / 1280, bb = (idx >> 6) % 20, pp = idx & 63;
    const float2 a = ap[(g * 65 + 64) * 64 + pp];
    if (bb < 4) {
      float hr = 0.f, hi = 0.f;
#pragma unroll 8
      for (int k = 0; k < 128; ++k) {
        const long n = (long)g * 640 + bb * 128 + k;
        HG[n * 1152 + 1024 + pp] = f2bf(hr);
        HG[n * 1152 + 1088 + pp] = f2bf(hi);
        const float sr = sloc[n * 128 + pp], si = sloc[n * 128 + 64 + pp];
        const float nr = a.x * hr - a.y * hi + sr, ni = a.x * hi + a.y * hr + si;
        hr = nr; hi = ni;
      }
      p.out[O_S5RP + (bb * 64 + g) * 64 + pp] = hr;
      p.out[O_S5IP + (bb * 64 + g) * 64 + pp] = hi;
    } else {
      const int b = bb - 4;
      const long n = (long)g * 640 + 512 + b;
      float hr = p.in[4][(b * 64 + g) * 64 + pp], hi = p.in[5][(b * 64 + g) * 64 + pp];
      HG[n * 1152 + 1024 + pp] = f2bf(hr);
      HG[n * 1152 + 1088 + pp] = f2bf(hi);
      const float sr = sloc[n * 128 + pp], si = sloc[n * 128 + 64 + pp];
      p.out[O_S5RS + (b * 64 + g) * 64 + pp] = a.x * hr - a.y * hi + sr;
      p.out[O_S5IS + (b * 64 + g) * 64 + pp] = a.x * hi + a.y * hr + si;
    }
  }
}

DI const float* mod_ptr(const P& p, int layer, int k) { return (const float*)(p.ws + W_MOD) + layer * 6144 + k * 1024; }

DI void phase_s5a(const P& p, bf16_t* smem) {
  const bf16_t* HG = (const bf16_t*)(p.ws + W_BIG + B_HG);
  const bf16_t* ME = (const bf16_t*)(p.ws + W_MEND);
  float* sloc = (float*)(p.ws + W_BIG + B_SLOC);
  __shared__ int s_q5a;
  DynQ dq = dynq_init(p, 23, 64 * 5);
  for (;;) {
    const int t = dynq_pop(dq, &s_q5a);
    if (t < 0) break;
    const int g = t / 5, mi = t % 5;
    const bf16_t* a0 = HG + (long)(g * 640 + mi * 128) * 1152;
    const bf16_t* b0 = ME + (long)g * 128 * 1024;
    float* o = sloc + (long)(g * 640 + mi * 128) * 128;
    gemm_tile(smem, [=](int r, int kt) { return a0 + (long)r * 1152 + kt * 64; }, [=](int r, int kt) { return b0 + (long)r * 1024 + kt * 64; }, 16,
              [=](int row0, int col, float4 v0, float4 v1) {
#pragma unroll
                for (int j = 0; j < 4; ++j) {
                  o[(long)(row0 + j) * 128 + col] = f4get(v0, j);
                  o[(long)(row0 + j) * 128 + col + 32] = f4get(v1, j);
                }
              });
  }
}

DI void phase_s5b(const P& p, bf16_t* smem) {
  const bf16_t* HG = (const bf16_t*)(p.ws + W_BIG + B_HG);
  const bf16_t* E = (const bf16_t*)(p.ws + W_E);
  const bf16_t* CH = (const bf16_t*)(p.ws + W_CH);
  bf16_t* Z = (bf16_t*)(p.ws + W_BIG + B_Z);
  __shared__ int s_q5b;
  DynQ dq = dynq_init(p, 20, 64 * 5 * 8);
  for (;;) {
    const int t = dynq_pop(dq, &s_q5b);
    if (t < 0) break;
    const int j = 7 - t / 320, g = (t % 320) / 5, mi = t % 5;
    const int nE = 2 * j + 2;
    const bf16_t* a0 = HG + (long)(g * 640 + mi * 128) * 1152;
    const bf16_t* e0 = E + (long)g * 16 * 2048;
    const bf16_t* c0 = CH + ((long)g * 1024 + j * 128) * 128;
    gemm_tile(smem,
              [=](int r, int kt) { const int k = kt < nE ? kt : 16 + kt - nE; return a0 + (long)r * 1152 + k * 64; },
              [=](int r, int kt) -> const bf16_t* {
                if (kt < nE) { const int tt = 8 * j + (r >> 4), co = r & 15; return e0 + co * 2048 + (63 - tt) * 16 + kt * 64; }
                return c0 + (long)r * 128 + (kt - nE) * 64;
              },
              nE + 2,
              [=](int row0, int col, float4 v0, float4 v1) {
#pragma unroll
                for (int q = 0; q < 4; ++q) {
                  const int n = mi * 128 + row0 + q;
                  if (n < 528) {
                    const int c0_ = col, c1_ = col + 32;
                    const long tok0 = (long)n * 64 + 8 * j + (c0_ >> 4), tok1 = (long)n * 64 + 8 * j + (c1_ >> 4);
                    Z[tok0 * 1024 + g * 16 + (c0_ & 15)] = f2bf(gelu_t(f4get(v0, q)));
                    Z[tok1 * 1024 + g * 16 + (c1_ & 15)] = f2bf(gelu_t(f4get(v1, q)));
                  }
                }
              });
  }
}

template <class EPI>
DI void run_gemm(const P& p, int qid, bf16_t* smem, const bf16_t* A, int lda, const bf16_t* B, int ldb, int mtiles, int ntiles, int nkt, EPI epi) {
  __shared__ int s_git2;
  DynQ dq = dynq_init(p, qid, mtiles * ntiles);
  for (;;) {
    const int t = dynq_pop(dq, &s_git2);
    if (t < 0) break;
    const int mt = t / ntiles, nt = t % ntiles;
    const bf16_t* a0 = A + (long)mt * 128 * lda;
    const bf16_t* b0 = B + (long)nt * 128 * ldb;
    gemm_tile(smem, [=](int r, int kt) { return a0 + (long)r * lda + kt * 64; }, [=](int r, int kt) { return b0 + (long)r * ldb + kt * 64; }, nkt,
              [=](int row0, int col, float4 v0, float4 v1) { epi(mt * 128 + row0, nt * 128 + col, v0, v1); });
  }
}

DI void resid_add(const P& p, const float* gate, int row0, int col, float4 v0, float4 v1, bool part) {
  const float* gb = gate + (long)batch_of(row0) * 24576;
  const float g0 = 1.f + gb[col], g1 = 1.f + gb[col + 32];
  if (part) {
#pragma unroll
    for (int j = 0; j < 4; ++j) {
      float* x = p.out + (long)(row0 + j) * 1024;
      atomicAdd(x + col, g0 * f4get(v0, j));
      atomicAdd(x + col + 32, g1 * f4get(v1, j));
    }
  } else {
#pragma unroll
    for (int j = 0; j < 4; ++j) {
      float* x = p.out + (long)(row0 + j) * 1024;
      x[col] += g0 * f4get(v0, j);
      x[col + 32] += g1 * f4get(v1, j);
    }
  }
}

DI void phase_glu(const P& p, bf16_t* smem) {
  const float* gate = mod_ptr(p, 0, 2);
  run_gemm256<false>(p, 12, smem, (const bf16_t*)(p.ws + W_BIG + B_Z), 1024, (const bf16_t*)(p.ws + W_GLU), 1024, 132, 16, 16,
           [=](int row0, int col, float4 v0, float4 v1, bool) {
             const int oc = (col >> 6) * 32 + (col & 31);
             const float g0 = 1.f + gate[(long)batch_of(row0) * 24576 + oc];
#pragma unroll
             for (int j = 0; j < 4; ++j) {
               float* x = p.out + (long)(row0 + j) * 1024 + oc;
               *x += g0 * f4get(v0, j) * sigmoid_f(f4get(v1, j));
             }
           });
}

DI void phase_mlp_up(const P& p, bf16_t* smem, int layer) {
  bf16_t* act = (bf16_t*)(p.ws + W_BIG + B_ACT);
  run_gemm256<false>(p, layer, smem, (const bf16_t*)(p.ws + W_H), 1024, (const bf16_t*)(p.ws + W_WUP) + (long)layer * 4096 * 1024, 1024, 132, 32, 16,
           [=](int row0, int col, float4 v0, float4 v1, bool) {
#pragma unroll
             for (int j = 0; j < 4; ++j) {
               const float a = fmaxf(f4get(v0, j), 0.f), b = fmaxf(f4get(v1, j), 0.f);
               act[(long)(row0 + j) * 4096 + col] = f2bf(a * a);
               act[(long)(row0 + j) * 4096 + col + 32] = f2bf(b * b);
             }
           }, layer == 0 ? 1 : 0);
}

DI void phase_mlp_down(const P& p, bf16_t* smem, int layer) {
  const float* gate = mod_ptr(p, layer, 5);
  run_gemm256<true>(p, 4 + layer, smem, (const bf16_t*)(p.ws + W_BIG + B_ACT), 4096, (const bf16_t*)(p.ws + W_WDN) + (long)layer * 1024 * 4096, 4096, 132, 8, 64,
           [=](int row0, int col, float4 v0, float4 v1, bool part) { resid_add(p, gate, row0, col, v0, v1, part); }, layer == 0 ? 2 : 0);
}

DI void phase_proj_resid(const P& p, bf16_t* smem, const bf16_t* A, int K, const bf16_t* B, int layer) {
  const float* gate = mod_ptr(p, layer, 2);
  run_gemm256<true>(p, 8 + layer, smem, A, K, B, K, 132, 8, K / 64, [=](int row0, int col, float4 v0, float4 v1, bool part) { resid_add(p, gate, row0, col, v0, v1, part); });
}

DI void store_t4(bf16_t* dst, float4 v) { *(uint2*)dst = make_uint2(pack2(v.x, v.y), pack2(v.z, v.w)); }

DI void phase_qkv(const P& p, bf16_t* smem) {
  unsigned char* big = p.ws + W_BIG;
  bf16_t* Qb = (bf16_t*)(big + B_QB);
  bf16_t* Kb = (bf16_t*)(big + B_KB);
  bf16_t* VT = (bf16_t*)(big + B_VTD);
  const float qscale = 0.125f * L2E;
  run_gemm(p, 14, smem, (const bf16_t*)(p.ws + W_H), 1024, (const bf16_t*)(p.ws + W_QKV), 1024, 264, 24, 16,
           [=](int row0, int col, float4 v0, float4 v1) {
             const int region = col >> 10;
             if (region < 2) {
               const int d = col & 31;
               const float invf = exp2f(-(float)d * (13.287712379549449f / 32.f));
#pragma unroll
               for (int j = 0; j < 4; ++j) {
                 const int row = row0 + j;
                 float c, s;
                 rope_cs(pos_of(row), invf, c, s);
                 const float x1 = f4get(v0, j), x2 = f4get(v1, j);
                 const float o1 = x1 * c - x2 * s, o2 = x1 * s + x2 * c;
                 if (region == 0) {
                   Qb[(long)row * 1024 + col] = f2bf(o1 * qscale);
                   Qb[(long)row * 1024 + col + 32] = f2bf(o2 * qscale);
                 } else {
                   const int kc = col - 1024;
                   float* ko = (row < NTP) ? p.out + O_DKP + (long)row * 1024 : p.out + O_DKS + (long)(row - NTP) * 1024;
                   ko[kc] = o1; ko[kc + 32] = o2;
                   const long kr = krow_of(row);
                   Kb[kr * 1024 + kc] = f2bf(o1);
                   Kb[kr * 1024 + kc + 32] = f2bf(o2);
                 }
               }
             } else {
               const int vc = col - 2048;
#pragma unroll
               for (int j = 0; j < 4; ++j) {
                 const int row = row0 + j;
                 float* vo = (row < NTP) ? p.out + O_DVP + (long)row * 1024 : p.out + O_DVS + (long)(row - NTP) * 1024;
                 vo[vc] = f4get(v0, j); vo[vc + 32] = f4get(v1, j);
               }
               long base; int Lk, key;
               if (row0 < NTP) { const int b = row0 >> 13; key = row0 & 8191; Lk = 8192; base = (long)b * 1024 * 8192; }
               else { const int b = (row0 - NTP) >> 6; key = 4096 + ((row0 - NTP) & 63); Lk = SLK; base = 4l * 1024 * 8192 + (long)b * 1024 * SLK; }
               store_t4(VT + base + (long)vc * Lk + vperm_key(key), v0);
               store_t4(VT + base + (long)(vc + 32) * Lk + vperm_key(key), v1);
             }
           });
}

DI void phase_mla_down(const P& p, bf16_t* smem) {
  unsigned char* big = p.ws + W_BIG;
  float* raw = (float*)(big + B_RAW);
  bf16_t* KR = (bf16_t*)(big + B_KR);
  run_gemm(p, 16, smem, (const bf16_t*)(p.ws + W_H), 1024, (const bf16_t*)(p.ws + W_MD), 1024, 264, 4, 16,
           [=](int row0, int col, float4 v0, float4 v1) {
             if (col < 384) {
#pragma unroll
               for (int j = 0; j < 4; ++j) {
                 raw[(long)(row0 + j) * 384 + col] = f4get(v0, j);
                 raw[(long)(row0 + j) * 384 + col + 32] = f4get(v1, j);
               }
             } else if (col < 400) {
               const int i = col - 384;
               const float invf = exp2f(-(float)i * (13.287712379549449f / 16.f));
#pragma unroll
               for (int j = 0; j < 4; ++j) {
                 const int row = row0 + j;
                 float c, s;
                 rope_cs(pos_of(row), invf, c, s);
                 const float x1 = f4get(v0, j), x2 = f4get(v1, j);
                 const float o1 = x1 * c - x2 * s, o2 = x1 * s + x2 * c;
                 float* ko = (row < NTP) ? p.out + O_KRP + (long)row * 32 : p.out + O_KRS + (long)(row - NTP) * 32;
                 ko[i] = o1; ko[16 + i] = o2;
                 const long kr = krow_of(row);
                 KR[kr * 32 + i] = f2bf(o1); KR[kr * 32 + 16 + i] = f2bf(o2);
               }
             }
           });
  {
    bf16_t* CKV = (bf16_t*)(big + B_CKV);
    const float* cc = p.in[8]; const float* cr = p.in[9];
    const long gt = (long)blockIdx.x * 256 + threadIdx.x, gs = (long)gridDim.x * 256;
    for (long idx = gt; idx < 16l * 4096 * 16; idx += gs) {
      const long rowc = idx >> 4; const int c8 = (int)(idx & 15) * 8;
      const int b = (int)(rowc >> 12), jk = (int)(rowc & 4095);
      const float4 a = *(const float4*)(cc + rowc * 128 + c8), bq = *(const float4*)(cc + rowc * 128 + c8 + 4);
      uint4 o = {pack2(a.x, a.y), pack2(a.z, a.w), pack2(bq.x, bq.y), pack2(bq.z, bq.w)};
      *(uint4*)(CKV + ((long)NTP + (long)b * SLK + jk) * 128 + c8) = o;
    }
    for (long idx = gt; idx < 16l * 4096 * 4; idx += gs) {
      const long rowc = idx >> 2; const int c8 = (int)(idx & 3) * 8;
      const int b = (int)(rowc >> 12), jk = (int)(rowc & 4095);
      const float4 a = *(const float4*)(cr + rowc * 32 + c8), bq = *(const float4*)(cr + rowc * 32 + c8 + 4);
      uint4 o = {pack2(a.x, a.y), pack2(a.z, a.w), pack2(bq.x, bq.y), pack2(bq.z, bq.w)};
      *(uint4*)(KR + ((long)NTP + (long)b * SLK + jk) * 32 + c8) = o;
    }
  }
}

DI void phase_mla_norm(const P& p) {
  unsigned char* big = p.ws + W_BIG;
  const float* raw = (const float*)(big + B_RAW);
  bf16_t* CQ = (bf16_t*)(big + B_CQ);
  bf16_t* CKV = (bf16_t*)(big + B_CKV);
  const int lane = threadIdx.x & 63;
  const int wv = blockIdx.x * 4 + (threadIdx.x >> 6), nwv = gridDim.x * 4;
  const float4 gq = *(const float4*)(p.in[35] + lane * 4);
  const float2 gk = *(const float2*)(p.in[38] + lane * 2);
  for (int row = wv; row < NT; row += nwv) {
    const float4 q = *(const float4*)(raw + (long)row * 384 + lane * 4);
    const float2 k = *(const float2*)(raw + (long)row * 384 + 256 + lane * 2);
    const float sq = wave_sum(q.x * q.x + q.y * q.y + q.z * q.z + q.w * q.w);
    const float sk = wave_sum(k.x * k.x + k.y * k.y);
    const float rq = rsqrtf(sq * (1.f / 256.f) + NORM_EPS), rk = rsqrtf(sk * (1.f / 128.f) + NORM_EPS);
    *(uint2*)(CQ + (long)row * 256 + lane * 4) = make_uint2(pack2(q.x * rq * gq.x, q.y * rq * gq.y), pack2(q.z * rq * gq.z, q.w * rq * gq.w));
    const float c0 = k.x * rk * gk.x, c1 = k.y * rk * gk.y;
    float* co = (row < NTP) ? p.out + O_CKP + (long)row * 128 : p.out + O_CKS + (long)(row - NTP) * 128;
    *(float2*)(co + lane * 2) = make_float2(c0, c1);
    *(unsigned*)(CKV + (long)krow_of(row) * 128 + lane * 2) = pack2(c0, c1);
  }
}

DI void phase_mla_up(const P& p, bf16_t* smem) {
  unsigned char* big = p.ws + W_BIG;
  bf16_t* QM = (bf16_t*)(big + B_QM);
  bf16_t* KN = (bf16_t*)(big + B_KN);
  bf16_t* VT = (bf16_t*)(big + B_VTM);
  const float qscale = 0.10206207261596577f * L2E;
  run_gemm(p, 17, smem, (const bf16_t*)(big + B_CQ), 256, (const bf16_t*)(p.ws + W_MUQ), 256, 264, 12, 4,
           [=](int row0, int col, float4 v0, float4 v1) {
             if (col < 1024) {
               const int o = (col >> 6) * 96 + (col & 63);
#pragma unroll
               for (int j = 0; j < 4; ++j) {
                 QM[(long)(row0 + j) * 1536 + o] = f2bf(f4get(v0, j) * qscale);
                 QM[(long)(row0 + j) * 1536 + o + 32] = f2bf(f4get(v1, j) * qscale);
               }
             } else {
               const int sp = (col - 1024) >> 6, ix = col & 31;
               const int head = sp * 2 + (ix >> 4), i = ix & 15;
               const float invf = exp2f(-(float)i * (13.287712379549449f / 16.f));
#pragma unroll
               for (int j = 0; j < 4; ++j) {
                 const int row = row0 + j;
                 float c, s;
                 rope_cs(pos_of(row), invf, c, s);
                 const float x1 = f4get(v0, j), x2 = f4get(v1, j);
                 QM[(long)row * 1536 + head * 96 + 64 + i] = f2bf((x1 * c - x2 * s) * qscale);
                 QM[(long)row * 1536 + head * 96 + 80 + i] = f2bf((x1 * s + x2 * c) * qscale);
               }
             }
           });
  run_gemm(p, 18, smem, (const bf16_t*)(big + B_CKV), 128, (const bf16_t*)(p.ws + W_MUKV), 128, 776, 16, 2,
           [=](int row0, int col, float4 v0, float4 v1) {
             if (col < 1024) {
#pragma unroll
               for (int j = 0; j < 4; ++j) {
                 KN[(long)(row0 + j) * 1024 + col] = f2bf(f4get(v0, j));
                 KN[(long)(row0 + j) * 1024 + col + 32] = f2bf(f4get(v1, j));
               }
             } else {
               const int vc = col - 1024;
               long base; int Lk, key;
               if (row0 < NTP) { const int b = row0 >> 13; key = row0 & 8191; Lk = 8192; base = (long)b * 1024 * 8192; }
               else { const int b = (row0 - NTP) / SLK; key = (row0 - NTP) - b * SLK; Lk = SLK; base = 4l * 1024 * 8192 + (long)b * 1024 * SLK; }
               store_t4(VT + base + (long)vc * Lk + vperm_key(key), v0);
               store_t4(VT + base + (long)(vc + 32) * Lk + vperm_key(key), v1);
             }
           });
}

DI void phase_sgu_in(const P& p, bf16_t* smem) {
  unsigned char* big = p.ws + W_BIG;
  bf16_t* U = (bf16_t*)(big + B_U);
  bf16_t* VR = (bf16_t*)(big + B_VRAW);
  run_gemm256<false>(p, 13, smem, (const bf16_t*)(p.ws + W_H), 1024, (const bf16_t*)(p.ws + W_SIN), 1024, 132, 32, 16,
           [=](int row0, int col, float4 v0, float4 v1, bool) {
             bf16_t* dst = (col < 2048) ? U + col : VR + (col - 2048);
#pragma unroll
             for (int j = 0; j < 4; ++j) {
               dst[(long)(row0 + j) * 2048] = f2bf(gelu_t(f4get(v0, j)));
               dst[(long)(row0 + j) * 2048 + 32] = f2bf(gelu_t(f4get(v1, j)));
             }
           });
}

DI void phase_sgu_norm(const P& p, float* smf) {
  unsigned char* big = p.ws + W_BIG;
  const bf16_t* VR = (const bf16_t*)(big + B_VRAW);
  bf16_t* VTS = (bf16_t*)(big + B_VTS);
  const float* gv = p.in[43];
  const int lane = threadIdx.x & 63, wave = threadIdx.x >> 6;
  __shared__ int s_qsn;
  DynQ dq = dynq_init(p, 22, 528 * 4);
  for (;;) {
    const int itq = dynq_pop(dq, &s_qsn);
    if (itq < 0) break;
    const int c64 = itq >> 2, qd = itq & 3;
    __syncthreads();
    for (int s = wave; s < 64; s += 4) {
      const bf16_t* rowp = VR + (long)(c64 * 64 + s) * 2048;
      float ss = 0.f;
#pragma unroll
      for (int i = 0; i < 4; ++i) {
        const uint4 q = *(const uint4*)(rowp + lane * 8 + 512 * i);
        const unsigned w[4] = {q.x, q.y, q.z, q.w};
#pragma unroll
        for (int e = 0; e < 4; ++e) {
          const float a = __uint_as_float(w[e] << 16), b = __uint_as_float(w[e] & 0xffff0000u);
          ss += a * a + b * b;
        }
      }
      ss = wave_sum(ss);
      if (lane == 0) smf[s] = rsqrtf(ss * (1.f / 2048.f) + NORM_EPS);
    }
    __syncthreads();
    for (int task = threadIdx.x; task < 128 * 8; task += 256) {
      const int d4 = (qd * 128 + (task & 127)) * 4, sg = task >> 7;
      const float4 g4 = *(const float4*)(gv + d4);
      float v[8][4];
#pragma unroll
      for (int j = 0; j < 8; ++j) {
        const int s = sg * 8 + j;
        const uint2 q = *(const uint2*)(VR + (long)(c64 * 64 + s) * 2048 + d4);
        const float rs = smf[s];
        v[j][0] = __uint_as_float(q.x << 16) * rs * g4.x;
        v[j][1] = __uint_as_float(q.x & 0xffff0000u) * rs * g4.y;
        v[j][2] = __uint_as_float(q.y << 16) * rs * g4.z;
        v[j][3] = __uint_as_float(q.y & 0xffff0000u) * rs * g4.w;
        if (c64 >= 512) *(float4*)(p.out + O_SGV + (long)((c64 - 512) * 64 + s) * 2048 + d4) = make_float4(v[j][0], v[j][1], v[j][2], v[j][3]);
      }
#pragma unroll
      for (int e = 0; e < 4; ++e) {
        uint4 o = {pack2(v[0][e], v[1][e]), pack2(v[2][e], v[3][e]), pack2(v[4][e], v[5][e]), pack2(v[6][e], v[7][e])};
        *(uint4*)(VTS + ((long)c64 * 2048 + d4 + e) * 64 + sg * 8) = o;
      }
    }
  }
}

DI void phase_sgu_spatial(const P& p, bf16_t* smem) {
  unsigned char* big = p.ws + W_BIG;
  const bf16_t* U = (const bf16_t*)(big + B_U);
  const bf16_t* VTS = (const bf16_t*)(big + B_VTS);
  bf16_t* G = (bf16_t*)(big + B_G);
  const float* bs = p.in[45];
  __shared__ int s_qsp;
  DynQ dq = dynq_init(p, 21, 264 * 16);
  for (;;) {
    const int t = dynq_pop(dq, &s_qsp);
    if (t < 0) break;
    const int mt = t >> 4, g = (t >> 1) & 7, dt = t & 1;
    const bf16_t* a0 = (const bf16_t*)(p.ws + (mt < 256 ? W_WS1 : W_WS2)) + g * 128 * 128;
    const bf16_t* b0 = VTS + ((long)mt * 2 * 2048 + g * 256 + dt * 128) * 64;
    const bool prompt = mt < 256;
    gemm_tile(smem, [=](int r, int kt) { return a0 + r * 128 + kt * 64; }, [=](int r, int kt) { return b0 + (long)kt * 2048 * 64 + r * 64; }, 2,
              [=](int row0, int col, float4 v0, float4 v1) {
                const int gc = g * 256 + dt * 128 + col;
#pragma unroll
                for (int j = 0; j < 4; ++j) {
                  const int tr = row0 + j;
                  const float bias = bs[g * 128 + (prompt ? tr : (tr & 63))];
                  const long o = (long)(mt * 128 + tr) * 2048 + gc;
                  G[o] = f2bf(bf2f(U[o]) * (f4get(v0, j) + bias));
                  G[o + 32] = f2bf(bf2f(U[o + 32]) * (f4get(v1, j) + bias));
                }
              });
  }
}

DI void phase_final_norm(const P& p) {
  const int lane = threadIdx.x & 63;
  const int wv = blockIdx.x * 4 + (threadIdx.x >> 6), nwv = gridDim.x * 4;
  const float* gam = p.in[16];
  for (int row = wv; row < NT; row += nwv) {
    float* x = p.out + (long)row * 1024;
    float4 v[4];
    float ss = 0.f;
#pragma unroll
    for (int i = 0; i < 4; ++i) {
      v[i] = *(const float4*)(x + lane * 4 + 256 * i);
      ss += v[i].x * v[i].x + v[i].y * v[i].y + v[i].z * v[i].z + v[i].w * v[i].w;
    }
    ss = wave_sum(ss);
    const float rinv = rsqrtf(ss * (1.f / 1024.f) + NORM_EPS);
#pragma unroll
    for (int i = 0; i < 4; ++i) {
      const int col = lane * 4 + 256 * i;
      const float4 g4 = *(const float4*)(gam + col);
      *(float4*)(x + col) = make_float4(v[i].x * rinv * g4.x, v[i].y * rinv * g4.y, v[i].z * rinv * g4.z, v[i].w * rinv * g4.w);
    }
  }
}

DI bf16x8 pack8(const f32x16& x, int s) {
  unsigned a = pack2(x[8 * s], x[8 * s + 1]), b = pack2(x[8 * s + 2], x[8 * s + 3]), c = pack2(x[8 * s + 4], x[8 * s + 5]), d = pack2(x[8 * s + 6], x[8 * s + 7]);
  uint4 u = {a, b, c, d};
  return __builtin_bit_cast(bf16x8, u);
}

DI unsigned xb_xcc_id_fwd() { return (unsigned)__builtin_amdgcn_s_getreg((3 << 11) | 20) & 0xFu; }
template <bool MLA>
DI void phase_attn(const P& p, bf16_t* smem) {
  constexpr int NKS = MLA ? 6 : 4;
  constexpr int NDT = MLA ? 2 : 4;
  constexpr int NLD = MLA ? 9 : 8;
  unsigned char* big = p.ws + W_BIG;
  const bf16_t* Q = (const bf16_t*)(big + (MLA ? B_QM : B_QB));
  const bf16_t* KK = (const bf16_t*)(big + (MLA ? B_KN : B_KB));
  const bf16_t* KR = (const bf16_t*)(big + B_KR);
  const bf16_t* VT = (const bf16_t*)(big + (MLA ? B_VTM : B_VTD));
  bf16_t* OB = (bf16_t*)(big + (MLA ? B_OBM : B_OB));
  const float lam = *(const float*)(p.ws + W_LAM);
  const float* gsub = p.in[32];
  const int tid = threadIdx.x, lane = tid & 63, wave = tid >> 6;
  const int wp = wave >> 1, wq = wave & 1, r = lane & 31, hh = lane >> 5;
  constexpr int L_K0 = 0, L_K1 = 4608, L_KR = 9216, L_V0 = MLA ? 11776 : 9216, L_V1 = 16384;
  __shared__ int s_item;
  unsigned* qctr = (unsigned*)(p.ws + W_CTRL) + 3584 + (MLA ? 64 : 0);
  const int xs = (int)(xb_xcc_id_fwd() & 7u);
  for (int pass = 0; pass < 8; ++pass) {
  const int hx = (xs + pass) & 7;
  for (;;) {
    if (tid == 0) s_item = (int)atomicAdd(&qctr[hx * 8], 1u);
    __syncthreads();
    const int jq = s_item;
    __syncthreads();
    if (jq >= 528) break;
    int b, qrow0, ntiles, Lk; long R0, vbase;
    if (jq < 16) {
      b = jq; qrow0 = NTP + b * 64; ntiles = 65; Lk = SLK;
      R0 = (long)NTP + (long)b * SLK; vbase = 4l * 1024 * 8192 + (long)b * 1024 * SLK;
    } else {
      const int i = jq - 16; const int qc = 127 - (i >> 2); b = i & 3;
      qrow0 = b * 8192 + qc * 64; ntiles = qc + 1; Lk = 8192; R0 = (long)b * 8192; vbase = (long)b * 1024 * 8192;
    }
    bf16x8 qf[NKS];
    {
      const long qr = (long)(qrow0 + wq * 32 + r);
      const bf16_t* qp = MLA ? Q + qr * 1536 + (hx * 2 + wp) * 96 + 8 * hh : Q + qr * 1024 + (hx * 2 + wp) * 64 + 8 * hh;
#pragma unroll
      for (int ks = 0; ks < NKS; ++ks) qf[ks] = *(const bf16x8*)(qp + ks * 16);
    }
    f32x16 O[NDT];
#pragma unroll
    for (int d = 0; d < NDT; ++d)
#pragma unroll
      for (int i = 0; i < 16; ++i) O[d][i] = 0.f;
    float m_run = -1e30f, l_run = 0.f;
    u32x4 ld[NLD];
#define ATT_GLOAD(KT)                                                                                                   \
  {                                                                                                                     \
    const long kr0 = R0 + (long)(KT) * 64;                                                                              \
    _Pragma("unroll") for (int j = 0; j < 4; ++j) {                                                                     \
      const int c = j >> 1, id = tid + 256 * (j & 1), key = id >> 3, ch = id & 7;                                       \
      ld[j] = *(const u32x4*)(KK + (kr0 + key) * 1024 + (hx * 2 + c) * 64 + ch * 8);                                    \
    }                                                                                                                   \
    if (!MLA) {                                                                                                         \
      _Pragma("unroll") for (int i = 0; i < 4; ++i) {                                                                   \
        const int id = tid + 256 * i, dv = id >> 3, ch = id & 7;                                                        \
        ld[4 + i] = *(const u32x4*)(VT + vbase + (long)(hx * 128 + dv) * Lk + (KT) * 64 + ch * 8);                      \
      }                                                                                                                 \
    } else {                                                                                                            \
      _Pragma("unroll") for (int j = 0; j < 4; ++j) {                                                                   \
        const int c = j >> 1, id = tid + 256 * (j & 1), dv = id >> 3, ch = id & 7;                                      \
        ld[4 + j] = *(const u32x4*)(VT + vbase + (long)((hx * 2 + c) * 64 + dv) * Lk + (KT) * 64 + ch * 8);             \
      }                                                                                                                 \
      ld[NLD - 1] = *(const u32x4*)(KR + (kr0 + (tid >> 2)) * 32 + (tid & 3) * 8);                                      \
    }                                                                                                                   \
  }
#define ATT_SWRITE()                                                                                                    \
  {                                                                                                                     \
    _Pragma("unroll") for (int j = 0; j < 4; ++j) {                                                                     \
      const int c = j >> 1, id = tid + 256 * (j & 1), key = id >> 3, ch = id & 7;                                       \
      *(u32x4*)(smem + (c ? L_K1 : L_K0) + key * LST + ch * 8) = ld[j];                                                 \
    }                                                                                                                   \
    if (!MLA) {                                                                                                         \
      _Pragma("unroll") for (int i = 0; i < 4; ++i) {                                                                   \
        const int id = tid + 256 * i, dv = id >> 3, ch = id & 7;                                                        \
        *(u32x4*)(smem + L_V0 + dv * LST + ch * 8) = ld[4 + i];                                                         \
      }                                                                                                                 \
    } else {                                                                                                            \
      _Pragma("unroll") for (int j = 0; j < 4; ++j) {                                                                   \
        const int c = j >> 1, id = tid + 256 * (j & 1), dv = id >> 3, ch = id & 7;                                      \
        *(u32x4*)(smem + (c ? L_V1 : L_V0) + dv * LST + ch * 8) = ld[4 + j];                                            \
      }                                                                                                                 \
      *(u32x4*)(smem + L_KR + (tid >> 2) * 40 + (tid & 3) * 8) = ld[NLD - 1];                                           \
    }                                                                                                                   \
  }
    ATT_GLOAD(0)
    const bf16_t* sK = smem + (wp ? L_K1 : L_K0);
    const bf16_t* sV = smem + ((MLA && wp) ? L_V1 : L_V0);
    for (int kt = 0; kt < ntiles; ++kt) {
      __syncthreads();
      ATT_SWRITE()
      __syncthreads();
      if (kt + 1 < ntiles) ATT_GLOAD(kt + 1)
      __builtin_amdgcn_sched_barrier(0);
      f32x16 st[2];
#pragma unroll
      for (int mt = 0; mt < 2; ++mt) {
#pragma unroll
        for (int i = 0; i < 16; ++i) st[mt][i] = 0.f;
#pragma unroll
        for (int ks = 0; ks < NKS; ++ks) {
          bf16x8 a;
          if (ks < 4) a = *(const bf16x8*)(sK + (mt * 32 + r) * LST + ks * 16 + 8 * hh);
          else a = *(const bf16x8*)(smem + L_KR + (mt * 32 + r) * 40 + (ks - 4) * 16 + 8 * hh);
          st[mt] = MFMA(a, qf[ks], st[mt]);
        }
      }
      float mloc = st[0][0];
#pragma unroll
      for (int i = 1; i < 16; ++i) mloc = fmaxf(mloc, st[0][i]);
#pragma unroll
      for (int i = 0; i < 16; ++i) mloc = fmaxf(mloc, st[1][i]);
      mloc = fmaxf(mloc, __shfl_xor(mloc, 32));
      const bool need = mloc > m_run + 8.f;
      if (__any(need)) {
        const float mnew = need ? mloc : m_run;
        const float alpha = __builtin_amdgcn_exp2f(m_run - mnew);
        m_run = mnew;
        l_run *= alpha;
#pragma unroll
        for (int d = 0; d < NDT; ++d)
#pragma unroll
          for (int i = 0; i < 16; ++i) O[d][i] *= alpha;
      }
      float ps = 0.f;
#pragma unroll
      for (int mt = 0; mt < 2; ++mt)
#pragma unroll
        for (int i = 0; i < 16; ++i) { const float e = __builtin_amdgcn_exp2f(st[mt][i] - m_run); st[mt][i] = e; ps += e; }
      l_run += ps;
#pragma unroll
      for (int k2 = 0; k2 < 4; ++k2) {
        const bf16x8 pf = pack8(st[k2 >> 1], k2 & 1);
#pragma unroll
        for (int d = 0; d < NDT; ++d) {
          const bf16x8 va = *(const bf16x8*)(sV + (d * 32 + r) * LST + 16 * k2 + 8 * hh);
          O[d] = MFMA(va, pf, O[d]);
        }
      }
    }
    const float ltot = l_run + __shfl_xor(l_run, 32);
    const float linv = 1.f / ltot;
    const long orow = (long)(qrow0 + wq * 32 + r);
    if (MLA) {
#pragma unroll
      for (int d = 0; d < NDT; ++d)
#pragma unroll
        for (int g = 0; g < 4; ++g) {
          uint2 o = {pack2(O[d][4 * g] * linv, O[d][4 * g + 1] * linv), pack2(O[d][4 * g + 2] * linv, O[d][4 * g + 3] * linv)};
          *(uint2*)(OB + orow * 1024 + (hx * 2 + wp) * 64 + d * 32 + 8 * g + 4 * hh) = o;
        }
    } else {
      float* xs = (float*)smem;
      __syncthreads();
      if (wp == 1) {
#pragma unroll
        for (int d = 0; d < NDT; ++d)
#pragma unroll
          for (int i = 0; i < 16; ++i) xs[(wq * 64 + d * 16 + i) * 64 + lane] = O[d][i] * linv;
      }
      __syncthreads();
      if (wp == 0) {
        float ss = 0.f;
#pragma unroll
        for (int d = 0; d < NDT; ++d)
#pragma unroll
          for (int i = 0; i < 16; ++i) {
            const float o = O[d][i] * linv - lam * xs[(wq * 64 + d * 16 + i) * 64 + lane];
            O[d][i] = o; ss += o * o;
          }
        ss += __shfl_xor(ss, 32);
        const float rinv = rsqrtf(ss * (1.f / 128.f) + NORM_EPS) * (1.f - LAMBDA_INIT);
#pragma unroll
        for (int d = 0; d < NDT; ++d)
#pragma unroll
          for (int g = 0; g < 4; ++g) {
            const int dv = d * 32 + 8 * g + 4 * hh;
            const float4 gs4 = *(const float4*)(gsub + dv);
            uint2 o = {pack2(O[d][4 * g] * rinv * gs4.x, O[d][4 * g + 1] * rinv * gs4.y), pack2(O[d][4 * g + 2] * rinv * gs4.z, O[d][4 * g + 3] * rinv * gs4.w)};
            *(uint2*)(OB + orow * 1024 + hx * 128 + dv) = o;
          }
      }
    }
  }
  }
}


#define XB_TMO      128
#define XB_XCNT(j)  (256  + 64 * (j))
#define XB_XSUB(j)  (1280 + 64 * (j))
#define XB_XGEN(j)  (2304 + 64 * (j))
#define XB_TOP      3328
#define XB_TOPGEN   3392
#define XCD_BAR_WORDS 3456
#define XB_SPIN_CAP (1u << 22)
#define LAS __attribute__((address_space(3)))
DI unsigned xb_ld(unsigned* p) { return __hip_atomic_load(p, __ATOMIC_RELAXED, __HIP_MEMORY_SCOPE_AGENT); }
DI unsigned xb_add(unsigned* p, unsigned v) { return __hip_atomic_fetch_add(p, v, __ATOMIC_RELAXED, __HIP_MEMORY_SCOPE_AGENT); }
DI unsigned xb_xcc_id() { return (unsigned)__builtin_amdgcn_s_getreg((3 << 11) | 20) & 0xFu; }
#define XB_SPIN(cond, bar) do { unsigned _sp = 0; while (cond) { __builtin_amdgcn_s_sleep(1); \
    if ((++_sp & 255u) == 0u) { if (xb_ld(&(bar)[XB_TMO])) break; if (_sp > XB_SPIN_CAP) { atomicAdd(&(bar)[XB_TMO], 1u); break; } } } } while (0)
struct XcdBarrier { unsigned* bar; unsigned x; volatile LAS unsigned* st; };
DI XcdBarrier xcd_barrier_post(unsigned* bar, volatile LAS unsigned* st) {
  XcdBarrier b; b.bar = bar; b.x = xb_xcc_id(); b.st = st;
  if (threadIdx.x == 0) (void)xb_add(&bar[XB_XCNT(b.x)], 1u);
  return b;
}
DI void xcd_barrier_complete(unsigned* bar, unsigned x, unsigned& nloc, unsigned& nx) {
  const unsigned G = gridDim.x * gridDim.y * gridDim.z;
  unsigned sum, cnt, mine, sp = 0u;
  for (;;) {
    sum = 0u; cnt = 0u; mine = 0u;
#pragma unroll
    for (unsigned j = 0; j < 16; ++j) { const unsigned c = xb_ld(&bar[XB_XCNT(j)]); sum += c; cnt += (c > 0u) ? 1u : 0u; mine = (j == x) ? c : mine; }
    if (sum == G) break;
    __builtin_amdgcn_s_sleep(1);
    if ((++sp & 255u) == 0u) { if (xb_ld(&bar[XB_TMO])) break; if (sp > XB_SPIN_CAP) { atomicAdd(&bar[XB_TMO], 1u); break; } }
  }
  nloc = mine > 0u ? mine : 1u; nx = cnt > 0u ? cnt : 1u;
}
DI void xcd_barrier(const XcdBarrier& b) {
  asm volatile("s_waitcnt vmcnt(0)" ::: "memory");
  __syncthreads();
  if (threadIdx.x == 0) {
    unsigned* bar = b.bar;
    __builtin_amdgcn_s_waitcnt(0);
    unsigned nloc = b.st[0], nx = b.st[1];
    if (nloc == 0u) { xcd_barrier_complete(bar, b.x, nloc, nx); b.st[0] = nloc; b.st[1] = nx; }
    const unsigned old = xb_add(&bar[XB_XSUB(b.x)], 1u);
    const unsigned gen = old / nloc;
    if (old + 1u == (gen + 1u) * nloc) {
      __builtin_amdgcn_fence(__ATOMIC_RELEASE, "agent");
      asm volatile("s_waitcnt vmcnt(0)" ::: "memory");
      const unsigned og = xb_add(&bar[XB_TOP], 1u);
      const unsigned tg = og / nx;
      if (og + 1u == (tg + 1u) * nx) xb_add(&bar[XB_TOPGEN], 1u);
      else XB_SPIN(xb_ld(&bar[XB_TOPGEN]) == tg, bar);
      __builtin_amdgcn_fence(__ATOMIC_ACQUIRE, "agent");
      xb_add(&bar[XB_XGEN(b.x)], 1u);
      asm volatile("s_waitcnt vmcnt(0)" ::: "memory");
    } else {
      XB_SPIN(xb_ld(&bar[XB_XGEN(b.x)]) == gen, bar);
      __builtin_amdgcn_fence(__ATOMIC_ACQUIRE, "agent");
      asm volatile("s_waitcnt vmcnt(0)" ::: "memory");
    }
  }
  __syncthreads();
}

constexpr int NPH = 35;
__global__ void __launch_bounds__(256, 2) mk_forward(P p) {
  __shared__ __attribute__((aligned(16))) unsigned char smem_raw[73728];
  cg::grid_group grid = cg::this_grid();
  __shared__ uint4 xb_words;
  if (threadIdx.x == 0) xb_words = make_uint4(0u, 0u, 0u, 0u);
  __syncthreads();
  XcdBarrier xb;
  xb.bar = (unsigned*)(p.ws + W_CTRL); xb.x = 0; xb.st = (volatile LAS unsigned*)&xb_words;
  if (p.hi - p.lo > 1) xb = xcd_barrier_post((unsigned*)(p.ws + W_CTRL), (volatile LAS unsigned*)&xb_words);
  bf16_t* smem = (bf16_t*)smem_raw;
  float* smf = (float*)smem_raw;
  unsigned char* big = p.ws + W_BIG;
  int ph = 0;
#ifdef PROBE_DUP_UP
#define PROBE_UP(l) __syncthreads(); phase_mlp_up(p, smem, l)
#else
#define PROBE_UP(l)
#endif
#ifdef PROBE_DUP_ATTN
#define PROBE_AT(m) __syncthreads(); phase_attn<m>(p, smem)
#else
#define PROBE_AT(m)
#endif
#ifndef ONLY_PH
#define ONLY_PH -1
#endif
#ifndef DUPMASK
#define DUPMASK 0ull
#endif
#define PH(...) { if ((ONLY_PH < 0 || ph == ONLY_PH) && ph >= p.lo && ph < p.hi) { __VA_ARGS__; if ((DUPMASK >> ph) & 1ull) { __syncthreads(); __VA_ARGS__; } } ++ph; if (ph > p.lo && ph < p.hi) { if (p.hi < 0) grid.sync(); else xcd_barrier(xb); } }
  PH(phase0(p, smf))
  PH(phase1(p))
  PH(phase_modulate<1>(p, 0, 0))
  PH(phase_s5a(p, smem))
  PH(phase_s5_carry(p))
  PH(phase_s5b(p, smem))
  PH(phase_glu(p, smem))
  PH(phase_modulate<0>(p, 0, 1))
  PH(phase_mlp_up(p, smem, 0); PROBE_UP(0))
  PH(phase_mlp_down(p, smem, 0))
  PH(phase_modulate<0>(p, 1, 0))
  PH(phase_qkv(p, smem))
  PH(phase_attn<false>(p, smem); PROBE_AT(false))
  PH(phase_proj_resid(p, smem, (const bf16_t*)(big + B_OB), 1024, (const bf16_t*)(p.ws + W_DWO), 1))
  PH(phase_modulate<0>(p, 1, 1))
  PH(phase_mlp_up(p, smem, 1); PROBE_UP(1))
  PH(phase_mlp_down(p, smem, 1))
  PH(phase_modulate<0>(p, 2, 0))
  PH(phase_mla_down(p, smem))
  PH(phase_mla_norm(p))
  PH(phase_mla_up(p, smem))
  PH(phase_attn<true>(p, smem); PROBE_AT(true))
  PH(phase_proj_resid(p, smem, (const bf16_t*)(big + B_OBM), 1024, (const bf16_t*)(p.ws + W_MWO), 2))
  PH(phase_modulate<0>(p, 2, 1))
  PH(phase_mlp_up(p, smem, 2); PROBE_UP(2))
  PH(phase_mlp_down(p, smem, 2))
  PH(phase_modulate<0>(p, 3, 0))
  PH(phase_sgu_in(p, smem))
  PH(phase_sgu_norm(p, smf))
  PH(phase_sgu_spatial(p, smem))
  PH(phase_proj_resid(p, smem, (const bf16_t*)(big + B_G), 2048, (const bf16_t*)(p.ws + W_SOUT), 3))
  PH(phase_modulate<0>(p, 3, 1))
  PH(phase_mlp_up(p, smem, 3); PROBE_UP(3))
  PH(phase_mlp_down(p, smem, 3))
  PH(phase_final_norm(p))
#undef PH
}

extern "C" void kernel_launch(void* const* d_in, const int* in_sizes, int n_in, void* d_out, int out_size, void* d_ws, size_t ws_size,
                              hipStream_t stream) {
  static int grid_blocks = 0;
  if (!grid_blocks) {
    int dev = 0, cus = 0, per_cu = 0;
    hipGetDevice(&dev);
    hipDeviceGetAttribute(&cus, hipDeviceAttributeMultiprocessorCount, dev);
    hipOccupancyMaxActiveBlocksPerMultiprocessor(&per_cu, mk_forward, 256, 0);
    if (per_cu < 1) per_cu = 1;
    if (per_cu > 2) per_cu = 2;
    grid_blocks = cus * per_cu;
    if (ws_size < WS_NEED) fprintf(stderr, "kernel_launch: workspace too small: %zu < %zu\n", ws_size, (size_t)WS_NEED);
  }
  P p{};
  for (int i = 0; i < 47; ++i) p.in[i] = (const float*)d_in[i];
  p.out = (float*)d_out;
  p.ws = (unsigned char*)d_ws;
#if MK_SINGLE
  (void)hipMemsetAsync(d_ws, 0, 32768, stream);
  p.lo = 0; p.hi = NPH;
  void* args[] = {&p};
  hipError_t e = hipLaunchCooperativeKernel((void*)mk_forward, dim3(grid_blocks), dim3(256), args, 0, stream);
  if (e != hipSuccess) fprintf(stderr, "cooperative launch failed: %s (grid %d)\n", hipGetErrorString(e), grid_blocks);
#else
  for (int ph = 0; ph < NPH; ++ph) {
    p.lo = ph; p.hi = ph + 1;
    hipLaunchKernelGGL(mk_forward, dim3(grid_blocks), dim3(256), 0, stream, p);
  }
#endif
}
```

```cpp
#include <hip/hip_runtime.h>
#include <hip/hip_cooperative_groups.h>
#include <stdint.h>
#include <stdio.h>
namespace cg = cooperative_groups;

#ifndef MK_SINGLE
#define MK_SINGLE 1
#endif

typedef unsigned short bf16_t;
typedef __attribute__((ext_vector_type(8))) short bf16x8;
typedef __attribute__((ext_vector_type(4))) short s16x4;
typedef __attribute__((ext_vector_type(4))) unsigned u32x4;
typedef __attribute__((ext_vector_type(16))) float f32x16;
typedef __bf16 bf2_t __attribute__((ext_vector_type(2)));
typedef float fl2_t __attribute__((ext_vector_type(2)));
#define DI __device__ __forceinline__
#define MFMA(a, b, c) __builtin_amdgcn_mfma_f32_32x32x16_bf16((a), (b), (c), 0, 0, 0)

constexpr int NTP = 32768, NTS = 1024, NT = 33792;
constexpr int SLK = 4160;
constexpr int KROWS = 99328;
constexpr float NORM_EPS = 1e-6f;
constexpr float LAMBDA_INIT = 0.35550906759096933f;
constexpr float L2E = 1.4426950408889634f;

constexpr size_t O_S5RP = (size_t)NT * 1024, O_S5IP = O_S5RP + 16384, O_S5RS = O_S5IP + 16384, O_S5IS = O_S5RS + 65536,
                 O_DKP = O_S5IS + 65536, O_DVP = O_DKP + (size_t)NTP * 1024, O_DKS = O_DVP + (size_t)NTP * 1024,
                 O_DVS = O_DKS + (size_t)NTS * 1024, O_CKP = O_DVS + (size_t)NTS * 1024, O_KRP = O_CKP + (size_t)NTP * 128,
                 O_CKS = O_KRP + (size_t)NTP * 32, O_KRS = O_CKS + (size_t)NTS * 128, O_SGV = O_KRS + (size_t)NTS * 32;

constexpr size_t W_CTRL = 0;
constexpr size_t W_LAM = 32768;
constexpr size_t W_MODP = W_LAM + 256;
constexpr size_t W_MOD = W_MODP + 8ull * 20 * 24576 * 4;
constexpr size_t W_AP = W_MOD + 20ull * 24576 * 4;
constexpr size_t W_BBAR = W_AP + 64ull * 65 * 64 * 8;
constexpr size_t W_E = W_BBAR + 64ull * 64 * 16 * 8;
constexpr size_t W_CH = W_E + 64ull * 16 * 2048 * 2;
constexpr size_t W_MEND = W_CH + 64ull * 1024 * 128 * 2;
constexpr size_t W_WS1 = W_MEND + 64ull * 128 * 1024 * 2;
constexpr size_t W_WS2 = W_WS1 + 8ull * 128 * 128 * 2;
constexpr size_t W_WUP = W_WS2 + 8ull * 128 * 128 * 2;
constexpr size_t W_WDN = W_WUP + 4ull * 4096 * 1024 * 2;
constexpr size_t W_GLU = W_WDN + 4ull * 4096 * 1024 * 2;
constexpr size_t W_QKV = W_GLU + 2048ull * 1024 * 2;
constexpr size_t W_DWO = W_QKV + 3072ull * 1024 * 2;
constexpr size_t W_MD = W_DWO + 1024ull * 1024 * 2;
constexpr size_t W_MUQ = W_MD + 512ull * 1024 * 2;
constexpr size_t W_MUKV = W_MUQ + 1536ull * 256 * 2;
constexpr size_t W_MWO = W_MUKV + 2048ull * 128 * 2;
constexpr size_t W_SIN = W_MWO + 1024ull * 1024 * 2;
constexpr size_t W_SOUT = W_SIN + 4096ull * 1024 * 2;
constexpr size_t W_H = W_SOUT + 1024ull * 2048 * 2;
constexpr size_t W_BIG = W_H + (size_t)NT * 1024 * 2;
constexpr size_t B_HG = 0, B_SLOC = 94371840ull, B_Z = 115343360ull;
constexpr size_t B_ACT = 0;
constexpr size_t B_QB = 0, B_KB = 545259520ull, B_VTD = 272629760ull, B_OB = 476053504ull;
constexpr size_t B_RAW = 0, B_CQ = 51904512ull, B_OBM = 0, B_CKV = 69206016ull, B_KR = 94633984ull, B_QM = 100990976ull,
                 B_KN = 204800000ull, B_VTM = 408223744ull;
constexpr size_t B_U = 0, B_VRAW = 138412032ull, B_VTS = 276824064ull, B_G = 415236096ull;
constexpr size_t WS_NEED = W_BIG + 748683264ull;

struct P {
  const float* in[47];
  float* out;
  unsigned char* ws;
  int lo, hi;
};

DI unsigned pack2(float a, float b) {
  fl2_t f = {a, b};
  bf2_t r = __builtin_convertvector(f, bf2_t);
  return __builtin_bit_cast(unsigned, r);
}
DI bf16_t f2bf(float a) { return (bf16_t)(pack2(a, 0.f) & 0xffffu); }
DI float bf2f(bf16_t v) { return __uint_as_float(((unsigned)v) << 16); }
DI float gelu_t(float x) {
  float u = 0.7978845608028654f * (x + 0.044715f * x * x * x);
  float t = 1.f - 2.f / (__expf(2.f * u) + 1.f);
  return 0.5f * x * (1.f + t);
}
DI float sigmoid_f(float x) { return 1.f / (1.f + __expf(-x)); }
DI int batch_of(int row) { return row < NTP ? (row >> 13) : 4 + ((row - NTP) >> 6); }
DI int pos_of(int row) { return row < NTP ? (row & 8191) : 4096 + ((row - NTP) & 63); }
DI int krow_of(int row) { return row < NTP ? row : NTP + ((row - NTP) >> 6) * SLK + 4096 + ((row - NTP) & 63); }
DI void rope_cs(int pos, float invf, float& c, float& s) {
  double t = (double)pos * (double)invf * 0.15915494309189535;
  t -= __builtin_rint(t);
  float ft = (float)t;
  c = __builtin_amdgcn_cosf(ft);
  s = __builtin_amdgcn_sinf(ft);
}
DI float wave_sum(float v) {
#pragma unroll
  for (int o = 32; o > 0; o >>= 1) v += __shfl_xor(v, o);
  return v;
}

DI unsigned xcc_id_() { return (unsigned)__builtin_amdgcn_s_getreg((3 << 11) | 20) & 0xFu; }
struct DynQ {
  unsigned* ctr; int G, per, nq, items, x0, pass, x;
};
DI DynQ dynq_init(const P& p, int qid, int items) {
  DynQ q; q.ctr = (unsigned*)(p.ws + W_CTRL) + 4096 + qid * 64; q.G = gridDim.x; q.nq = ((q.G & 7) == 0) ? 8 : 1; q.per = q.G / q.nq;
  q.items = items; q.x0 = (int)(xcc_id_() & 7u) % q.nq; q.pass = 0; q.x = q.x0; return q;
}
DI int dynq_pop(DynQ& q, int* s_slot) {
  for (;;) {
    if (q.pass >= q.nq) return -1;
    if (threadIdx.x == 0) *s_slot = (int)atomicAdd(&q.ctr[q.x * 8], 1u);
    __syncthreads();
    const int j = *s_slot;
    __syncthreads();
    const int it = (j / q.per) * q.G + q.x * q.per + (j % q.per);
    if (it < q.items) return it;
    ++q.pass; q.x = (q.x0 + q.pass) % q.nq;
  }
}


constexpr int LST = 72;
template <class AF, class BF, class EPI>
DI void gemm_tile(bf16_t* smem, AF af, BF bf, int nkt, EPI epi) {
  const int tid = threadIdx.x, lane = tid & 63, wave = tid >> 6;
  const int wm = wave >> 1, wn = wave & 1, r = lane & 31, h = lane >> 5;
  bf16_t* sA = smem;
  bf16_t* sB = smem + 2 * 128 * LST;
  f32x16 acc[2][2];
#pragma unroll
  for (int a = 0; a < 2; ++a)
#pragma unroll
    for (int b = 0; b < 2; ++b)
#pragma unroll
      for (int i = 0; i < 16; ++i) acc[a][b][i] = 0.f;
  const int lr = tid >> 3, lc = (tid & 7) * 8;
  u32x4 ra[4], rb[4];
#pragma unroll
  for (int i = 0; i < 4; ++i) {
    ra[i] = *(const u32x4*)(af(lr + 32 * i, 0) + lc);
    rb[i] = *(const u32x4*)(bf(lr + 32 * i, 0) + lc);
  }
#pragma unroll
  for (int i = 0; i < 4; ++i) {
    *(u32x4*)(sA + (lr + 32 * i) * LST + lc) = ra[i];
    *(u32x4*)(sB + (lr + 32 * i) * LST + lc) = rb[i];
  }
  __syncthreads();
  for (int kt = 0; kt < nkt; ++kt) {
    const bool more = (kt + 1 < nkt);
    if (more) {
#pragma unroll
      for (int i = 0; i < 4; ++i) {
        ra[i] = *(const u32x4*)(af(lr + 32 * i, kt + 1) + lc);
        rb[i] = *(const u32x4*)(bf(lr + 32 * i, kt + 1) + lc);
      }
    }
    __builtin_amdgcn_sched_barrier(0);
    const bf16_t* pa = sA + (kt & 1) * 128 * LST + (wm * 64 + r) * LST + h * 8;
    const bf16_t* pb = sB + (kt & 1) * 128 * LST + (wn * 64 + r) * LST + h * 8;
#pragma unroll
    for (int ks = 0; ks < 4; ++ks) {
      bf16x8 a0 = *(const bf16x8*)(pa + ks * 16);
      bf16x8 a1 = *(const bf16x8*)(pa + 32 * LST + ks * 16);
      bf16x8 b0 = *(const bf16x8*)(pb + ks * 16);
      bf16x8 b1 = *(const bf16x8*)(pb + 32 * LST + ks * 16);
      acc[0][0] = MFMA(a0, b0, acc[0][0]);
      acc[0][1] = MFMA(a0, b1, acc[0][1]);
      acc[1][0] = MFMA(a1, b0, acc[1][0]);
      acc[1][1] = MFMA(a1, b1, acc[1][1]);
    }
    if (more) {
      const int nb = ((kt + 1) & 1) * 128 * LST;
#pragma unroll
      for (int i = 0; i < 4; ++i) {
        *(u32x4*)(sA + nb + (lr + 32 * i) * LST + lc) = ra[i];
        *(u32x4*)(sB + nb + (lr + 32 * i) * LST + lc) = rb[i];
      }
    }
    __syncthreads();
  }
#pragma unroll
  for (int mi = 0; mi < 2; ++mi)
#pragma unroll
    for (int g = 0; g < 4; ++g) {
      float4 v0 = {acc[mi][0][4 * g], acc[mi][0][4 * g + 1], acc[mi][0][4 * g + 2], acc[mi][0][4 * g + 3]};
      float4 v1 = {acc[mi][1][4 * g], acc[mi][1][4 * g + 1], acc[mi][1][4 * g + 2], acc[mi][1][4 * g + 3]};
      epi(wm * 64 + mi * 32 + 8 * g + 4 * h, wn * 64 + r, v0, v1);
      __builtin_amdgcn_sched_barrier(0);
    }
}


DI int vperm_key(int key) { const int q = (key >> 2) & 3; const int q2 = ((q & 1) << 1) | (q >> 1); return (key & ~15) | (q2 << 2); }

DI void conv_k_slice(const P& p, long t0, int n) {
  const float* ck = p.in[6];
  bf16_t* Kb = (bf16_t*)(p.ws + W_BIG + B_KB);
  for (int i = 0; i < n; ++i) {
    const long idx = t0 + (long)i * 256 + threadIdx.x;
    if (idx < 16l * 4096 * 128) {
      const long rowc = idx >> 7; const int c8 = (int)(idx & 127) * 8;
      const int b = (int)(rowc >> 12), jk = (int)(rowc & 4095);
      const float4 a = *(const float4*)(ck + rowc * 1024 + c8), bq = *(const float4*)(ck + rowc * 1024 + c8 + 4);
      uint4 o = {pack2(a.x, a.y), pack2(a.z, a.w), pack2(bq.x, bq.y), pack2(bq.z, bq.w)};
      *(uint4*)(Kb + ((long)NTP + (long)b * SLK + jk) * 1024 + c8) = o;
    }
  }
}
DI void conv_v_slice(const P& p, long t0, int n) {
  const float* cv = p.in[7];
  bf16_t* VT = (bf16_t*)(p.ws + W_BIG + B_VTD);
  for (int i = 0; i < n; ++i) {
    const long idx = t0 + (long)i * 256 + threadIdx.x;
    if (idx < 16l * 512 * 1024) {
      const int hd = (int)(idx & 1023); const long t = idx >> 10;
      const int kg = (int)(t & 511), b = (int)(t >> 9);
      const float* src = cv + ((long)b * 4096 + kg * 8) * 1024 + hd;
      const float v0 = src[0], v1 = src[1024], v2 = src[2048], v3 = src[3072], v4 = src[4096], v5 = src[5120], v6 = src[6144], v7 = src[7168];
      bf16_t* vd = VT + 4l * 1024 * 8192 + (long)b * 1024 * SLK + (long)hd * SLK;
      *(uint2*)(vd + vperm_key(kg * 8)) = make_uint2(pack2(v0, v1), pack2(v2, v3));
      *(uint2*)(vd + vperm_key(kg * 8 + 4)) = make_uint2(pack2(v4, v5), pack2(v6, v7));
    }
  }
}


typedef __attribute__((ext_vector_type(4))) float f32x4;
#define MFMA16(a, b, c) __builtin_amdgcn_mfma_f32_16x16x32_bf16((a), (b), (c), 0, 0, 0)
constexpr int LS2 = 80;
template <class EPI>
DI void gemm_tile256(bf16_t* smem, const bf16_t* __restrict__ Ab, int lda, const bf16_t* __restrict__ Bb, int ldb, int nkt, EPI epi) {
  const int tid = threadIdx.x, lane = tid & 63, wave = tid >> 6;
  const int wm = wave >> 1, wn = wave & 1, l15 = lane & 15, quad = lane >> 4;
  bf16_t* sA = smem;
  bf16_t* sB = smem + 256 * LS2;
  f32x4 acc[8][4];
#pragma unroll
  for (int a = 0; a < 8; ++a)
#pragma unroll
    for (int b = 0; b < 4; ++b)
#pragma unroll
      for (int i = 0; i < 4; ++i) acc[a][b][i] = 0.f;
  const int lr = tid >> 3, lc = (tid & 7) * 8;
  u32x4 rg[12];
  unsigned offa = (unsigned)(lr * lda + lc), offb = (unsigned)(lr * ldb + lc);
  const unsigned sta = 32u * lda, stb = 32u * ldb;
#pragma unroll
  for (int i = 0; i < 8; ++i) rg[i] = *(const u32x4*)(Ab + (offa + i * sta));
#pragma unroll
  for (int i = 0; i < 4; ++i) rg[8 + i] = *(const u32x4*)(Bb + (offb + i * stb));
  for (int kt = 0; kt < nkt; ++kt) {
    __syncthreads();
#pragma unroll
    for (int i = 0; i < 8; ++i) *(u32x4*)(sA + (lr + 32 * i) * LS2 + lc) = rg[i];
#pragma unroll
    for (int i = 0; i < 4; ++i) *(u32x4*)(sB + (lr + 32 * i) * LS2 + lc) = rg[8 + i];
    __syncthreads();
    if (kt + 1 < nkt) {
      offa += 64u; offb += 64u;
#pragma unroll
      for (int i = 0; i < 8; ++i) rg[i] = *(const u32x4*)(Ab + (offa + i * sta));
#pragma unroll
      for (int i = 0; i < 4; ++i) rg[8 + i] = *(const u32x4*)(Bb + (offb + i * stb));
    }
    __builtin_amdgcn_sched_barrier(0);
    const bf16_t* pa = sA + (wm * 128 + l15) * LS2 + quad * 8;
    const bf16_t* pb = sB + (wn * 64 + l15) * LS2 + quad * 8;
#pragma unroll
    for (int ks = 0; ks < 2; ++ks) {
      bf16x8 bfr[4];
#pragma unroll
      for (int ni = 0; ni < 4; ++ni) bfr[ni] = *(const bf16x8*)(pb + ni * 16 * LS2 + ks * 32);
#pragma unroll
      for (int mi = 0; mi < 8; ++mi) {
        const bf16x8 a = *(const bf16x8*)(pa + mi * 16 * LS2 + ks * 32);
#pragma unroll
        for (int ni = 0; ni < 4; ++ni) acc[mi][ni] = MFMA16(a, bfr[ni], acc[mi][ni]);
        if ((mi & 3) == 3) __builtin_amdgcn_sched_barrier(0);
      }
    }
  }
  __syncthreads();
#pragma unroll
  for (int mi = 0; mi < 8; ++mi)
#pragma unroll
    for (int pr = 0; pr < 2; ++pr) {
      float4 v0 = {acc[mi][pr][0], acc[mi][pr][1], acc[mi][pr][2], acc[mi][pr][3]};
      float4 v1 = {acc[mi][pr + 2][0], acc[mi][pr + 2][1], acc[mi][pr + 2][2], acc[mi][pr + 2][3]};
      epi(wm * 128 + mi * 16 + quad * 4, wn * 64 + pr * 16 + l15, v0, v1);
      __builtin_amdgcn_sched_barrier(0);
    }
}

template <bool SPLIT, class EPI>
DI void run_gemm256(const P& p, int qid, bf16_t* smem, const bf16_t* A, int lda, const bf16_t* B, int ldb, int mtiles, int ntiles, int nkt, EPI epi, int sidejob = 0) {
  const int T = mtiles * ntiles, G = gridDim.x;
  int full = T, S = 1;
  if (SPLIT) {
    const int R = T % G;
    if (R > 0) {
      full = T - R;
      S = 16;
      while (S > 1 && (S * R > G || S > nkt)) S >>= 1;
    }
  }
  const int items = full + (T - full) * S;
  __shared__ int s_git;
  DynQ dq = dynq_init(p, qid, items);
  for (;;) {
    const int it = dynq_pop(dq, &s_git);
    if (it < 0) break;
    int t = it, k0 = 0, nk = nkt; bool part = false;
    if (it >= full) { const int j = it - full; t = full + j / S; nk = nkt / S; k0 = (j % S) * nk; part = (S > 1); }
    const int mt = t / ntiles, nt = t % ntiles;
    const bf16_t* a0 = A + (long)mt * 256 * lda + k0 * 64;
    const bf16_t* b0 = B + (long)nt * 128 * ldb + k0 * 64;
    gemm_tile256(smem, a0, lda, b0, ldb, nk,
                 [=](int row0, int col, float4 v0, float4 v1) { epi(mt * 256 + row0, nt * 128 + col, v0, v1, part); });
    if (sidejob == 2 && it < 1024) { conv_v_slice(p, (long)it * 8192, 32); conv_k_slice(p, (long)it * 8192, 32); }
  }
}

DI float f4get(const float4& v, int j) { return j == 0 ? v.x : (j == 1 ? v.y : (j == 2 ? v.z : v.w)); }

template <class F>
DI void prep_w(bf16_t* dst, int K, int N, int ld, F colsrc) {
  const long total = (long)N * (K / 8);
  for (long idx = (long)blockIdx.x * 256 + threadIdx.x; idx < total; idx += (long)gridDim.x * 256) {
    const int n = (int)(idx % N);
    const int kg = (int)(idx / N);
    const float* s = colsrc(n);
    uint4 o = {0u, 0u, 0u, 0u};
    if (s) {
      s += (long)kg * 8 * ld;
      float v0 = s[0], v1 = s[(long)ld], v2 = s[2l * ld], v3 = s[3l * ld], v4 = s[4l * ld], v5 = s[5l * ld], v6 = s[6l * ld], v7 = s[7l * ld];
      o.x = pack2(v0, v1); o.y = pack2(v2, v3); o.z = pack2(v4, v5); o.w = pack2(v6, v7);
    }
    *(uint4*)(dst + (long)n * K + kg * 8) = o;
  }
}

DI void phase0(const P& p, float* smf) {
  unsigned char* ws = p.ws;
  const int gt = blockIdx.x * 256 + threadIdx.x, gs = gridDim.x * 256;
  {
    float* modp = (float*)(ws + W_MODP);
    __shared__ int s_qmp;
    DynQ dq = dynq_init(p, 24, 768);
    for (;;) {
      const int it = dynq_pop(dq, &s_qmp);
      if (it < 0) break;
      const int kc = it / 96, ch = it % 96;
      __syncthreads();
      for (int e = threadIdx.x; e < 20 * 128; e += 256) {
        const int m = e >> 7, k = e & 127;
        const float c = (m < 4) ? p.in[2][m * 1024 + kc * 128 + k] : p.in[3][(m - 4) * 1024 + kc * 128 + k];
        smf[k * 20 + m] = c / (1.f + __expf(-c));
      }
      __syncthreads();
      const int n = ch * 256 + threadIdx.x;
      const int layer = n / 6144, col = n % 6144;
      const float* w = p.in[10] + ((long)(layer * 1024 + kc * 128)) * 6144 + col;
      float acc[20];
#pragma unroll
      for (int m = 0; m < 20; ++m) acc[m] = 0.f;
      for (int k = 0; k < 128; ++k) {
        const float wv = w[(long)k * 6144];
#pragma unroll
        for (int m = 0; m < 20; ++m) acc[m] += smf[k * 20 + m] * wv;
      }
#pragma unroll
      for (int m = 0; m < 20; ++m) modp[(long)(kc * 20 + m) * 24576 + n] = acc[m];
    }
  }
  {
    float2* ap = (float2*)(ws + W_AP);
    for (int idx = gt; idx < 64 * 65 * 64; idx += gs) {
      const int g = idx / (65 * 64), tau = (idx / 64) % 65, pp = idx & 63;
      const float dt = expf(p.in[24][g]);
      const float are = p.in[17][g * 64 + pp], aim = p.in[18][g * 64 + pp];
      const float mag = expf(are * dt * (float)tau);
      double t = (double)aim * (double)dt * (double)tau * 0.15915494309189535;
      t -= __builtin_rint(t);
      const float ft = (float)t;
      ap[idx] = make_float2(mag * __builtin_amdgcn_cosf(ft), mag * __builtin_amdgcn_sinf(ft));
    }
    float2* bb = (float2*)(ws + W_BBAR);
    for (int idx = gt; idx < 64 * 64 * 16; idx += gs) {
      const int g = idx / 1024, pp = (idx >> 4) & 63;
      const float dt = expf(p.in[24][g]);
      const float are = p.in[17][g * 64 + pp], aim = p.in[18][g * 64 + pp];
      const float mag = expf(are * dt);
      double t = (double)aim * (double)dt * 0.15915494309189535;
      t -= __builtin_rint(t);
      const float ft = (float)t;
      const float nr = mag * __builtin_amdgcn_cosf(ft) - 1.f, ni = mag * __builtin_amdgcn_sinf(ft);
      const float den = are * are + aim * aim;
      const float qr = (nr * are + ni * aim) / den, qi = (ni * are - nr * aim) / den;
      const float br = p.in[19][idx], bi = p.in[20][idx];
      bb[idx] = make_float2(qr * br - qi * bi, qr * bi + qi * br);
    }
  }
  if (gt == 0) {
    float s1 = 0.f, s2 = 0.f;
    for (int i = 0; i < 64; ++i) { s1 += p.in[28][i] * p.in[29][i]; s2 += p.in[30][i] * p.in[31][i]; }
    *(float*)(ws + W_LAM) = expf(s1) - expf(s2) + LAMBDA_INIT;
  }
  {
    bf16_t* w1 = (bf16_t*)(ws + W_WS1);
    bf16_t* w2 = (bf16_t*)(ws + W_WS2);
    const float* wsrc = p.in[44];
    for (int idx = gt; idx < 8 * 128 * 128; idx += gs) {
      const int g = idx >> 14, t = (idx >> 7) & 127, s = idx & 127;
      w1[idx] = f2bf(s <= t ? wsrc[idx] : 0.f);
      const int tt = t & 63, ss = s & 63;
      w2[idx] = f2bf(((t >> 6) == (s >> 6) && ss <= tt) ? wsrc[(g * 128 + tt) * 128 + ss] : 0.f);
    }
  }
#ifndef REP_W
#define REP_W 1
#endif
#pragma unroll 1
  for (int rep = 0; rep < REP_W; ++rep) {
  for (int l = 0; l < 4; ++l) {
    const float* up = p.in[14] + (long)l * 1024 * 4096;
    prep_w((bf16_t*)(ws + W_WUP) + (long)l * 4096 * 1024, 1024, 4096, 4096, [=](int n) { return up + n; });
    const float* dn = p.in[15] + (long)l * 4096 * 1024;
    prep_w((bf16_t*)(ws + W_WDN) + (long)l * 1024 * 4096, 4096, 1024, 1024, [=](int n) { return dn + n; });
  }
  {
    const float* ga = p.in[25]; const float* gb = p.in[26];
    prep_w((bf16_t*)(ws + W_GLU), 1024, 2048, 1024, [=](int n) { const int sp = n >> 6, w = n & 63; return ((w < 32) ? ga : gb) + sp * 32 + (w & 31); });
    const float* s = p.in[27];
    prep_w((bf16_t*)(ws + W_QKV), 1024, 3072, 3072, [=](int n) { return s + n; });
    const float* s2 = p.in[33];
    prep_w((bf16_t*)(ws + W_DWO), 1024, 1024, 1024, [=](int n) { return s2 + n; });
    const float* dq = p.in[34];
    prep_w((bf16_t*)(ws + W_MD), 1024, 256, 256, [=](int n) { return dq + n; });
    const float* dkv = p.in[37];
    prep_w((bf16_t*)(ws + W_MD) + 256 * 1024, 1024, 256, 160, [=](int n) -> const float* {
      if (n < 128) return dkv + n;
      const int w = n - 128;
      if (w < 16) return dkv + 128 + w;
      if (w >= 32 && w < 48) return dkv + 144 + (w - 32);
      return nullptr;
    });
    const float* uq = p.in[36];
    prep_w((bf16_t*)(ws + W_MUQ), 256, 1536, 1536, [=](int n) {
      if (n < 1024) return uq + (n >> 6) * 96 + (n & 63);
      const int sp = (n - 1024) >> 6, w = (n - 1024) & 63, half = w >> 5, ix = w & 31;
      const int head = sp * 2 + (ix >> 4), i = ix & 15;
      return uq + head * 96 + 64 + half * 16 + i;
    });
    const float* uk = p.in[39]; const float* uv = p.in[40];
    prep_w((bf16_t*)(ws + W_MUKV), 128, 2048, 1024, [=](int n) { return n < 1024 ? uk + n : uv + (n - 1024); });
    const float* mwo = p.in[41];
    prep_w((bf16_t*)(ws + W_MWO), 1024, 1024, 1024, [=](int n) { return mwo + n; });
    const float* sin_ = p.in[42];
    prep_w((bf16_t*)(ws + W_SIN), 1024, 4096, 4096, [=](int n) { return sin_ + n; });
    const float* sout = p.in[46];
    prep_w((bf16_t*)(ws + W_SOUT), 2048, 1024, 1024, [=](int n) { return sout + n; });
  }
  }
}

DI void phase1(const P& p) {
  unsigned char* ws = p.ws;
  const int gt = blockIdx.x * 256 + threadIdx.x, gs = gridDim.x * 256;
  {
    const float* modp = (const float*)(ws + W_MODP);
    float* mod = (float*)(ws + W_MOD);
    for (int idx = gt; idx < 20 * 24576; idx += gs) {
      const int n = idx % 24576;
      float s = p.in[11][n];
#pragma unroll
      for (int kc = 0; kc < 8; ++kc) s += modp[(long)kc * 20 * 24576 + idx];
      mod[idx] = s;
    }
  }
  const float2* ap = (const float2*)(ws + W_AP);
  const float2* bb = (const float2*)(ws + W_BBAR);
  const float* cre = p.in[21]; const float* cim = p.in[22];
  {
    bf16_t* E = (bf16_t*)(ws + W_E);
    for (int idx = gt; idx < 64 * 16 * 2048; idx += gs) {
      const int g = idx >> 15, co = (idx >> 11) & 15, j = idx & 2047;
      float v = 0.f;
      if (j < 1024) {
        const int tau = 63 - (j >> 4), ci = j & 15;
        for (int pp = 0; pp < 64; ++pp) {
          const float2 a = ap[(g * 65 + tau) * 64 + pp];
          const float2 b = bb[(g * 64 + pp) * 16 + ci];
          const float cr = cre[(g * 16 + co) * 64 + pp], cimv = cim[(g * 16 + co) * 64 + pp];
          const float abr = a.x * b.x - a.y * b.y, abi = a.x * b.y + a.y * b.x;
          v += cr * abr - cimv * abi;
        }
        if (tau == 0 && co == ci) v += p.in[23][g * 16 + co];
      }
      E[idx] = f2bf(v);
    }
    bf16_t* CH = (bf16_t*)(ws + W_CH);
    for (int idx = gt; idx < 64 * 1024 * 128; idx += gs) {
      const int g = idx >> 17, m = (idx >> 7) & 1023, q = idx & 127;
      const int t = m >> 4, co = m & 15, pp = q & 63;
      const float2 a = ap[(g * 65 + t + 1) * 64 + pp];
      const float cr = cre[(g * 16 + co) * 64 + pp], cimv = cim[(g * 16 + co) * 64 + pp];
      const float zr = cr * a.x - cimv * a.y, zi = cr * a.y + cimv * a.x;
      CH[idx] = f2bf(q < 64 ? zr : -zi);
    }
    bf16_t* ME = (bf16_t*)(ws + W_MEND);
    for (int idx = gt; idx < 64 * 128 * 1024; idx += gs) {
      const int g = idx >> 17, q = (idx >> 10) & 127, k = idx & 1023;
      const int s = k >> 4, c = k & 15, pp = q & 63;
      const float2 a = ap[(g * 65 + 63 - s) * 64 + pp];
      const float2 b = bb[(g * 64 + pp) * 16 + c];
      ME[idx] = f2bf(q < 64 ? (a.x * b.x - a.y * b.y) : (a.x * b.y + a.y * b.x));
    }
  }
}

template <int MODE>
DI void phase_modulate(const P& p, int layer, int which) {
  unsigned char* ws = p.ws;
  const float* mod = (const float*)(ws + W_MOD);
  const float* gam = (which == 0 ? p.in[12] : p.in[13]) + layer * 1024;
  const int lane = threadIdx.x & 63;
  const int wv = blockIdx.x * 4 + (threadIdx.x >> 6), nwv = gridDim.x * 4;
  bf16_t* H = (bf16_t*)(ws + W_H);
  bf16_t* HG = (bf16_t*)(ws + W_BIG + B_HG);
  for (int row = wv; row < NT; row += nwv) {
    const float* x = (MODE == 1) ? (row < NTP ? p.in[0] + (long)row * 1024 : p.in[1] + (long)(row - NTP) * 1024) : p.out + (long)row * 1024;
    float4 v[4];
    float ss = 0.f;
#pragma unroll
    for (int i = 0; i < 4; ++i) {
      v[i] = *(const float4*)(x + lane * 4 + 256 * i);
      ss += v[i].x * v[i].x + v[i].y * v[i].y + v[i].z * v[i].z + v[i].w * v[i].w;
    }
    ss = wave_sum(ss);
    const float rinv = rsqrtf(ss * (1.f / 1024.f) + NORM_EPS);
    const int b = batch_of(row);
    const float* sh = mod + (long)b * 24576 + layer * 6144 + (which * 3) * 1024;
    const float* sc = sh + 1024;
#pragma unroll
    for (int i = 0; i < 4; ++i) {
      const int col = lane * 4 + 256 * i;
      const float4 g4 = *(const float4*)(gam + col), sh4 = *(const float4*)(sh + col), sc4 = *(const float4*)(sc + col);
      const float h0 = v[i].x * rinv * g4.x * (1.f + sc4.x) + sh4.x;
      const float h1 = v[i].y * rinv * g4.y * (1.f + sc4.y) + sh4.y;
      const float h2 = v[i].z * rinv * g4.z * (1.f + sc4.z) + sh4.z;
      const float h3 = v[i].w * rinv * g4.w * (1.f + sc4.w) + sh4.w;
      uint2 o = {pack2(h0, h1), pack2(h2, h3)};
      if (MODE == 1) {
        *(float4*)(p.out + (long)row * 1024 + col) = v[i];
        const int g = col >> 4, c = col & 15, n = row >> 6, s = row & 63;
        *(uint2*)(HG + ((long)(g * 640 + n)) * 1152 + s * 16 + c) = o;
      } else {
        *(uint2*)(H + (long)row * 1024 + col) = o;
      }
    }
  }
}

DI void phase_s5_carry(const P& p) {
  unsigned char* ws = p.ws;
  const float2* ap = (const float2*)(ws + W_AP);
  const float* sloc = (const float*)(ws + W_BIG + B_SLOC);
  bf16_t* HG = (bf16_t*)(ws + W_BIG + B_HG);
  const int gt = blockIdx.x * 256 + threadIdx.x, gs = gridDim.x * 256;
  for (int idx = gt; idx < 64 * 20 * 64; idx += gs) {
    const int g = idx / 1280, bb = (idx >> 6) % 20, pp = idx & 63;
    const float2 a = ap[(g * 65 + 64) * 64 + pp];
    if (bb < 4) {
      float hr = 0.f, hi = 0.f;
#pragma unroll 8
      for (int k = 0; k < 128; ++k) {
        const long n = (long)g * 640 + bb * 128 + k;
        HG[n * 1152 + 1024 + pp] = f2bf(hr);
        HG[n * 1152 + 1088 + pp] = f2bf(hi);
        const float sr = sloc[n * 128 + pp], si = sloc[n * 128 + 64 + pp];
        const float nr = a.x * hr - a.y * hi + sr, ni = a.x * hi + a.y * hr + si;
        hr = nr; hi = ni;
      }
      p.out[O_S5RP + (bb * 64 + g) * 64 + pp] = hr;
      p.out[O_S5IP + (bb * 64 + g) * 64 + pp] = hi;
    } else {
      const int b = bb - 4;
      const long n = (long)g * 640 + 512 + b;
      float hr = p.in[4][(b * 64 + g) * 64 + pp], hi = p.in[5][(b * 64 + g) * 64 + pp];
      HG[n * 1152 + 1024 + pp] = f2bf(hr);
      HG[n * 1152 + 1088 + pp] = f2bf(hi);
      const float sr = sloc[n * 128 + pp], si = sloc[n * 128 + 64 + pp];
      p.out[O_S5RS + (b * 64 + g) * 64 + pp] = a.x * hr - a.y * hi + sr;
      p.out[O_S5IS + (b * 64 + g) * 64 + pp] = a.x * hi + a.y * hr + si;
    }
  }
}

DI const float* mod_ptr(const P& p, int layer, int k) { return (const float*)(p.ws + W_MOD) + layer * 6144 + k * 1024; }

DI void phase_s5a(const P& p, bf16_t* smem) {
  const bf16_t* HG = (const bf16_t*)(p.ws + W_BIG + B_HG);
  const bf16_t* ME = (const bf16_t*)(p.ws + W_MEND);
  float* sloc = (float*)(p.ws + W_BIG + B_SLOC);
  __shared__ int s_q5a;
  DynQ dq = dynq_init(p, 23, 64 * 5);
  for (;;) {
    const int t = dynq_pop(dq, &s_q5a);
    if (t < 0) break;
    const int g = t / 5, mi = t % 5;
    const bf16_t* a0 = HG + (long)(g * 640 + mi * 128) * 1152;
    const bf16_t* b0 = ME + (long)g * 128 * 1024;
    float* o = sloc + (long)(g * 640 + mi * 128) * 128;
    gemm_tile(smem, [=](int r, int kt) { return a0 + (long)r * 1152 + kt * 64; }, [=](int r, int kt) { return b0 + (long)r * 1024 + kt * 64; }, 16,
              [=](int row0, int col, float4 v0, float4 v1) {
#pragma unroll
                for (int j = 0; j < 4; ++j) {
                  o[(long)(row0 + j) * 128 + col] = f4get(v0, j);
                  o[(long)(row0 + j) * 128 + col + 32] = f4get(v1, j);
                }
              });
  }
}

DI void phase_s5b(const P& p, bf16_t* smem) {
  const bf16_t* HG = (const bf16_t*)(p.ws + W_BIG + B_HG);
  const bf16_t* E = (const bf16_t*)(p.ws + W_E);
  const bf16_t* CH = (const bf16_t*)(p.ws + W_CH);
  bf16_t* Z = (bf16_t*)(p.ws + W_BIG + B_Z);
  __shared__ int s_q5b;
  DynQ dq = dynq_init(p, 20, 64 * 5 * 8);
  for (;;) {
    const int t = dynq_pop(dq, &s_q5b);
    if (t < 0) break;
    const int j = 7 - t / 320, g = (t % 320) / 5, mi = t % 5;
    const int nE = 2 * j + 2;
    const bf16_t* a0 = HG + (long)(g * 640 + mi * 128) * 1152;
    const bf16_t* e0 = E + (long)g * 16 * 2048;
    const bf16_t* c0 = CH + ((long)g * 1024 + j * 128) * 128;
    gemm_tile(smem,
              [=](int r, int kt) { const int k = kt < nE ? kt : 16 + kt - nE; return a0 + (long)r * 1152 + k * 64; },
              [=](int r, int kt) -> const bf16_t* {
                if (kt < nE) { const int tt = 8 * j + (r >> 4), co = r & 15; return e0 + co * 2048 + (63 - tt) * 16 + kt * 64; }
                return c0 + (long)r * 128 + (kt - nE) * 64;
              },
              nE + 2,
              [=](int row0, int col, float4 v0, float4 v1) {
#pragma unroll
                for (int q = 0; q < 4; ++q) {
                  const int n = mi * 128 + row0 + q;
                  if (n < 528) {
                    const int c0_ = col, c1_ = col + 32;
                    const long tok0 = (long)n * 64 + 8 * j + (c0_ >> 4), tok1 = (long)n * 64 + 8 * j + (c1_ >> 4);
                    Z[tok0 * 1024 + g * 16 + (c0_ & 15)] = f2bf(gelu_t(f4get(v0, q)));
                    Z[tok1 * 1024 + g * 16 + (c1_ & 15)] = f2bf(gelu_t(f4get(v1, q)));
                  }
                }
              });
  }
}

template <class EPI>
DI void run_gemm(const P& p, int qid, bf16_t* smem, const bf16_t* A, int lda, const bf16_t* B, int ldb, int mtiles, int ntiles, int nkt, EPI epi) {
  __shared__ int s_git2;
  DynQ dq = dynq_init(p, qid, mtiles * ntiles);
  for (;;) {
    const int t = dynq_pop(dq, &s_git2);
    if (t < 0) break;
    const int mt = t / ntiles, nt = t % ntiles;
    const bf16_t* a0 = A + (long)mt * 128 * lda;
    const bf16_t* b0 = B + (long)nt * 128 * ldb;
    gemm_tile(smem, [=](int r, int kt) { return a0 + (long)r * lda + kt * 64; }, [=](int r, int kt) { return b0 + (long)r * ldb + kt * 64; }, nkt,
              [=](int row0, int col, float4 v0, float4 v1) { epi(mt * 128 + row0, nt * 128 + col, v0, v1); });
  }
}

DI void resid_add(const P& p, const float* gate, int row0, int col, float4 v0, float4 v1, bool part) {
  const float* gb = gate + (long)batch_of(row0) * 24576;
  const float g0 = 1.f + gb[col], g1 = 1.f + gb[col + 32];
  if (part) {
#pragma unroll
    for (int j = 0; j < 4; ++j) {
      float* x = p.out + (long)(row0 + j) * 1024;
      atomicAdd(x + col, g0 * f4get(v0, j));
      atomicAdd(x + col + 32, g1 * f4get(v1, j));
    }
  } else {
#pragma unroll
    for (int j = 0; j < 4; ++j) {
      float* x = p.out + (long)(row0 + j) * 1024;
      x[col] += g0 * f4get(v0, j);
      x[col + 32] += g1 * f4get(v1, j);
    }
  }
}

DI void phase_glu(const P& p, bf16_t* smem) {
  const float* gate = mod_ptr(p, 0, 2);
  run_gemm256<false>(p, 12, smem, (const bf16_t*)(p.ws + W_BIG + B_Z), 1024, (const bf16_t*)(p.ws + W_GLU), 1024, 132, 16, 16,
           [=](int row0, int col, float4 v0, float4 v1, bool) {
             const int oc = (col >> 6) * 32 + (col & 31);
             const float g0 = 1.f + gate[(long)batch_of(row0) * 24576 + oc];
#pragma unroll
             for (int j = 0; j < 4; ++j) {
               float* x = p.out + (long)(row0 + j) * 1024 + oc;
               *x += g0 * f4get(v0, j) * sigmoid_f(f4get(v1, j));
             }
           });
}

DI void phase_mlp_up(const P& p, bf16_t* smem, int layer) {
  bf16_t* act = (bf16_t*)(p.ws + W_BIG + B_ACT);
  run_gemm256<false>(p, layer, smem, (const bf16_t*)(p.ws + W_H), 1024, (const bf16_t*)(p.ws + W_WUP) + (long)layer * 4096 * 1024, 1024, 132, 32, 16,
           [=](int row0, int col, float4 v0, float4 v1, bool) {
#pragma unroll
             for (int j = 0; j < 4; ++j) {
               const float a = fmaxf(f4get(v0, j), 0.f), b = fmaxf(f4get(v1, j), 0.f);
               act[(long)(row0 + j) * 4096 + col] = f2bf(a * a);
               act[(long)(row0 + j) * 4096 + col + 32] = f2bf(b * b);
             }
           });
}

DI void phase_mlp_down(const P& p, bf16_t* smem, int layer) {
  const float* gate = mod_ptr(p, layer, 5);
  run_gemm256<true>(p, 4 + layer, smem, (const bf16_t*)(p.ws + W_BIG + B_ACT), 4096, (const bf16_t*)(p.ws + W_WDN) + (long)layer * 1024 * 4096, 4096, 132, 8, 64,
           [=](int row0, int col, float4 v0, float4 v1, bool part) { resid_add(p, gate, row0, col, v0, v1, part); }, layer == 0 ? 2 : 0);
}

DI void phase_proj_resid(const P& p, bf16_t* smem, const bf16_t* A, int K, const bf16_t* B, int layer) {
  const float* gate = mod_ptr(p, layer, 2);
  run_gemm256<true>(p, 8 + layer, smem, A, K, B, K, 132, 8, K / 64, [=](int row0, int col, float4 v0, float4 v1, bool part) { resid_add(p, gate, row0, col, v0, v1, part); });
}

DI void store_t4(bf16_t* dst, float4 v) { *(uint2*)dst = make_uint2(pack2(v.x, v.y), pack2(v.z, v.w)); }

DI void phase_qkv(const P& p, bf16_t* smem) {
  unsigned char* big = p.ws + W_BIG;
  bf16_t* Qb = (bf16_t*)(big + B_QB);
  bf16_t* Kb = (bf16_t*)(big + B_KB);
  bf16_t* VT = (bf16_t*)(big + B_VTD);
  const float qscale = 0.125f * L2E;
  run_gemm(p, 14, smem, (const bf16_t*)(p.ws + W_H), 1024, (const bf16_t*)(p.ws + W_QKV), 1024, 264, 24, 16,
           [=](int row0, int col, float4 v0, float4 v1) {
             const int region = col >> 10;
             if (region < 2) {
               const int d = col & 31;
               const float invf = exp2f(-(float)d * (13.287712379549449f / 32.f));
#pragma unroll
               for (int j = 0; j < 4; ++j) {
                 const int row = row0 + j;
                 float c, s;
                 rope_cs(pos_of(row), invf, c, s);
                 const float x1 = f4get(v0, j), x2 = f4get(v1, j);
                 const float o1 = x1 * c - x2 * s, o2 = x1 * s + x2 * c;
                 if (region == 0) {
                   Qb[(long)row * 1024 + col] = f2bf(o1 * qscale);
                   Qb[(long)row * 1024 + col + 32] = f2bf(o2 * qscale);
                 } else {
                   const int kc = col - 1024;
                   float* ko = (row < NTP) ? p.out + O_DKP + (long)row * 1024 : p.out + O_DKS + (long)(row - NTP) * 1024;
                   ko[kc] = o1; ko[kc + 32] = o2;
                   const long kr = krow_of(row);
                   Kb[kr * 1024 + kc] = f2bf(o1);
                   Kb[kr * 1024 + kc + 32] = f2bf(o2);
                 }
               }
             } else {
               const int vc = col - 2048;
#pragma unroll
               for (int j = 0; j < 4; ++j) {
                 const int row = row0 + j;
                 float* vo = (row < NTP) ? p.out + O_DVP + (long)row * 1024 : p.out + O_DVS + (long)(row - NTP) * 1024;
                 vo[vc] = f4get(v0, j); vo[vc + 32] = f4get(v1, j);
               }
               long base; int Lk, key;
               if (row0 < NTP) { const int b = row0 >> 13; key = row0 & 8191; Lk = 8192; base = (long)b * 1024 * 8192; }
               else { const int b = (row0 - NTP) >> 6; key = 4096 + ((row0 - NTP) & 63); Lk = SLK; base = 4l * 1024 * 8192 + (long)b * 1024 * SLK; }
               store_t4(VT + base + (long)vc * Lk + vperm_key(key), v0);
               store_t4(VT + base + (long)(vc + 32) * Lk + vperm_key(key), v1);
             }
           });
}

DI void phase_mla_down(const P& p, bf16_t* smem) {
  unsigned char* big = p.ws + W_BIG;
  float* raw = (float*)(big + B_RAW);
  bf16_t* KR = (bf16_t*)(big + B_KR);
  run_gemm(p, 16, smem, (const bf16_t*)(p.ws + W_H), 1024, (const bf16_t*)(p.ws + W_MD), 1024, 264, 4, 16,
           [=](int row0, int col, float4 v0, float4 v1) {
             if (col < 384) {
#pragma unroll
               for (int j = 0; j < 4; ++j) {
                 raw[(long)(row0 + j) * 384 + col] = f4get(v0, j);
                 raw[(long)(row0 + j) * 384 + col + 32] = f4get(v1, j);
               }
             } else if (col < 400) {
               const int i = col - 384;
               const float invf = exp2f(-(float)i * (13.287712379549449f / 16.f));
#pragma unroll
               for (int j = 0; j < 4; ++j) {
                 const int row = row0 + j;
                 float c, s;
                 rope_cs(pos_of(row), invf, c, s);
                 const float x1 = f4get(v0, j), x2 = f4get(v1, j);
                 const float o1 = x1 * c - x2 * s, o2 = x1 * s + x2 * c;
                 float* ko = (row < NTP) ? p.out + O_KRP + (long)row * 32 : p.out + O_KRS + (long)(row - NTP) * 32;
                 ko[i] = o1; ko[16 + i] = o2;
                 const long kr = krow_of(row);
                 KR[kr * 32 + i] = f2bf(o1); KR[kr * 32 + 16 + i] = f2bf(o2);
               }
             }
           });
  {
    bf16_t* CKV = (bf16_t*)(big + B_CKV);
    const float* cc = p.in[8]; const float* cr = p.in[9];
    const long gt = (long)blockIdx.x * 256 + threadIdx.x, gs = (long)gridDim.x * 256;
    for (long idx = gt; idx < 16l * 4096 * 16; idx += gs) {
      const long rowc = idx >> 4; const int c8 = (int)(idx & 15) * 8;
      const int b = (int)(rowc >> 12), jk = (int)(rowc & 4095);
      const float4 a = *(const float4*)(cc + rowc * 128 + c8), bq = *(const float4*)(cc + rowc * 128 + c8 + 4);
      uint4 o = {pack2(a.x, a.y), pack2(a.z, a.w), pack2(bq.x, bq.y), pack2(bq.z, bq.w)};
      *(uint4*)(CKV + ((long)NTP + (long)b * SLK + jk) * 128 + c8) = o;
    }
    for (long idx = gt; idx < 16l * 4096 * 4; idx += gs) {
      const long rowc = idx >> 2; const int c8 = (int)(idx & 3) * 8;
      const int b = (int)(rowc >> 12), jk = (int)(rowc & 4095);
      const float4 a = *(const float4*)(cr + rowc * 32 + c8), bq = *(const float4*)(cr + rowc * 32 + c8 + 4);
      uint4 o = {pack2(a.x, a.y), pack2(a.z, a.w), pack2(bq.x, bq.y), pack2(bq.z, bq.w)};
      *(uint4*)(KR + ((long)NTP + (long)b * SLK + jk) * 32 + c8) = o;
    }
  }
}

DI void phase_mla_norm(const P& p) {
  unsigned char* big = p.ws + W_BIG;
  const float* raw = (const float*)(big + B_RAW);
  bf16_t* CQ = (bf16_t*)(big + B_CQ);
  bf16_t* CKV = (bf16_t*)(big + B_CKV);
  const int lane = threadIdx.x & 63;
  const int wv = blockIdx.x * 4 + (threadIdx.x >> 6), nwv = gridDim.x * 4;
  const float4 gq = *(const float4*)(p.in[35] + lane * 4);
  const float2 gk = *(const float2*)(p.in[38] + lane * 2);
  for (int row = wv; row < NT; row += nwv) {
    const float4 q = *(const float4*)(raw + (long)row * 384 + lane * 4);
    const float2 k = *(const float2*)(raw + (long)row * 384 + 256 + lane * 2);
    const float sq = wave_sum(q.x * q.x + q.y * q.y + q.z * q.z + q.w * q.w);
    const float sk = wave_sum(k.x * k.x + k.y * k.y);
    const float rq = rsqrtf(sq * (1.f / 256.f) + NORM_EPS), rk = rsqrtf(sk * (1.f / 128.f) + NORM_EPS);
    *(uint2*)(CQ + (long)row * 256 + lane * 4) = make_uint2(pack2(q.x * rq * gq.x, q.y * rq * gq.y), pack2(q.z * rq * gq.z, q.w * rq * gq.w));
    const float c0 = k.x * rk * gk.x, c1 = k.y * rk * gk.y;
    float* co = (row < NTP) ? p.out + O_CKP + (long)row * 128 : p.out + O_CKS + (long)(row - NTP) * 128;
    *(float2*)(co + lane * 2) = make_float2(c0, c1);
    *(unsigned*)(CKV + (long)krow_of(row) * 128 + lane * 2) = pack2(c0, c1);
  }
}

DI void phase_mla_up(const P& p, bf16_t* smem) {
  unsigned char* big = p.ws + W_BIG;
  bf16_t* QM = (bf16_t*)(big + B_QM);
  bf16_t* KN = (bf16_t*)(big + B_KN);
  bf16_t* VT = (bf16_t*)(big + B_VTM);
  const float qscale = 0.10206207261596577f * L2E;
  run_gemm(p, 17, smem, (const bf16_t*)(big + B_CQ), 256, (const bf16_t*)(p.ws + W_MUQ), 256, 264, 12, 4,
           [=](int row0, int col, float4 v0, float4 v1) {
             if (col < 1024) {
               const int o = (col >> 6) * 96 + (col & 63);
#pragma unroll
               for (int j = 0; j < 4; ++j) {
                 QM[(long)(row0 + j) * 1536 + o] = f2bf(f4get(v0, j) * qscale);
                 QM[(long)(row0 + j) * 1536 + o + 32] = f2bf(f4get(v1, j) * qscale);
               }
             } else {
               const int sp = (col - 1024) >> 6, ix = col & 31;
               const int head = sp * 2 + (ix >> 4), i = ix & 15;
               const float invf = exp2f(-(float)i * (13.287712379549449f / 16.f));
#pragma unroll
               for (int j = 0; j < 4; ++j) {
                 const int row = row0 + j;
                 float c, s;
                 rope_cs(pos_of(row), invf, c, s);
                 const float x1 = f4get(v0, j), x2 = f4get(v1, j);
                 QM[(long)row * 1536 + head * 96 + 64 + i] = f2bf((x1 * c - x2 * s) * qscale);
                 QM[(long)row * 1536 + head * 96 + 80 + i] = f2bf((x1 * s + x2 * c) * qscale);
               }
             }
           });
  run_gemm(p, 18, smem, (const bf16_t*)(big + B_CKV), 128, (const bf16_t*)(p.ws + W_MUKV), 128, 776, 16, 2,
           [=](int row0, int col, float4 v0, float4 v1) {
             if (col < 1024) {
#pragma unroll
               for (int j = 0; j < 4; ++j) {
                 KN[(long)(row0 + j) * 1024 + col] = f2bf(f4get(v0, j));
                 KN[(long)(row0 + j) * 1024 + col + 32] = f2bf(f4get(v1, j));
               }
             } else {
               const int vc = col - 1024;
               long base; int Lk, key;
               if (row0 < NTP) { const int b = row0 >> 13; key = row0 & 8191; Lk = 8192; base = (long)b * 1024 * 8192; }
               else { const int b = (row0 - NTP) / SLK; key = (row0 - NTP) - b * SLK; Lk = SLK; base = 4l * 1024 * 8192 + (long)b * 1024 * SLK; }
               store_t4(VT + base + (long)vc * Lk + vperm_key(key), v0);
               store_t4(VT + base + (long)(vc + 32) * Lk + vperm_key(key), v1);
             }
           });
}

DI void phase_sgu_in(const P& p, bf16_t* smem) {
  unsigned char* big = p.ws + W_BIG;
  bf16_t* U = (bf16_t*)(big + B_U);
  bf16_t* VR = (bf16_t*)(big + B_VRAW);
  run_gemm256<false>(p, 13, smem, (const bf16_t*)(p.ws + W_H), 1024, (const bf16_t*)(p.ws + W_SIN), 1024, 132, 32, 16,
           [=](int row0, int col, float4 v0, float4 v1, bool) {
             bf16_t* dst = (col < 2048) ? U + col : VR + (col - 2048);
#pragma unroll
             for (int j = 0; j < 4; ++j) {
               dst[(long)(row0 + j) * 2048] = f2bf(gelu_t(f4get(v0, j)));
               dst[(long)(row0 + j) * 2048 + 32] = f2bf(gelu_t(f4get(v1, j)));
             }
           });
}

DI void phase_sgu_norm(const P& p, float* smf) {
  unsigned char* big = p.ws + W_BIG;
  const bf16_t* VR = (const bf16_t*)(big + B_VRAW);
  bf16_t* VTS = (bf16_t*)(big + B_VTS);
  const float* gv = p.in[43];
  const int lane = threadIdx.x & 63, wave = threadIdx.x >> 6;
  __shared__ int s_qsn;
  DynQ dq = dynq_init(p, 22, 528 * 4);
  for (;;) {
    const int itq = dynq_pop(dq, &s_qsn);
    if (itq < 0) break;
    const int c64 = itq >> 2, qd = itq & 3;
    __syncthreads();
    for (int s = wave; s < 64; s += 4) {
      const bf16_t* rowp = VR + (long)(c64 * 64 + s) * 2048;
      float ss = 0.f;
#pragma unroll
      for (int i = 0; i < 4; ++i) {
        const uint4 q = *(const uint4*)(rowp + lane * 8 + 512 * i);
        const unsigned w[4] = {q.x, q.y, q.z, q.w};
#pragma unroll
        for (int e = 0; e < 4; ++e) {
          const float a = __uint_as_float(w[e] << 16), b = __uint_as_float(w[e] & 0xffff0000u);
          ss += a * a + b * b;
        }
      }
      ss = wave_sum(ss);
      if (lane == 0) smf[s] = rsqrtf(ss * (1.f / 2048.f) + NORM_EPS);
    }
    __syncthreads();
    for (int task = threadIdx.x; task < 128 * 8; task += 256) {
      const int d4 = (qd * 128 + (task & 127)) * 4, sg = task >> 7;
      const float4 g4 = *(const float4*)(gv + d4);
      float v[8][4];
#pragma unroll
      for (int j = 0; j < 8; ++j) {
        const int s = sg * 8 + j;
        const uint2 q = *(const uint2*)(VR + (long)(c64 * 64 + s) * 2048 + d4);
        const float rs = smf[s];
        v[j][0] = __uint_as_float(q.x << 16) * rs * g4.x;
        v[j][1] = __uint_as_float(q.x & 0xffff0000u) * rs * g4.y;
        v[j][2] = __uint_as_float(q.y << 16) * rs * g4.z;
        v[j][3] = __uint_as_float(q.y & 0xffff0000u) * rs * g4.w;
        if (c64 >= 512) *(float4*)(p.out + O_SGV + (long)((c64 - 512) * 64 + s) * 2048 + d4) = make_float4(v[j][0], v[j][1], v[j][2], v[j][3]);
      }
#pragma unroll
      for (int e = 0; e < 4; ++e) {
        uint4 o = {pack2(v[0][e], v[1][e]), pack2(v[2][e], v[3][e]), pack2(v[4][e], v[5][e]), pack2(v[6][e], v[7][e])};
        *(uint4*)(VTS + ((long)c64 * 2048 + d4 + e) * 64 + sg * 8) = o;
      }
    }
  }
}

DI void phase_sgu_spatial(const P& p, bf16_t* smem) {
  unsigned char* big = p.ws + W_BIG;
  const bf16_t* U = (const bf16_t*)(big + B_U);
  const bf16_t* VTS = (const bf16_t*)(big + B_VTS);
  bf16_t* G = (bf16_t*)(big + B_G);
  const float* bs = p.in[45];
  __shared__ int s_qsp;
  DynQ dq = dynq_init(p, 21, 264 * 16);
  for (;;) {
    const int t = dynq_pop(dq, &s_qsp);
    if (t < 0) break;
    const int mt = t >> 4, g = (t >> 1) & 7, dt = t & 1;
    const bf16_t* a0 = (const bf16_t*)(p.ws + (mt < 256 ? W_WS1 : W_WS2)) + g * 128 * 128;
    const bf16_t* b0 = VTS + ((long)mt * 2 * 2048 + g * 256 + dt * 128) * 64;
    const bool prompt = mt < 256;
    gemm_tile(smem, [=](int r, int kt) { return a0 + r * 128 + kt * 64; }, [=](int r, int kt) { return b0 + (long)kt * 2048 * 64 + r * 64; }, 2,
              [=](int row0, int col, float4 v0, float4 v1) {
                const int gc = g * 256 + dt * 128 + col;
#pragma unroll
                for (int j = 0; j < 4; ++j) {
                  const int tr = row0 + j;
                  const float bias = bs[g * 128 + (prompt ? tr : (tr & 63))];
                  const long o = (long)(mt * 128 + tr) * 2048 + gc;
                  G[o] = f2bf(bf2f(U[o]) * (f4get(v0, j) + bias));
                  G[o + 32] = f2bf(bf2f(U[o + 32]) * (f4get(v1, j) + bias));
                }
              });
  }
}

DI void phase_final_norm(const P& p) {
  const int lane = threadIdx.x & 63;
  const int wv = blockIdx.x * 4 + (threadIdx.x >> 6), nwv = gridDim.x * 4;
  const float* gam = p.in[16];
  for (int row = wv; row < NT; row += nwv) {
    float* x = p.out + (long)row * 1024;
    float4 v[4];
    float ss = 0.f;
#pragma unroll
    for (int i = 0; i < 4; ++i) {
      v[i] = *(const float4*)(x + lane * 4 + 256 * i);
      ss += v[i].x * v[i].x + v[i].y * v[i].y + v[i].z * v[i].z + v[i].w * v[i].w;
    }
    ss = wave_sum(ss);
    const float rinv = rsqrtf(ss * (1.f / 1024.f) + NORM_EPS);
#pragma unroll
    for (int i = 0; i < 4; ++i) {
      const int col = lane * 4 + 256 * i;
      const float4 g4 = *(const float4*)(gam + col);
      *(float4*)(x + col) = make_float4(v[i].x * rinv * g4.x, v[i].y * rinv * g4.y, v[i].z * rinv * g4.z, v[i].w * rinv * g4.w);
    }
  }
}

DI bf16x8 pack8(const f32x16& x, int s) {
  unsigned a = pack2(x[8 * s], x[8 * s + 1]), b = pack2(x[8 * s + 2], x[8 * s + 3]), c = pack2(x[8 * s + 4], x[8 * s + 5]), d = pack2(x[8 * s + 6], x[8 * s + 7]);
  uint4 u = {a, b, c, d};
  return __builtin_bit_cast(bf16x8, u);
}

DI unsigned xb_xcc_id_fwd() { return (unsigned)__builtin_amdgcn_s_getreg((3 << 11) | 20) & 0xFu; }
template <bool MLA>
DI void phase_attn(const P& p, bf16_t* smem) {
  constexpr int NKS = MLA ? 6 : 4;
  constexpr int NDT = MLA ? 2 : 4;
  constexpr int NLD = MLA ? 9 : 8;
  unsigned char* big = p.ws + W_BIG;
  const bf16_t* Q = (const bf16_t*)(big + (MLA ? B_QM : B_QB));
  const bf16_t* KK = (const bf16_t*)(big + (MLA ? B_KN : B_KB));
  const bf16_t* KR = (const bf16_t*)(big + B_KR);
  const bf16_t* VT = (const bf16_t*)(big + (MLA ? B_VTM : B_VTD));
  bf16_t* OB = (bf16_t*)(big + (MLA ? B_OBM : B_OB));
  const float lam = *(const float*)(p.ws + W_LAM);
  const float* gsub = p.in[32];
  const int tid = threadIdx.x, lane = tid & 63, wave = tid >> 6;
  const int wp = wave >> 1, wq = wave & 1, r = lane & 31, hh = lane >> 5;
  constexpr int L_K0 = 0, L_K1 = 4608, L_KR = 9216, L_V0 = MLA ? 11776 : 9216, L_V1 = 16384;
  __shared__ int s_item;
  unsigned* qctr = (unsigned*)(p.ws + W_CTRL) + 3584 + (MLA ? 64 : 0);
  const int xs = (int)(xb_xcc_id_fwd() & 7u);
  for (int pass = 0; pass < 8; ++pass) {
  const int hx = (xs + pass) & 7;
  for (;;) {
    if (tid == 0) s_item = (int)atomicAdd(&qctr[hx * 8], 1u);
    __syncthreads();
    const int jq = s_item;
    __syncthreads();
    if (jq >= 528) break;
    int b, qrow0, ntiles, Lk; long R0, vbase;
    if (jq < 16) {
      b = jq; qrow0 = NTP + b * 64; ntiles = 65; Lk = SLK;
      R0 = (long)NTP + (long)b * SLK; vbase = 4l * 1024 * 8192 + (long)b * 1024 * SLK;
    } else {
      const int i = jq - 16; const int qc = 127 - (i >> 2); b = i & 3;
      qrow0 = b * 8192 + qc * 64; ntiles = qc + 1; Lk = 8192; R0 = (long)b * 8192; vbase = (long)b * 1024 * 8192;
    }
    bf16x8 qf[NKS];
    {
      const long qr = (long)(qrow0 + wq * 32 + r);
      const bf16_t* qp = MLA ? Q + qr * 1536 + (hx * 2 + wp) * 96 + 8 * hh : Q + qr * 1024 + (hx * 2 + wp) * 64 + 8 * hh;
#pragma unroll
      for (int ks = 0; ks < NKS; ++ks) qf[ks] = *(const bf16x8*)(qp + ks * 16);
    }
    f32x16 O[NDT];
#pragma unroll
    for (int d = 0; d < NDT; ++d)
#pragma unroll
      for (int i = 0; i < 16; ++i) O[d][i] = 0.f;
    float m_run = -1e30f, l_run = 0.f;
    u32x4 ld[NLD];
#define ATT_GLOAD(KT)                                                                                                   \
  {                                                                                                                     \
    const long kr0 = R0 + (long)(KT) * 64;                                                                              \
    _Pragma("unroll") for (int j = 0; j < 4; ++j) {                                                                     \
      const int c = j >> 1, id = tid + 256 * (j & 1), key = id >> 3, ch = id & 7;                                       \
      ld[j] = *(const u32x4*)(KK + (kr0 + key) * 1024 + (hx * 2 + c) * 64 + ch * 8);                                    \
    }                                                                                                                   \
    if (!MLA) {                                                                                                         \
      _Pragma("unroll") for (int i = 0; i < 4; ++i) {                                                                   \
        const int id = tid + 256 * i, dv = id >> 3, ch = id & 7;                                                        \
        ld[4 + i] = *(const u32x4*)(VT + vbase + (long)(hx * 128 + dv) * Lk + (KT) * 64 + ch * 8);                      \
      }                                                                                                                 \
    } else {                                                                                                            \
      _Pragma("unroll") for (int j = 0; j < 4; ++j) {                                                                   \
        const int c = j >> 1, id = tid + 256 * (j & 1), dv = id >> 3, ch = id & 7;                                      \
        ld[4 + j] = *(const u32x4*)(VT + vbase + (long)((hx * 2 + c) * 64 + dv) * Lk + (KT) * 64 + ch * 8);             \
      }                                                                                                                 \
      ld[NLD - 1] = *(const u32x4*)(KR + (kr0 + (tid >> 2)) * 32 + (tid & 3) * 8);                                      \
    }                                                                                                                   \
  }
#define ATT_SWRITE()                                                                                                    \
  {                                                                                                                     \
    _Pragma("unroll") for (int j = 0; j < 4; ++j) {                                                                     \
      const int c = j >> 1, id = tid + 256 * (j & 1), key = id >> 3, ch = id & 7;                                       \
      *(u32x4*)(smem + (c ? L_K1 : L_K0) + key * LST + ch * 8) = ld[j];                                                 \
    }                                                                                                                   \
    if (!MLA) {                                                                                                         \
      _Pragma("unroll") for (int i = 0; i < 4; ++i) {                                                                   \
        const int id = tid + 256 * i, dv = id >> 3, ch = id & 7;                                                        \
        *(u32x4*)(smem + L_V0 + dv * LST + ch * 8) = ld[4 + i];                                                         \
      }                                                                                                                 \
    } else {                                                                                                            \
      _Pragma("unroll") for (int j = 0; j < 4; ++j) {                                                                   \
        const int c = j >> 1, id = tid + 256 * (j & 1), dv = id >> 3, ch = id & 7;                                      \
        *(u32x4*)(smem + (c ? L_V1 : L_V0) + dv * LST + ch * 8) = ld[4 + j];                                            \
      }                                                                                                                 \
      *(u32x4*)(smem + L_KR + (tid >> 2) * 40 + (tid & 3) * 8) = ld[NLD - 1];                                           \
    }                                                                                                                   \
  }
    ATT_GLOAD(0)
    const bf16_t* sK = smem + (wp ? L_K1 : L_K0);
    const bf16_t* sV = smem + ((MLA && wp) ? L_V1 : L_V0);
    for (int kt = 0; kt < ntiles; ++kt) {
      __syncthreads();
      ATT_SWRITE()
      __syncthreads();
      if (kt + 1 < ntiles) ATT_GLOAD(kt + 1)
      __builtin_amdgcn_sched_barrier(0);
      f32x16 st[2];
#pragma unroll
      for (int mt = 0; mt < 2; ++mt) {
#pragma unroll
        for (int i = 0; i < 16; ++i) st[mt][i] = 0.f;
#pragma unroll
        for (int ks = 0; ks < NKS; ++ks) {
          bf16x8 a;
          if (ks < 4) a = *(const bf16x8*)(sK + (mt * 32 + r) * LST + ks * 16 + 8 * hh);
          else a = *(const bf16x8*)(smem + L_KR + (mt * 32 + r) * 40 + (ks - 4) * 16 + 8 * hh);
          st[mt] = MFMA(a, qf[ks], st[mt]);
        }
      }
      float mloc = st[0][0];
#pragma unroll
      for (int i = 1; i < 16; ++i) mloc = fmaxf(mloc, st[0][i]);
#pragma unroll
      for (int i = 0; i < 16; ++i) mloc = fmaxf(mloc, st[1][i]);
      mloc = fmaxf(mloc, __shfl_xor(mloc, 32));
      const bool need = mloc > m_run + 8.f;
      if (__any(need)) {
        const float mnew = need ? mloc : m_run;
        const float alpha = __builtin_amdgcn_exp2f(m_run - mnew);
        m_run = mnew;
        l_run *= alpha;
#pragma unroll
        for (int d = 0; d < NDT; ++d)
#pragma unroll
          for (int i = 0; i < 16; ++i) O[d][i] *= alpha;
      }
      float ps = 0.f;
#pragma unroll
      for (int mt = 0; mt < 2; ++mt)
#pragma unroll
        for (int i = 0; i < 16; ++i) { const float e = __builtin_amdgcn_exp2f(st[mt][i] - m_run); st[mt][i] = e; ps += e; }
      l_run += ps;
#pragma unroll
      for (int k2 = 0; k2 < 4; ++k2) {
        const bf16x8 pf = pack8(st[k2 >> 1], k2 & 1);
#pragma unroll
        for (int d = 0; d < NDT; ++d) {
          const bf16x8 va = *(const bf16x8*)(sV + (d * 32 + r) * LST + 16 * k2 + 8 * hh);
          O[d] = MFMA(va, pf, O[d]);
        }
      }
    }
    const float ltot = l_run + __shfl_xor(l_run, 32);
    const float linv = 1.f / ltot;
    const long orow = (long)(qrow0 + wq * 32 + r);
    if (MLA) {
#pragma unroll
      for (int d = 0; d < NDT; ++d)
#pragma unroll
        for (int g = 0; g < 4; ++g) {
          uint2 o = {pack2(O[d][4 * g] * linv, O[d][4 * g + 1] * linv), pack2(O[d][4 * g + 2] * linv, O[d][4 * g + 3] * linv)};
          *(uint2*)(OB + orow * 1024 + (hx * 2 + wp) * 64 + d * 32 + 8 * g + 4 * hh) = o;
        }
    } else {
      float* xs = (float*)smem;
      __syncthreads();
      if (wp == 1) {
#pragma unroll
        for (int d = 0; d < NDT; ++d)
#pragma unroll
          for (int i = 0; i < 16; ++i) xs[(wq * 64 + d * 16 + i) * 64 + lane] = O[d][i] * linv;
      }
      __syncthreads();
      if (wp == 0) {
        float ss = 0.f;
#pragma unroll
        for (int d = 0; d < NDT; ++d)
#pragma unroll
          for (int i = 0; i < 16; ++i) {
            const float o = O[d][i] * linv - lam * xs[(wq * 64 + d * 16 + i) * 64 + lane];
            O[d][i] = o; ss += o * o;
          }
        ss += __shfl_xor(ss, 32);
        const float rinv = rsqrtf(ss * (1.f / 128.f) + NORM_EPS) * (1.f - LAMBDA_INIT);
#pragma unroll
        for (int d = 0; d < NDT; ++d)
#pragma unroll
          for (int g = 0; g < 4; ++g) {
            const int dv = d * 32 + 8 * g + 4 * hh;
            const float4 gs4 = *(const float4*)(gsub + dv);
            uint2 o = {pack2(O[d][4 * g] * rinv * gs4.x, O[d][4 * g + 1] * rinv * gs4.y), pack2(O[d][4 * g + 2] * rinv * gs4.z, O[d][4 * g + 3] * rinv * gs4.w)};
            *(uint2*)(OB + orow * 1024 + hx * 128 + dv) = o;
          }
      }
    }
  }
  }
}


#define XB_TMO      128
#define XB_XCNT(j)  (256  + 64 * (j))
#define XB_XSUB(j)  (1280 + 64 * (j))
#define XB_XGEN(j)  (2304 + 64 * (j))
#define XB_TOP      3328
#define XB_TOPGEN   3392
#define XCD_BAR_WORDS 3456
#define XB_SPIN_CAP (1u << 22)
#define LAS __attribute__((address_space(3)))
DI unsigned xb_ld(unsigned* p) { return __hip_atomic_load(p, __ATOMIC_RELAXED, __HIP_MEMORY_SCOPE_AGENT); }
DI unsigned xb_add(unsigned* p, unsigned v) { return __hip_atomic_fetch_add(p, v, __ATOMIC_RELAXED, __HIP_MEMORY_SCOPE_AGENT); }
DI unsigned xb_xcc_id() { return (unsigned)__builtin_amdgcn_s_getreg((3 << 11) | 20) & 0xFu; }
#define XB_SPIN(cond, bar) do { unsigned _sp = 0; while (cond) { __builtin_amdgcn_s_sleep(1); \
    if ((++_sp & 255u) == 0u) { if (xb_ld(&(bar)[XB_TMO])) break; if (_sp > XB_SPIN_CAP) { atomicAdd(&(bar)[XB_TMO], 1u); break; } } } } while (0)
struct XcdBarrier { unsigned* bar; unsigned x; volatile LAS unsigned* st; };
DI XcdBarrier xcd_barrier_post(unsigned* bar, volatile LAS unsigned* st) {
  XcdBarrier b; b.bar = bar; b.x = xb_xcc_id(); b.st = st;
  if (threadIdx.x == 0) (void)xb_add(&bar[XB_XCNT(b.x)], 1u);
  return b;
}
DI void xcd_barrier_complete(unsigned* bar, unsigned x, unsigned& nloc, unsigned& nx) {
  const unsigned G = gridDim.x * gridDim.y * gridDim.z;
  unsigned sum, cnt, mine, sp = 0u;
  for (;;) {
    sum = 0u; cnt = 0u; mine = 0u;
#pragma unroll
    for (unsigned j = 0; j < 16; ++j) { const unsigned c = xb_ld(&bar[XB_XCNT(j)]); sum += c; cnt += (c > 0u) ? 1u : 0u; mine = (j == x) ? c : mine; }
    if (sum == G) break;
    __builtin_amdgcn_s_sleep(1);
    if ((++sp & 255u) == 0u) { if (xb_ld(&bar[XB_TMO])) break; if (sp > XB_SPIN_CAP) { atomicAdd(&bar[XB_TMO], 1u); break; } }
  }
  nloc = mine > 0u ? mine : 1u; nx = cnt > 0u ? cnt : 1u;
}
DI void xcd_barrier(const XcdBarrier& b) {
  asm volatile("s_waitcnt vmcnt(0)" ::: "memory");
  __syncthreads();
  if (threadIdx.x == 0) {
    unsigned* bar = b.bar;
    __builtin_amdgcn_s_waitcnt(0);
    unsigned nloc = b.st[0], nx = b.st[1];
    if (nloc == 0u) { xcd_barrier_complete(bar, b.x, nloc, nx); b.st[0] = nloc; b.st[1] = nx; }
    const unsigned old = xb_add(&bar[XB_XSUB(b.x)], 1u);
    const unsigned gen = old / nloc;
    if (old + 1u == (gen + 1u) * nloc) {
      __builtin_amdgcn_fence(__ATOMIC_RELEASE, "agent");
      asm volatile("s_waitcnt vmcnt(0)" ::: "memory");
      const unsigned og = xb_add(&bar[XB_TOP], 1u);
      const unsigned tg = og / nx;
      if (og + 1u == (tg + 1u) * nx) xb_add(&bar[XB_TOPGEN], 1u);
      else XB_SPIN(xb_ld(&bar[XB_TOPGEN]) == tg, bar);
      __builtin_amdgcn_fence(__ATOMIC_ACQUIRE, "agent");
      xb_add(&bar[XB_XGEN(b.x)], 1u);
      asm volatile("s_waitcnt vmcnt(0)" ::: "memory");
    } else {
      XB_SPIN(xb_ld(&bar[XB_XGEN(b.x)]) == gen, bar);
      __builtin_amdgcn_fence(__ATOMIC_ACQUIRE, "agent");
      asm volatile("s_waitcnt vmcnt(0)" ::: "memory");
    }
  }
  __syncthreads();
}

constexpr int NPH = 35;
__global__ void __launch_bounds__(256, 2) mk_forward(P p) {
  __shared__ __attribute__((aligned(16))) unsigned char smem_raw[73728];
  cg::grid_group grid = cg::this_grid();
  __shared__ uint4 xb_words;
  if (threadIdx.x == 0) xb_words = make_uint4(0u, 0u, 0u, 0u);
  __syncthreads();
  XcdBarrier xb;
  xb.bar = (unsigned*)(p.ws + W_CTRL); xb.x = 0; xb.st = (volatile LAS unsigned*)&xb_words;
  if (p.hi - p.lo > 1) xb = xcd_barrier_post((unsigned*)(p.ws + W_CTRL), (volatile LAS unsigned*)&xb_words);
  bf16_t* smem = (bf16_t*)smem_raw;
  float* smf = (float*)smem_raw;
  unsigned char* big = p.ws + W_BIG;
  int ph = 0;
#ifdef PROBE_DUP_UP
#define PROBE_UP(l) __syncthreads(); phase_mlp_up(p, smem, l)
#else
#define PROBE_UP(l)
#endif
#ifdef PROBE_DUP_ATTN
#define PROBE_AT(m) __syncthreads(); phase_attn<m>(p, smem)
#else
#define PROBE_AT(m)
#endif
#ifndef ONLY_PH
#define ONLY_PH -1
#endif
#ifndef DUPMASK
#define DUPMASK 0ull
#endif
#define PH(...) { if ((ONLY_PH < 0 || ph == ONLY_PH) && ph >= p.lo && ph < p.hi) { __VA_ARGS__; if ((DUPMASK >> ph) & 1ull) { __syncthreads(); __VA_ARGS__; } } ++ph; if (ph > p.lo && ph < p.hi) { if (p.hi < 0) grid.sync(); else xcd_barrier(xb); } }
  PH(phase0(p, smf))
  PH(phase1(p))
  PH(phase_modulate<1>(p, 0, 0))
  PH(phase_s5a(p, smem))
  PH(phase_s5_carry(p))
  PH(phase_s5b(p, smem))
  PH(phase_glu(p, smem))
  PH(phase_modulate<0>(p, 0, 1))
  PH(phase_mlp_up(p, smem, 0); PROBE_UP(0))
  PH(phase_mlp_down(p, smem, 0))
  PH(phase_modulate<0>(p, 1, 0))
  PH(phase_qkv(p, smem))
  PH(phase_attn<false>(p, smem); PROBE_AT(false))
  PH(phase_proj_resid(p, smem, (const bf16_t*)(big + B_OB), 1024, (const bf16_t*)(p.ws + W_DWO), 1))
  PH(phase_modulate<0>(p, 1, 1))
  PH(phase_mlp_up(p, smem, 1); PROBE_UP(1))
  PH(phase_mlp_down(p, smem, 1))
  PH(phase_modulate<0>(p, 2, 0))
  PH(phase_mla_down(p, smem))
  PH(phase_mla_norm(p))
  PH(phase_mla_up(p, smem))
  PH(phase_attn<true>(p, smem); PROBE_AT(true))
  PH(phase_proj_resid(p, smem, (const bf16_t*)(big + B_OBM), 1024, (const bf16_t*)(p.ws + W_MWO), 2))
  PH(phase_modulate<0>(p, 2, 1))
  PH(phase_mlp_up(p, smem, 2); PROBE_UP(2))
  PH(phase_mlp_down(p, smem, 2))
  PH(phase_modulate<0>(p, 3, 0))
  PH(phase_sgu_in(p, smem))
  PH(phase_sgu_norm(p, smf))
  PH(phase_sgu_spatial(p, smem))
  PH(phase_proj_resid(p, smem, (const bf16_t*)(big + B_G), 2048, (const bf16_t*)(p.ws + W_SOUT), 3))
  PH(phase_modulate<0>(p, 3, 1))
  PH(phase_mlp_up(p, smem, 3); PROBE_UP(3))
  PH(phase_mlp_down(p, smem, 3))
  PH(phase_final_norm(p))
#undef PH
}

extern "C" void kernel_launch(void* const* d_in, const int* in_sizes, int n_in, void* d_out, int out_size, void* d_ws, size_t ws_size,
                              hipStream_t stream) {
  static int grid_blocks = 0;
  if (!grid_blocks) {
    int dev = 0, cus = 0, per_cu = 0;
    hipGetDevice(&dev);
    hipDeviceGetAttribute(&cus, hipDeviceAttributeMultiprocessorCount, dev);
    hipOccupancyMaxActiveBlocksPerMultiprocessor(&per_cu, mk_forward, 256, 0);
    if (per_cu < 1) per_cu = 1;
    if (per_cu > 2) per_cu = 2;
    grid_blocks = cus * per_cu;
    if (ws_size < WS_NEED) fprintf(stderr, "kernel_launch: workspace too small: %zu < %zu\n", ws_size, (size_t)WS_NEED);
  }
  P p{};
  for (int i = 0; i < 47; ++i) p.in[i] = (const float*)d_in[i];
  p.out = (float*)d_out;
  p.ws = (unsigned char*)d_ws;
#if MK_SINGLE
  (void)hipMemsetAsync(d_ws, 0, 32768, stream);
  p.lo = 0; p.hi = NPH;
  void* args[] = {&p};
  hipError_t e = hipLaunchCooperativeKernel((void*)mk_forward, dim3(grid_blocks), dim3(256), args, 0, stream);
  if (e != hipSuccess) fprintf(stderr, "cooperative launch failed: %s (grid %d)\n", hipGetErrorString(e), grid_blocks);
#else
  for (int ph = 0; ph < NPH; ++ph) {
    p.lo = ph; p.hi = ph + 1;
    hipLaunchKernelGGL(mk_forward, dim3(grid_blocks), dim3(256), 0, stream, p);
  }
#endif
}
```

```cpp
#include <hip/hip_runtime.h>
#include <hip/hip_cooperative_groups.h>
#include <stdint.h>
#include <stdio.h>
namespace cg = cooperative_groups;

#ifndef MK_SINGLE
#define MK_SINGLE 1
#endif

typedef unsigned short bf16_t;
typedef __attribute__((ext_vector_type(8))) short bf16x8;
typedef __attribute__((ext_vector_type(4))) short s16x4;
typedef __attribute__((ext_vector_type(4))) unsigned u32x4;
typedef __attribute__((ext_vector_type(4))) float f32x4n;
typedef __attribute__((ext_vector_type(16))) float f32x16;
typedef __bf16 bf2_t __attribute__((ext_vector_type(2)));
typedef float fl2_t __attribute__((ext_vector_type(2)));
#define DI __device__ __forceinline__
#define MFMA(a, b, c) __builtin_amdgcn_mfma_f32_32x32x16_bf16((a), (b), (c), 0, 0, 0)

constexpr int NTP = 32768, NTS = 1024, NT = 33792;
constexpr int SLK = 4160;
constexpr int KROWS = 99328;
constexpr float NORM_EPS = 1e-6f;
constexpr float LAMBDA_INIT = 0.35550906759096933f;
constexpr float L2E = 1.4426950408889634f;

constexpr size_t O_S5RP = (size_t)NT * 1024, O_S5IP = O_S5RP + 16384, O_S5RS = O_S5IP + 16384, O_S5IS = O_S5RS + 65536,
                 O_DKP = O_S5IS + 65536, O_DVP = O_DKP + (size_t)NTP * 1024, O_DKS = O_DVP + (size_t)NTP * 1024,
                 O_DVS = O_DKS + (size_t)NTS * 1024, O_CKP = O_DVS + (size_t)NTS * 1024, O_KRP = O_CKP + (size_t)NTP * 128,
                 O_CKS = O_KRP + (size_t)NTP * 32, O_KRS = O_CKS + (size_t)NTS * 128, O_SGV = O_KRS + (size_t)NTS * 32;

constexpr size_t W_CTRL = 0;
constexpr size_t W_LAM = 32768;
constexpr size_t W_MODP = W_LAM + 256;
constexpr size_t W_MOD = W_MODP + 8ull * 20 * 24576 * 4;
constexpr size_t W_AP = W_MOD + 20ull * 24576 * 4;
constexpr size_t W_BBAR = W_AP + 64ull * 65 * 64 * 8;
constexpr size_t W_E = W_BBAR + 64ull * 64 * 16 * 8;
constexpr size_t W_CH = W_E + 64ull * 16 * 2048 * 2;
constexpr size_t W_MEND = W_CH + 64ull * 1024 * 128 * 2;
constexpr size_t W_WS1 = W_MEND + 64ull * 128 * 1024 * 2;
constexpr size_t W_WS2 = W_WS1 + 8ull * 128 * 128 * 2;
constexpr size_t W_WUP = W_WS2 + 8ull * 128 * 128 * 2;
constexpr size_t W_WDN = W_WUP + 4ull * 4096 * 1024 * 2;
constexpr size_t W_GLU = W_WDN + 4ull * 4096 * 1024 * 2;
constexpr size_t W_QKV = W_GLU + 2048ull * 1024 * 2;
constexpr size_t W_DWO = W_QKV + 3072ull * 1024 * 2;
constexpr size_t W_MD = W_DWO + 1024ull * 1024 * 2;
constexpr size_t W_MUQ = W_MD + 512ull * 1024 * 2;
constexpr size_t W_MUKV = W_MUQ + 1536ull * 256 * 2;
constexpr size_t W_MWO = W_MUKV + 2048ull * 128 * 2;
constexpr size_t W_SIN = W_MWO + 1024ull * 1024 * 2;
constexpr size_t W_SOUT = W_SIN + 4096ull * 1024 * 2;
constexpr size_t W_H = W_SOUT + 1024ull * 2048 * 2;
constexpr size_t W_BIG = W_H + (size_t)NT * 1024 * 2;
constexpr size_t B_HG = 0, B_SLOC = 94371840ull, B_Z = 115343360ull;
constexpr size_t B_ACT = 0;
constexpr size_t B_QB = 0, B_KB = 545259520ull, B_VTD = 272629760ull, B_OB = 476053504ull;
constexpr size_t B_RAW = 0, B_CQ = 51904512ull, B_OBM = 0, B_CKV = 69206016ull, B_KR = 94633984ull, B_QM = 100990976ull,
                 B_KN = 204800000ull, B_VTM = 408223744ull;
constexpr size_t B_U = 0, B_VRAW = 138412032ull, B_VTS = 276824064ull, B_G = 415236096ull;
constexpr size_t WS_NEED = W_BIG + 748683264ull;

struct P {
  const float* in[47];
  float* out;
  unsigned char* ws;
  int lo, hi;
};

DI unsigned pack2(float a, float b) {
  fl2_t f = {a, b};
  bf2_t r = __builtin_convertvector(f, bf2_t);
  return __builtin_bit_cast(unsigned, r);
}
DI bf16_t f2bf(float a) { return (bf16_t)(pack2(a, 0.f) & 0xffffu); }
DI float bf2f(bf16_t v) { return __uint_as_float(((unsigned)v) << 16); }
DI float gelu_t(float x) {
  float u = 0.7978845608028654f * (x + 0.044715f * x * x * x);
  float t = 1.f - 2.f / (__expf(2.f * u) + 1.f);
  return 0.5f * x * (1.f + t);
}
DI float sigmoid_f(float x) { return 1.f / (1.f + __expf(-x)); }
DI int batch_of(int row) { return row < NTP ? (row >> 13) : 4 + ((row - NTP) >> 6); }
DI int pos_of(int row) { return row < NTP ? (row & 8191) : 4096 + ((row - NTP) & 63); }
DI int krow_of(int row) { return row < NTP ? row : NTP + ((row - NTP) >> 6) * SLK + 4096 + ((row - NTP) & 63); }
DI void rope_cs(int pos, float invf, float& c, float& s) {
  double t = (double)pos * (double)invf * 0.15915494309189535;
  t -= __builtin_rint(t);
  float ft = (float)t;
  c = __builtin_amdgcn_cosf(ft);
  s = __builtin_amdgcn_sinf(ft);
}
DI float wave_sum(float v) {
#pragma unroll
  for (int o = 32; o > 0; o >>= 1) v += __shfl_xor(v, o);
  return v;
}

DI unsigned xcc_id_() { return (unsigned)__builtin_amdgcn_s_getreg((3 << 11) | 20) & 0xFu; }
struct DynQ {
  unsigned* ctr; int G, per, nq, items, x0, pass, x;
};
DI DynQ dynq_init(const P& p, int qid, int items) {
  DynQ q; q.ctr = (unsigned*)(p.ws + W_CTRL) + 4096 + qid * 64; q.G = gridDim.x; q.nq = ((q.G & 7) == 0) ? 8 : 1; q.per = q.G / q.nq;
  q.items = items; q.x0 = (int)(xcc_id_() & 7u) % q.nq; q.pass = 0; q.x = q.x0; return q;
}
DI int dynq_pop(DynQ& q, int* s_slot) {
  for (;;) {
    if (q.pass >= q.nq) return -1;
    if (threadIdx.x == 0) *s_slot = (int)atomicAdd(&q.ctr[q.x * 8], 1u);
    __syncthreads();
    const int j = *s_slot;
    __syncthreads();
    const int it = (j / q.per) * q.G + q.x * q.per + (j % q.per);
    if (it < q.items) return it;
    ++q.pass; q.x = (q.x0 + q.pass) % q.nq;
  }
}


constexpr int LST = 72;
template <class AF, class BF, class EPI>
DI void gemm_tile(bf16_t* smem, AF af, BF bf, int nkt, EPI epi) {
  const int tid = threadIdx.x, lane = tid & 63, wave = tid >> 6;
  const int wm = wave >> 1, wn = wave & 1, r = lane & 31, h = lane >> 5;
  bf16_t* sA = smem;
  bf16_t* sB = smem + 2 * 128 * LST;
  f32x16 acc[2][2];
#pragma unroll
  for (int a = 0; a < 2; ++a)
#pragma unroll
    for (int b = 0; b < 2; ++b)
#pragma unroll
      for (int i = 0; i < 16; ++i) acc[a][b][i] = 0.f;
  const int lr = tid >> 3, lc = (tid & 7) * 8;
  u32x4 ra[4], rb[4];
#pragma unroll
  for (int i = 0; i < 4; ++i) {
    ra[i] = *(const u32x4*)(af(lr + 32 * i, 0) + lc);
    rb[i] = *(const u32x4*)(bf(lr + 32 * i, 0) + lc);
  }
#pragma unroll
  for (int i = 0; i < 4; ++i) {
    *(u32x4*)(sA + (lr + 32 * i) * LST + lc) = ra[i];
    *(u32x4*)(sB + (lr + 32 * i) * LST + lc) = rb[i];
  }
  __syncthreads();
  for (int kt = 0; kt < nkt; ++kt) {
    const bool more = (kt + 1 < nkt);
    if (more) {
#pragma unroll
      for (int i = 0; i < 4; ++i) {
        ra[i] = *(const u32x4*)(af(lr + 32 * i, kt + 1) + lc);
        rb[i] = *(const u32x4*)(bf(lr + 32 * i, kt + 1) + lc);
      }
    }
    __builtin_amdgcn_sched_barrier(0);
    const bf16_t* pa = sA + (kt & 1) * 128 * LST + (wm * 64 + r) * LST + h * 8;
    const bf16_t* pb = sB + (kt & 1) * 128 * LST + (wn * 64 + r) * LST + h * 8;
#pragma unroll
    for (int ks = 0; ks < 4; ++ks) {
      bf16x8 a0 = *(const bf16x8*)(pa + ks * 16);
      bf16x8 a1 = *(const bf16x8*)(pa + 32 * LST + ks * 16);
      bf16x8 b0 = *(const bf16x8*)(pb + ks * 16);
      bf16x8 b1 = *(const bf16x8*)(pb + 32 * LST + ks * 16);
      acc[0][0] = MFMA(a0, b0, acc[0][0]);
      acc[0][1] = MFMA(a0, b1, acc[0][1]);
      acc[1][0] = MFMA(a1, b0, acc[1][0]);
      acc[1][1] = MFMA(a1, b1, acc[1][1]);
    }
    if (more) {
      const int nb = ((kt + 1) & 1) * 128 * LST;
#pragma unroll
      for (int i = 0; i < 4; ++i) {
        *(u32x4*)(sA + nb + (lr + 32 * i) * LST + lc) = ra[i];
        *(u32x4*)(sB + nb + (lr + 32 * i) * LST + lc) = rb[i];
      }
    }
    __syncthreads();
  }
#pragma unroll
  for (int mi = 0; mi < 2; ++mi)
#pragma unroll
    for (int g = 0; g < 4; ++g) {
      float4 v0 = {acc[mi][0][4 * g], acc[mi][0][4 * g + 1], acc[mi][0][4 * g + 2], acc[mi][0][4 * g + 3]};
      float4 v1 = {acc[mi][1][4 * g], acc[mi][1][4 * g + 1], acc[mi][1][4 * g + 2], acc[mi][1][4 * g + 3]};
      epi(wm * 64 + mi * 32 + 8 * g + 4 * h, wn * 64 + r, v0, v1);
      __builtin_amdgcn_sched_barrier(0);
    }
}


DI int vperm_key(int key) { const int q = (key >> 2) & 3; const int q2 = ((q & 1) << 1) | (q >> 1); return (key & ~15) | (q2 << 2); }

DI void conv_k_slice(const P& p, long t0, int n) {
  const float* ck = p.in[6];
  bf16_t* Kb = (bf16_t*)(p.ws + W_BIG + B_KB);
  for (int i = 0; i < n; ++i) {
    const long idx = t0 + (long)i * 256 + threadIdx.x;
    if (idx < 16l * 4096 * 128) {
      const long rowc = idx >> 7; const int c8 = (int)(idx & 127) * 8;
      const int b = (int)(rowc >> 12), jk = (int)(rowc & 4095);
      const f32x4n a = __builtin_nontemporal_load((const f32x4n*)(ck + rowc * 1024 + c8)), bq = __builtin_nontemporal_load((const f32x4n*)(ck + rowc * 1024 + c8 + 4));
      uint4 o = {pack2(a.x, a.y), pack2(a.z, a.w), pack2(bq.x, bq.y), pack2(bq.z, bq.w)};
      *(uint4*)(Kb + ((long)NTP + (long)b * SLK + jk) * 1024 + c8) = o;
    }
  }
}
DI void conv_v_slice(const P& p, long t0, int n) {
  const float* cv = p.in[7];
  bf16_t* VT = (bf16_t*)(p.ws + W_BIG + B_VTD);
  for (int i = 0; i < n; ++i) {
    const long idx = t0 + (long)i * 256 + threadIdx.x;
    if (idx < 16l * 512 * 1024) {
      const int hd = (int)(idx & 1023); const long t = idx >> 10;
      const int kg = (int)(t & 511), b = (int)(t >> 9);
      const float* src = cv + ((long)b * 4096 + kg * 8) * 1024 + hd;
      const float v0 = __builtin_nontemporal_load(src), v1 = __builtin_nontemporal_load(src + 1024), v2 = __builtin_nontemporal_load(src + 2048), v3 = __builtin_nontemporal_load(src + 3072), v4 = __builtin_nontemporal_load(src + 4096), v5 = __builtin_nontemporal_load(src + 5120), v6 = __builtin_nontemporal_load(src + 6144), v7 = __builtin_nontemporal_load(src + 7168);
      bf16_t* vd = VT + 4l * 1024 * 8192 + (long)b * 1024 * SLK + (long)hd * SLK;
      *(uint2*)(vd + vperm_key(kg * 8)) = make_uint2(pack2(v0, v1), pack2(v2, v3));
      *(uint2*)(vd + vperm_key(kg * 8 + 4)) = make_uint2(pack2(v4, v5), pack2(v6, v7));
    }
  }
}


typedef __attribute__((ext_vector_type(4))) float f32x4;
#define MFMA16(a, b, c) __builtin_amdgcn_mfma_f32_16x16x32_bf16((a), (b), (c), 0, 0, 0)
constexpr int LS2 = 80;
template <class EPI>
DI void gemm_tile256(bf16_t* smem, const bf16_t* __restrict__ Ab, int lda, const bf16_t* __restrict__ Bb, int ldb, int nkt, EPI epi) {
  const int tid = threadIdx.x, lane = tid & 63, wave = tid >> 6;
  const int wm = wave >> 1, wn = wave & 1, l15 = lane & 15, quad = lane >> 4;
  bf16_t* sA = smem;
  bf16_t* sB = smem + 256 * LS2;
  f32x4 acc[8][4];
#pragma unroll
  for (int a = 0; a < 8; ++a)
#pragma unroll
    for (int b = 0; b < 4; ++b)
#pragma unroll
      for (int i = 0; i < 4; ++i) acc[a][b][i] = 0.f;
  const int lr = tid >> 3, lc = (tid & 7) * 8;
  u32x4 rg[12];
  unsigned offa = (unsigned)(lr * lda + lc), offb = (unsigned)(lr * ldb + lc);
  const unsigned sta = 32u * lda, stb = 32u * ldb;
#pragma unroll
  for (int i = 0; i < 8; ++i) rg[i] = *(const u32x4*)(Ab + (offa + i * sta));
#pragma unroll
  for (int i = 0; i < 4; ++i) rg[8 + i] = *(const u32x4*)(Bb + (offb + i * stb));
  for (int kt = 0; kt < nkt; ++kt) {
    __syncthreads();
#pragma unroll
    for (int i = 0; i < 8; ++i) *(u32x4*)(sA + (lr + 32 * i) * LS2 + lc) = rg[i];
#pragma unroll
    for (int i = 0; i < 4; ++i) *(u32x4*)(sB + (lr + 32 * i) * LS2 + lc) = rg[8 + i];
    __syncthreads();
    if (kt + 1 < nkt) {
      offa += 64u; offb += 64u;
#pragma unroll
      for (int i = 0; i < 8; ++i) rg[i] = *(const u32x4*)(Ab + (offa + i * sta));
#pragma unroll
      for (int i = 0; i < 4; ++i) rg[8 + i] = *(const u32x4*)(Bb + (offb + i * stb));
    }
    __builtin_amdgcn_sched_barrier(0);
    const bf16_t* pa = sA + (wm * 128 + l15) * LS2 + quad * 8;
    const bf16_t* pb = sB + (wn * 64 + l15) * LS2 + quad * 8;
#pragma unroll
    for (int ks = 0; ks < 2; ++ks) {
      bf16x8 bfr[4];
#pragma unroll
      for (int ni = 0; ni < 4; ++ni) bfr[ni] = *(const bf16x8*)(pb + ni * 16 * LS2 + ks * 32);
#pragma unroll
      for (int mi = 0; mi < 8; ++mi) {
        const bf16x8 a = *(const bf16x8*)(pa + mi * 16 * LS2 + ks * 32);
#pragma unroll
        for (int ni = 0; ni < 4; ++ni) acc[mi][ni] = MFMA16(a, bfr[ni], acc[mi][ni]);
        if ((mi & 3) == 3) __builtin_amdgcn_sched_barrier(0);
      }
    }
  }
  __syncthreads();
#pragma unroll
  for (int mi = 0; mi < 8; ++mi)
#pragma unroll
    for (int pr = 0; pr < 2; ++pr) {
      float4 v0 = {acc[mi][pr][0], acc[mi][pr][1], acc[mi][pr][2], acc[mi][pr][3]};
      float4 v1 = {acc[mi][pr + 2][0], acc[mi][pr + 2][1], acc[mi][pr + 2][2], acc[mi][pr + 2][3]};
      epi(wm * 128 + mi * 16 + quad * 4, wn * 64 + pr * 16 + l15, v0, v1);
      __builtin_amdgcn_sched_barrier(0);
    }
}

template <bool SPLIT, class EPI>
DI void run_gemm256(const P& p, int qid, bf16_t* smem, const bf16_t* A, int lda, const bf16_t* B, int ldb, int mtiles, int ntiles, int nkt, EPI epi, int sidejob = 0) {
  const int T = mtiles * ntiles, G = gridDim.x;
  int full = T, S = 1;
  if (SPLIT) {
    const int R = T % G;
    if (R > 0) {
      full = T - R;
      S = 16;
      while (S > 1 && (S * R > G || S > nkt)) S >>= 1;
    }
  }
  const int items = full + (T - full) * S;
  __shared__ int s_git;
  DynQ dq = dynq_init(p, qid, items);
  for (;;) {
    const int it = dynq_pop(dq, &s_git);
    if (it < 0) break;
    int t = it, k0 = 0, nk = nkt; bool part = false;
    if (it >= full) { const int j = it - full; t = full + j / S; nk = nkt / S; k0 = (j % S) * nk; part = (S > 1); }
    const int mt = t / ntiles, nt = t % ntiles;
    const bf16_t* a0 = A + (long)mt * 256 * lda + k0 * 64;
    const bf16_t* b0 = B + (long)nt * 128 * ldb + k0 * 64;
    gemm_tile256(smem, a0, lda, b0, ldb, nk,
                 [=](int row0, int col, float4 v0, float4 v1) { epi(mt * 256 + row0, nt * 128 + col, v0, v1, part); });
    if (sidejob == 2 && it < 1024) { conv_v_slice(p, (long)it * 8192, 32); conv_k_slice(p, (long)it * 8192, 32); }
  }
}

DI float f4get(const float4& v, int j) { return j == 0 ? v.x : (j == 1 ? v.y : (j == 2 ? v.z : v.w)); }

template <class F>
DI void prep_w(bf16_t* dst, int K, int N, int ld, F colsrc) {
  const long total = (long)N * (K / 8);
  for (long idx = (long)blockIdx.x * 256 + threadIdx.x; idx < total; idx += (long)gridDim.x * 256) {
    const int n = (int)(idx % N);
    const int kg = (int)(idx / N);
    const float* s = colsrc(n);
    uint4 o = {0u, 0u, 0u, 0u};
    if (s) {
      s += (long)kg * 8 * ld;
      float v0 = s[0], v1 = s[(long)ld], v2 = s[2l * ld], v3 = s[3l * ld], v4 = s[4l * ld], v5 = s[5l * ld], v6 = s[6l * ld], v7 = s[7l * ld];
      o.x = pack2(v0, v1); o.y = pack2(v2, v3); o.z = pack2(v4, v5); o.w = pack2(v6, v7);
    }
    *(uint4*)(dst + (long)n * K + kg * 8) = o;
  }
}

DI void phase0(const P& p, float* smf) {
  unsigned char* ws = p.ws;
  const int gt = blockIdx.x * 256 + threadIdx.x, gs = gridDim.x * 256;
  {
    float* modp = (float*)(ws + W_MODP);
    __shared__ int s_qmp;
    DynQ dq = dynq_init(p, 24, 768);
    for (;;) {
      const int it = dynq_pop(dq, &s_qmp);
      if (it < 0) break;
      const int kc = it / 96, ch = it % 96;
      __syncthreads();
      for (int e = threadIdx.x; e < 20 * 128; e += 256) {
        const int m = e >> 7, k = e & 127;
        const float c = (m < 4) ? p.in[2][m * 1024 + kc * 128 + k] : p.in[3][(m - 4) * 1024 + kc * 128 + k];
        smf[k * 20 + m] = c / (1.f + __expf(-c));
      }
      __syncthreads();
      const int n = ch * 256 + threadIdx.x;
      const int layer = n / 6144, col = n % 6144;
      const float* w = p.in[10] + ((long)(layer * 1024 + kc * 128)) * 6144 + col;
      float acc[20];
#pragma unroll
      for (int m = 0; m < 20; ++m) acc[m] = 0.f;
      for (int k = 0; k < 128; ++k) {
        const float wv = w[(long)k * 6144];
#pragma unroll
        for (int m = 0; m < 20; ++m) acc[m] += smf[k * 20 + m] * wv;
      }
#pragma unroll
      for (int m = 0; m < 20; ++m) modp[(long)(kc * 20 + m) * 24576 + n] = acc[m];
    }
  }
  {
    float2* ap = (float2*)(ws + W_AP);
    for (int idx = gt; idx < 64 * 65 * 64; idx += gs) {
      const int g = idx / (65 * 64), tau = (idx / 64) % 65, pp = idx & 63;
      const float dt = expf(p.in[24][g]);
      const float are = p.in[17][g * 64 + pp], aim = p.in[18][g * 64 + pp];
      const float mag = expf(are * dt * (float)tau);
      double t = (double)aim * (double)dt * (double)tau * 0.15915494309189535;
      t -= __builtin_rint(t);
      const float ft = (float)t;
      ap[idx] = make_float2(mag * __builtin_amdgcn_cosf(ft), mag * __builtin_amdgcn_sinf(ft));
    }
    float2* bb = (float2*)(ws + W_BBAR);
    for (int idx = gt; idx < 64 * 64 * 16; idx += gs) {
      const int g = idx / 1024, pp = (idx >> 4) & 63;
      const float dt = expf(p.in[24][g]);
      const float are = p.in[17][g * 64 + pp], aim = p.in[18][g * 64 + pp];
      const float mag = expf(are * dt);
      double t = (double)aim * (double)dt * 0.15915494309189535;
      t -= __builtin_rint(t);
      const float ft = (float)t;
      const float nr = mag * __builtin_amdgcn_cosf(ft) - 1.f, ni = mag * __builtin_amdgcn_sinf(ft);
      const float den = are * are + aim * aim;
      const float qr = (nr * are + ni * aim) / den, qi = (ni * are - nr * aim) / den;
      const float br = p.in[19][idx], bi = p.in[20][idx];
      bb[idx] = make_float2(qr * br - qi * bi, qr * bi + qi * br);
    }
  }
  if (gt == 0) {
    float s1 = 0.f, s2 = 0.f;
    for (int i = 0; i < 64; ++i) { s1 += p.in[28][i] * p.in[29][i]; s2 += p.in[30][i] * p.in[31][i]; }
    *(float*)(ws + W_LAM) = expf(s1) - expf(s2) + LAMBDA_INIT;
  }
  {
    bf16_t* w1 = (bf16_t*)(ws + W_WS1);
    bf16_t* w2 = (bf16_t*)(ws + W_WS2);
    const float* wsrc = p.in[44];
    for (int idx = gt; idx < 8 * 128 * 128; idx += gs) {
      const int g = idx >> 14, t = (idx >> 7) & 127, s = idx & 127;
      w1[idx] = f2bf(s <= t ? wsrc[idx] : 0.f);
      const int tt = t & 63, ss = s & 63;
      w2[idx] = f2bf(((t >> 6) == (s >> 6) && ss <= tt) ? wsrc[(g * 128 + tt) * 128 + ss] : 0.f);
    }
  }
#ifndef REP_W
#define REP_W 1
#endif
#pragma unroll 1
  for (int rep = 0; rep < REP_W; ++rep) {
  for (int l = 0; l < 4; ++l) {
    const float* up = p.in[14] + (long)l * 1024 * 4096;
    prep_w((bf16_t*)(ws + W_WUP) + (long)l * 4096 * 1024, 1024, 4096, 4096, [=](int n) { return up + n; });
    const float* dn = p.in[15] + (long)l * 4096 * 1024;
    prep_w((bf16_t*)(ws + W_WDN) + (long)l * 1024 * 4096, 4096, 1024, 1024, [=](int n) { return dn + n; });
  }
  {
    const float* ga = p.in[25]; const float* gb = p.in[26];
    prep_w((bf16_t*)(ws + W_GLU), 1024, 2048, 1024, [=](int n) { const int sp = n >> 6, w = n & 63; return ((w < 32) ? ga : gb) + sp * 32 + (w & 31); });
    const float* s = p.in[27];
    prep_w((bf16_t*)(ws + W_QKV), 1024, 3072, 3072, [=](int n) { return s + n; });
    const float* s2 = p.in[33];
    prep_w((bf16_t*)(ws + W_DWO), 1024, 1024, 1024, [=](int n) { return s2 + n; });
    const float* dq = p.in[34];
    prep_w((bf16_t*)(ws + W_MD), 1024, 256, 256, [=](int n) { return dq + n; });
    const float* dkv = p.in[37];
    prep_w((bf16_t*)(ws + W_MD) + 256 * 1024, 1024, 256, 160, [=](int n) -> const float* {
      if (n < 128) return dkv + n;
      const int w = n - 128;
      if (w < 16) return dkv + 128 + w;
      if (w >= 32 && w < 48) return dkv + 144 + (w - 32);
      return nullptr;
    });
    const float* uq = p.in[36];
    prep_w((bf16_t*)(ws + W_MUQ), 256, 1536, 1536, [=](int n) {
      if (n < 1024) return uq + (n >> 6) * 96 + (n & 63);
      const int sp = (n - 1024) >> 6, w = (n - 1024) & 63, half = w >> 5, ix = w & 31;
      const int head = sp * 2 + (ix >> 4), i = ix & 15;
      return uq + head * 96 + 64 + half * 16 + i;
    });
    const float* uk = p.in[39]; const float* uv = p.in[40];
    prep_w((bf16_t*)(ws + W_MUKV), 128, 2048, 1024, [=](int n) { return n < 1024 ? uk + n : uv + (n - 1024); });
    const float* mwo = p.in[41];
    prep_w((bf16_t*)(ws + W_MWO), 1024, 1024, 1024, [=](int n) { return mwo + n; });
    const float* sin_ = p.in[42];
    prep_w((bf16_t*)(ws + W_SIN), 1024, 4096, 4096, [=](int n) { return sin_ + n; });
    const float* sout = p.in[46];
    prep_w((bf16_t*)(ws + W_SOUT), 2048, 1024, 1024, [=](int n) { return sout + n; });
  }
  }
}

DI void phase1(const P& p) {
  unsigned char* ws = p.ws;
  const int gt = blockIdx.x * 256 + threadIdx.x, gs = gridDim.x * 256;
  {
    const float* modp = (const float*)(ws + W_MODP);
    float* mod = (float*)(ws + W_MOD);
    for (int idx = gt; idx < 20 * 24576; idx += gs) {
      const int n = idx % 24576;
      float s = p.in[11][n];
#pragma unroll
      for (int kc = 0; kc < 8; ++kc) s += modp[(long)kc * 20 * 24576 + idx];
      mod[idx] = s;
    }
  }
  const float2* ap = (const float2*)(ws + W_AP);
  const float2* bb = (const float2*)(ws + W_BBAR);
  const float* cre = p.in[21]; const float* cim = p.in[22];
  {
    bf16_t* E = (bf16_t*)(ws + W_E);
    for (int idx = gt; idx < 64 * 16 * 2048; idx += gs) {
      const int g = idx >> 15, co = (idx >> 11) & 15, j = idx & 2047;
      float v = 0.f;
      if (j < 1024) {
        const int tau = 63 - (j >> 4), ci = j & 15;
        for (int pp = 0; pp < 64; ++pp) {
          const float2 a = ap[(g * 65 + tau) * 64 + pp];
          const float2 b = bb[(g * 64 + pp) * 16 + ci];
          const float cr = cre[(g * 16 + co) * 64 + pp], cimv = cim[(g * 16 + co) * 64 + pp];
          const float abr = a.x * b.x - a.y * b.y, abi = a.x * b.y + a.y * b.x;
          v += cr * abr - cimv * abi;
        }
        if (tau == 0 && co == ci) v += p.in[23][g * 16 + co];
      }
      E[idx] = f2bf(v);
    }
    bf16_t* CH = (bf16_t*)(ws + W_CH);
    for (int idx = gt; idx < 64 * 1024 * 128; idx += gs) {
      const int g = idx >> 17, m = (idx >> 7) & 1023, q = idx & 127;
      const int t = m >> 4, co = m & 15, pp = q & 63;
      const float2 a = ap[(g * 65 + t + 1) * 64 + pp];
      const float cr = cre[(g * 16 + co) * 64 + pp], cimv = cim[(g * 16 + co) * 64 + pp];
      const float zr = cr * a.x - cimv * a.y, zi = cr * a.y + cimv * a.x;
      CH[idx] = f2bf(q < 64 ? zr : -zi);
    }
    bf16_t* ME = (bf16_t*)(ws + W_MEND);
    for (int idx = gt; idx < 64 * 128 * 1024; idx += gs) {
      const int g = idx >> 17, q = (idx >> 10) & 127, k = idx & 1023;
      const int s = k >> 4, c = k & 15, pp = q & 63;
      const float2 a = ap[(g * 65 + 63 - s) * 64 + pp];
      const float2 b = bb[(g * 64 + pp) * 16 + c];
      ME[idx] = f2bf(q < 64 ? (a.x * b.x - a.y * b.y) : (a.x * b.y + a.y * b.x));
    }
  }
}

template <int MODE>
DI void phase_modulate(const P& p, int layer, int which) {
  unsigned char* ws = p.ws;
  const float* mod = (const float*)(ws + W_MOD);
  const float* gam = (which == 0 ? p.in[12] : p.in[13]) + layer * 1024;
  const int lane = threadIdx.x & 63;
  const int wv = blockIdx.x * 4 + (threadIdx.x >> 6), nwv = gridDim.x * 4;
  bf16_t* H = (bf16_t*)(ws + W_H);
  bf16_t* HG = (bf16_t*)(ws + W_BIG + B_HG);
  for (int row = wv; row < NT; row += nwv) {
    const float* x = (MODE == 1) ? (row < NTP ? p.in[0] + (long)row * 1024 : p.in[1] + (long)(row - NTP) * 1024) : p.out + (long)row * 1024;
    float4 v[4];
    float ss = 0.f;
#pragma unroll
    for (int i = 0; i < 4; ++i) {
      v[i] = *(const float4*)(x + lane * 4 + 256 * i);
      ss += v[i].x * v[i].x + v[i].y * v[i].y + v[i].z * v[i].z + v[i].w * v[i].w;
    }
    ss = wave_sum(ss);
    const float rinv = rsqrtf(ss * (1.f / 1024.f) + NORM_EPS);
    const int b = batch_of(row);
    const float* sh = mod + (long)b * 24576 + layer * 6144 + (which * 3) * 1024;
    const float* sc = sh + 1024;
#pragma unroll
    for (int i = 0; i < 4; ++i) {
      const int col = lane * 4 + 256 * i;
      const float4 g4 = *(const float4*)(gam + col), sh4 = *(const float4*)(sh + col), sc4 = *(const float4*)(sc + col);
      const float h0 = v[i].x * rinv * g4.x * (1.f + sc4.x) + sh4.x;
      const float h1 = v[i].y * rinv * g4.y * (1.f + sc4.y) + sh4.y;
      const float h2 = v[i].z * rinv * g4.z * (1.f + sc4.z) + sh4.z;
      const float h3 = v[i].w * rinv * g4.w * (1.f + sc4.w) + sh4.w;
      uint2 o = {pack2(h0, h1), pack2(h2, h3)};
      if (MODE == 1) {
        *(float4*)(p.out + (long)row * 1024 + col) = v[i];
        const int g = col >> 4, c = col & 15, n = row >> 6, s = row & 63;
        *(uint2*)(HG + ((long)(g * 640 + n)) * 1152 + s * 16 + c) = o;
      } else {
        *(uint2*)(H + (long)row * 1024 + col) = o;
      }
    }
  }
}

DI void phase_s5_carry(const P& p) {
  unsigned char* ws = p.ws;
  const float2* ap = (const float2*)(ws + W_AP);
  const float* sloc = (const float*)(ws + W_BIG + B_SLOC);
  bf16_t* HG = (bf16_t*)(ws + W_BIG + B_HG);
  const int gt = blockIdx.x * 256 + threadIdx.x, gs = gridDim.x * 256;
  for (int idx = gt; idx < 64 * 20 * 64; idx += gs) {
    const int g = idx / 1280, bb = (idx >> 6) % 20, pp = idx & 63;
    const float2 a = ap[(g * 65 + 64) * 64 + pp];
    if (bb < 4) {
      float hr = 0.f, hi = 0.f;
#pragma unroll 8
      for (int k = 0; k < 128; ++k) {
        const long n = (long)g * 640 + bb * 128 + k;
        HG[n * 1152 + 1024 + pp] = f2bf(hr);
        HG[n * 1152 + 1088 + pp] = f2bf(hi);
        const float sr = sloc[n * 128 + pp], si = sloc[n * 128 + 64 + pp];
        const float nr = a.x * hr - a.y * hi + sr, ni = a.x * hi + a.y * hr + si;
        hr = nr; hi = ni;
      }
      p.out[O_S5RP + (bb * 64 + g) * 64 + pp] = hr;
      p.out[O_S5IP + (bb * 64 + g) * 64 + pp] = hi;
    } else {
      const int b = bb - 4;
      const long n = (long)g * 640 + 512 + b;
      float hr = p.in[4][(b * 64 + g) * 64 + pp], hi = p.in[5][(b * 64 + g) * 64 + pp];
      HG[n * 1152 + 1024 + pp] = f2bf(hr);
      HG[n * 1152 + 1088 + pp] = f2bf(hi);
      const float sr = sloc[n * 128 + pp], si = sloc[n * 128 + 64 + pp];
      p.out[O_S5RS + (b * 64 + g) * 64 + pp] = a.x * hr - a.y * hi + sr;
      p.out[O_S5IS + (b * 64 + g) * 64 + pp] = a.x * hi + a.y * hr + si;
    }
  }
}

DI const float* mod_ptr(const P& p, int layer, int k) { return (const float*)(p.ws + W_MOD) + layer * 6144 + k * 1024; }

DI void phase_s5a(const P& p, bf16_t* smem) {
  const bf16_t* HG = (const bf16_t*)(p.ws + W_BIG + B_HG);
  const bf16_t* ME = (const bf16_t*)(p.ws + W_MEND);
  float* sloc = (float*)(p.ws + W_BIG + B_SLOC);
  __shared__ int s_q5a;
  DynQ dq = dynq_init(p, 23, 64 * 5);
  for (;;) {
    const int t = dynq_pop(dq, &s_q5a);
    if (t < 0) break;
    const int g = t / 5, mi = t % 5;
    const bf16_t* a0 = HG + (long)(g * 640 + mi * 128) * 1152;
    const bf16_t* b0 = ME + (long)g * 128 * 1024;
    float* o = sloc + (long)(g * 640 + mi * 128) * 128;
    gemm_tile(smem, [=](int r, int kt) { return a0 + (long)r * 1152 + kt * 64; }, [=](int r, int kt) { return b0 + (long)r * 1024 + kt * 64; }, 16,
              [=](int row0, int col, float4 v0, float4 v1) {
#pragma unroll
                for (int j = 0; j < 4; ++j) {
                  o[(long)(row0 + j) * 128 + col] = f4get(v0, j);
                  o[(long)(row0 + j) * 128 + col + 32] = f4get(v1, j);
                }
              });
  }
}

DI void phase_s5b(const P& p, bf16_t* smem) {
  const bf16_t* HG = (const bf16_t*)(p.ws + W_BIG + B_HG);
  const bf16_t* E = (const bf16_t*)(p.ws + W_E);
  const bf16_t* CH = (const bf16_t*)(p.ws + W_CH);
  bf16_t* Z = (bf16_t*)(p.ws + W_BIG + B_Z);
  __shared__ int s_q5b;
  DynQ dq = dynq_init(p, 20, 64 * 5 * 8);
  for (;;) {
    const int t = dynq_pop(dq, &s_q5b);
    if (t < 0) break;
    const int j = 7 - t / 320, g = (t % 320) / 5, mi = t % 5;
    const int nE = 2 * j + 2;
    const bf16_t* a0 = HG + (long)(g * 640 + mi * 128) * 1152;
    const bf16_t* e0 = E + (long)g * 16 * 2048;
    const bf16_t* c0 = CH + ((long)g * 1024 + j * 128) * 128;
    gemm_tile(smem,
              [=](int r, int kt) { const int k = kt < nE ? kt : 16 + kt - nE; return a0 + (long)r * 1152 + k * 64; },
              [=](int r, int kt) -> const bf16_t* {
                if (kt < nE) { const int tt = 8 * j + (r >> 4), co = r & 15; return e0 + co * 2048 + (63 - tt) * 16 + kt * 64; }
                return c0 + (long)r * 128 + (kt - nE) * 64;
              },
              nE + 2,
              [=](int row0, int col, float4 v0, float4 v1) {
#pragma unroll
                for (int q = 0; q < 4; ++q) {
                  const int n = mi * 128 + row0 + q;
                  if (n < 528) {
                    const int c0_ = col, c1_ = col + 32;
                    const long tok0 = (long)n * 64 + 8 * j + (c0_ >> 4), tok1 = (long)n * 64 + 8 * j + (c1_ >> 4);
                    Z[tok0 * 1024 + g * 16 + (c0_ & 15)] = f2bf(gelu_t(f4get(v0, q)));
                    Z[tok1 * 1024 + g * 16 + (c1_ & 15)] = f2bf(gelu_t(f4get(v1, q)));
                  }
                }
              });
  }
}

template <class EPI>
DI void run_gemm(const P& p, int qid, bf16_t* smem, const bf16_t* A, int lda, const bf16_t* B, int ldb, int mtiles, int ntiles, int nkt, EPI epi) {
  __shared__ int s_git2;
  DynQ dq = dynq_init(p, qid, mtiles * ntiles);
  for (;;) {
    const int t = dynq_pop(dq, &s_git2);
    if (t < 0) break;
    const int mt = t / ntiles, nt = t % ntiles;
    const bf16_t* a0 = A + (long)mt * 128 * lda;
    const bf16_t* b0 = B + (long)nt * 128 * ldb;
    gemm_tile(smem, [=](int r, int kt) { return a0 + (long)r * lda + kt * 64; }, [=](int r, int kt) { return b0 + (long)r * ldb + kt * 64; }, nkt,
              [=](int row0, int col, float4 v0, float4 v1) { epi(mt * 128 + row0, nt * 128 + col, v0, v1); });
  }
}

DI void resid_add(const P& p, const float* gate, int row0, int col, float4 v0, float4 v1, bool part) {
  const float* gb = gate + (long)batch_of(row0) * 24576;
  const float g0 = 1.f + gb[col], g1 = 1.f + gb[col + 32];
  if (part) {
#pragma unroll
    for (int j = 0; j < 4; ++j) {
      float* x = p.out + (long)(row0 + j) * 1024;
      atomicAdd(x + col, g0 * f4get(v0, j));
      atomicAdd(x + col + 32, g1 * f4get(v1, j));
    }
  } else {
#pragma unroll
    for (int j = 0; j < 4; ++j) {
      float* x = p.out + (long)(row0 + j) * 1024;
      x[col] += g0 * f4get(v0, j);
      x[col + 32] += g1 * f4get(v1, j);
    }
  }
}

DI void phase_glu(const P& p, bf16_t* smem) {
  const float* gate = mod_ptr(p, 0, 2);
  run_gemm256<false>(p, 12, smem, (const bf16_t*)(p.ws + W_BIG + B_Z), 1024, (const bf16_t*)(p.ws + W_GLU), 1024, 132, 16, 16,
           [=](int row0, int col, float4 v0, float4 v1, bool) {
             const int oc = (col >> 6) * 32 + (col & 31);
             const float g0 = 1.f + gate[(long)batch_of(row0) * 24576 + oc];
#pragma unroll
             for (int j = 0; j < 4; ++j) {
               float* x = p.out + (long)(row0 + j) * 1024 + oc;
               *x += g0 * f4get(v0, j) * sigmoid_f(f4get(v1, j));
             }
           });
}

DI void phase_mlp_up(const P& p, bf16_t* smem, int layer) {
  bf16_t* act = (bf16_t*)(p.ws + W_BIG + B_ACT);
  run_gemm256<false>(p, layer, smem, (const bf16_t*)(p.ws + W_H), 1024, (const bf16_t*)(p.ws + W_WUP) + (long)layer * 4096 * 1024, 1024, 132, 32, 16,
           [=](int row0, int col, float4 v0, float4 v1, bool) {
#pragma unroll
             for (int j = 0; j < 4; ++j) {
               const float a = fmaxf(f4get(v0, j), 0.f), b = fmaxf(f4get(v1, j), 0.f);
               act[(long)(row0 + j) * 4096 + col] = f2bf(a * a);
               act[(long)(row0 + j) * 4096 + col + 32] = f2bf(b * b);
             }
           });
}

DI void phase_mlp_down(const P& p, bf16_t* smem, int layer) {
  const float* gate = mod_ptr(p, layer, 5);
  run_gemm256<true>(p, 4 + layer, smem, (const bf16_t*)(p.ws + W_BIG + B_ACT), 4096, (const bf16_t*)(p.ws + W_WDN) + (long)layer * 1024 * 4096, 4096, 132, 8, 64,
           [=](int row0, int col, float4 v0, float4 v1, bool part) { resid_add(p, gate, row0, col, v0, v1, part); }, layer == 0 ? 2 : 0);
}

DI void phase_proj_resid(const P& p, bf16_t* smem, const bf16_t* A, int K, const bf16_t* B, int layer) {
  const float* gate = mod_ptr(p, layer, 2);
  run_gemm256<true>(p, 8 + layer, smem, A, K, B, K, 132, 8, K / 64, [=](int row0, int col, float4 v0, float4 v1, bool part) { resid_add(p, gate, row0, col, v0, v1, part); });
}

DI void store_t4(bf16_t* dst, float4 v) { *(uint2*)dst = make_uint2(pack2(v.x, v.y), pack2(v.z, v.w)); }

DI void phase_qkv(const P& p, bf16_t* smem) {
  unsigned char* big = p.ws + W_BIG;
  bf16_t* Qb = (bf16_t*)(big + B_QB);
  bf16_t* Kb = (bf16_t*)(big + B_KB);
  bf16_t* VT = (bf16_t*)(big + B_VTD);
  const float qscale = 0.125f * L2E;
  run_gemm(p, 14, smem, (const bf16_t*)(p.ws + W_H), 1024, (const bf16_t*)(p.ws + W_QKV), 1024, 264, 24, 16,
           [=](int row0, int col, float4 v0, float4 v1) {
             const int region = col >> 10;
             if (region < 2) {
               const int d = col & 31;
               const float invf = exp2f(-(float)d * (13.287712379549449f / 32.f));
#pragma unroll
               for (int j = 0; j < 4; ++j) {
                 const int row = row0 + j;
                 float c, s;
                 rope_cs(pos_of(row), invf, c, s);
                 const float x1 = f4get(v0, j), x2 = f4get(v1, j);
                 const float o1 = x1 * c - x2 * s, o2 = x1 * s + x2 * c;
                 if (region == 0) {
                   Qb[(long)row * 1024 + col] = f2bf(o1 * qscale);
                   Qb[(long)row * 1024 + col + 32] = f2bf(o2 * qscale);
                 } else {
                   const int kc = col - 1024;
                   float* ko = (row < NTP) ? p.out + O_DKP + (long)row * 1024 : p.out + O_DKS + (long)(row - NTP) * 1024;
                   __builtin_nontemporal_store(o1, ko + kc); __builtin_nontemporal_store(o2, ko + kc + 32);
                   const long kr = krow_of(row);
                   Kb[kr * 1024 + kc] = f2bf(o1);
                   Kb[kr * 1024 + kc + 32] = f2bf(o2);
                 }
               }
             } else {
               const int vc = col - 2048;
#pragma unroll
               for (int j = 0; j < 4; ++j) {
                 const int row = row0 + j;
                 float* vo = (row < NTP) ? p.out + O_DVP + (long)row * 1024 : p.out + O_DVS + (long)(row - NTP) * 1024;
                 __builtin_nontemporal_store(f4get(v0, j), vo + vc); __builtin_nontemporal_store(f4get(v1, j), vo + vc + 32);
               }
               long base; int Lk, key;
               if (row0 < NTP) { const int b = row0 >> 13; key = row0 & 8191; Lk = 8192; base = (long)b * 1024 * 8192; }
               else { const int b = (row0 - NTP) >> 6; key = 4096 + ((row0 - NTP) & 63); Lk = SLK; base = 4l * 1024 * 8192 + (long)b * 1024 * SLK; }
               store_t4(VT + base + (long)vc * Lk + vperm_key(key), v0);
               store_t4(VT + base + (long)(vc + 32) * Lk + vperm_key(key), v1);
             }
           });
}

DI void phase_mla_down(const P& p, bf16_t* smem) {
  unsigned char* big = p.ws + W_BIG;
  float* raw = (float*)(big + B_RAW);
  bf16_t* KR = (bf16_t*)(big + B_KR);
  run_gemm(p, 16, smem, (const bf16_t*)(p.ws + W_H), 1024, (const bf16_t*)(p.ws + W_MD), 1024, 264, 4, 16,
           [=](int row0, int col, float4 v0, float4 v1) {
             if (col < 384) {
#pragma unroll
               for (int j = 0; j < 4; ++j) {
                 raw[(long)(row0 + j) * 384 + col] = f4get(v0, j);
                 raw[(long)(row0 + j) * 384 + col + 32] = f4get(v1, j);
               }
             } else if (col < 400) {
               const int i = col - 384;
               const float invf = exp2f(-(float)i * (13.287712379549449f / 16.f));
#pragma unroll
               for (int j = 0; j < 4; ++j) {
                 const int row = row0 + j;
                 float c, s;
                 rope_cs(pos_of(row), invf, c, s);
                 const float x1 = f4get(v0, j), x2 = f4get(v1, j);
                 const float o1 = x1 * c - x2 * s, o2 = x1 * s + x2 * c;
                 float* ko = (row < NTP) ? p.out + O_KRP + (long)row * 32 : p.out + O_KRS + (long)(row - NTP) * 32;
                 ko[i] = o1; ko[16 + i] = o2;
                 const long kr = krow_of(row);
                 KR[kr * 32 + i] = f2bf(o1); KR[kr * 32 + 16 + i] = f2bf(o2);
               }
             }
           });
  {
    bf16_t* CKV = (bf16_t*)(big + B_CKV);
    const float* cc = p.in[8]; const float* cr = p.in[9];
    const long gt = (long)blockIdx.x * 256 + threadIdx.x, gs = (long)gridDim.x * 256;
    for (long idx = gt; idx < 16l * 4096 * 16; idx += gs) {
      const long rowc = idx >> 4; const int c8 = (int)(idx & 15) * 8;
      const int b = (int)(rowc >> 12), jk = (int)(rowc & 4095);
      const float4 a = *(const float4*)(cc + rowc * 128 + c8), bq = *(const float4*)(cc + rowc * 128 + c8 + 4);
      uint4 o = {pack2(a.x, a.y), pack2(a.z, a.w), pack2(bq.x, bq.y), pack2(bq.z, bq.w)};
      *(uint4*)(CKV + ((long)NTP + (long)b * SLK + jk) * 128 + c8) = o;
    }
    for (long idx = gt; idx < 16l * 4096 * 4; idx += gs) {
      const long rowc = idx >> 2; const int c8 = (int)(idx & 3) * 8;
      const int b = (int)(rowc >> 12), jk = (int)(rowc & 4095);
      const float4 a = *(const float4*)(cr + rowc * 32 + c8), bq = *(const float4*)(cr + rowc * 32 + c8 + 4);
      uint4 o = {pack2(a.x, a.y), pack2(a.z, a.w), pack2(bq.x, bq.y), pack2(bq.z, bq.w)};
      *(uint4*)(KR + ((long)NTP + (long)b * SLK + jk) * 32 + c8) = o;
    }
  }
}

DI void phase_mla_norm(const P& p) {
  unsigned char* big = p.ws + W_BIG;
  const float* raw = (const float*)(big + B_RAW);
  bf16_t* CQ = (bf16_t*)(big + B_CQ);
  bf16_t* CKV = (bf16_t*)(big + B_CKV);
  const int lane = threadIdx.x & 63;
  const int wv = blockIdx.x * 4 + (threadIdx.x >> 6), nwv = gridDim.x * 4;
  const float4 gq = *(const float4*)(p.in[35] + lane * 4);
  const float2 gk = *(const float2*)(p.in[38] + lane * 2);
  for (int row = wv; row < NT; row += nwv) {
    const float4 q = *(const float4*)(raw + (long)row * 384 + lane * 4);
    const float2 k = *(const float2*)(raw + (long)row * 384 + 256 + lane * 2);
    const float sq = wave_sum(q.x * q.x + q.y * q.y + q.z * q.z + q.w * q.w);
    const float sk = wave_sum(k.x * k.x + k.y * k.y);
    const float rq = rsqrtf(sq * (1.f / 256.f) + NORM_EPS), rk = rsqrtf(sk * (1.f / 128.f) + NORM_EPS);
    *(uint2*)(CQ + (long)row * 256 + lane * 4) = make_uint2(pack2(q.x * rq * gq.x, q.y * rq * gq.y), pack2(q.z * rq * gq.z, q.w * rq * gq.w));
    const float c0 = k.x * rk * gk.x, c1 = k.y * rk * gk.y;
    float* co = (row < NTP) ? p.out + O_CKP + (long)row * 128 : p.out + O_CKS + (long)(row - NTP) * 128;
    *(float2*)(co + lane * 2) = make_float2(c0, c1);
    *(unsigned*)(CKV + (long)krow_of(row) * 128 + lane * 2) = pack2(c0, c1);
  }
}

DI void phase_mla_up(const P& p, bf16_t* smem) {
  unsigned char* big = p.ws + W_BIG;
  bf16_t* QM = (bf16_t*)(big + B_QM);
  bf16_t* KN = (bf16_t*)(big + B_KN);
  bf16_t* VT = (bf16_t*)(big + B_VTM);
  const float qscale = 0.10206207261596577f * L2E;
  run_gemm(p, 17, smem, (const bf16_t*)(big + B_CQ), 256, (const bf16_t*)(p.ws + W_MUQ), 256, 264, 12, 4,
           [=](int row0, int col, float4 v0, float4 v1) {
             if (col < 1024) {
               const int o = (col >> 6) * 96 + (col & 63);
#pragma unroll
               for (int j = 0; j < 4; ++j) {
                 QM[(long)(row0 + j) * 1536 + o] = f2bf(f4get(v0, j) * qscale);
                 QM[(long)(row0 + j) * 1536 + o + 32] = f2bf(f4get(v1, j) * qscale);
               }
             } else {
               const int sp = (col - 1024) >> 6, ix = col & 31;
               const int head = sp * 2 + (ix >> 4), i = ix & 15;
               const float invf = exp2f(-(float)i * (13.287712379549449f / 16.f));
#pragma unroll
               for (int j = 0; j < 4; ++j) {
                 const int row = row0 + j;
                 float c, s;
                 rope_cs(pos_of(row), invf, c, s);
                 const float x1 = f4get(v0, j), x2 = f4get(v1, j);
                 QM[(long)row * 1536 + head * 96 + 64 + i] = f2bf((x1 * c - x2 * s) * qscale);
                 QM[(long)row * 1536 + head * 96 + 80 + i] = f2bf((x1 * s + x2 * c) * qscale);
               }
             }
           });
  run_gemm(p, 18, smem, (const bf16_t*)(big + B_CKV), 128, (const bf16_t*)(p.ws + W_MUKV), 128, 776, 16, 2,
           [=](int row0, int col, float4 v0, float4 v1) {
             if (col < 1024) {
#pragma unroll
               for (int j = 0; j < 4; ++j) {
                 KN[(long)(row0 + j) * 1024 + col] = f2bf(f4get(v0, j));
                 KN[(long)(row0 + j) * 1024 + col + 32] = f2bf(f4get(v1, j));
               }
             } else {
               const int vc = col - 1024;
               long base; int Lk, key;
               if (row0 < NTP) { const int b = row0 >> 13; key = row0 & 8191; Lk = 8192; base = (long)b * 1024 * 8192; }
               else { const int b = (row0 - NTP) / SLK; key = (row0 - NTP) - b * SLK; Lk = SLK; base = 4l * 1024 * 8192 + (long)b * 1024 * SLK; }
               store_t4(VT + base + (long)vc * Lk + vperm_key(key), v0);
               store_t4(VT + base + (long)(vc + 32) * Lk + vperm_key(key), v1);
             }
           });
}

DI void phase_sgu_in(const P& p, bf16_t* smem) {
  unsigned char* big = p.ws + W_BIG;
  bf16_t* U = (bf16_t*)(big + B_U);
  bf16_t* VR = (bf16_t*)(big + B_VRAW);
  run_gemm256<false>(p, 13, smem, (const bf16_t*)(p.ws + W_H), 1024, (const bf16_t*)(p.ws + W_SIN), 1024, 132, 32, 16,
           [=](int row0, int col, float4 v0, float4 v1, bool) {
             bf16_t* dst = (col < 2048) ? U + col : VR + (col - 2048);
#pragma unroll
             for (int j = 0; j < 4; ++j) {
               dst[(long)(row0 + j) * 2048] = f2bf(gelu_t(f4get(v0, j)));
               dst[(long)(row0 + j) * 2048 + 32] = f2bf(gelu_t(f4get(v1, j)));
             }
           });
}

DI void phase_sgu_norm(const P& p, float* smf) {
  unsigned char* big = p.ws + W_BIG;
  const bf16_t* VR = (const bf16_t*)(big + B_VRAW);
  bf16_t* VTS = (bf16_t*)(big + B_VTS);
  const float* gv = p.in[43];
  const int lane = threadIdx.x & 63, wave = threadIdx.x >> 6;
  __shared__ int s_qsn;
  DynQ dq = dynq_init(p, 22, 528 * 4);
  for (;;) {
    const int itq = dynq_pop(dq, &s_qsn);
    if (itq < 0) break;
    const int c64 = itq >> 2, qd = itq & 3;
    __syncthreads();
    for (int s = wave; s < 64; s += 4) {
      const bf16_t* rowp = VR + (long)(c64 * 64 + s) * 2048;
      float ss = 0.f;
#pragma unroll
      for (int i = 0; i < 4; ++i) {
        const uint4 q = *(const uint4*)(rowp + lane * 8 + 512 * i);
        const unsigned w[4] = {q.x, q.y, q.z, q.w};
#pragma unroll
        for (int e = 0; e < 4; ++e) {
          const float a = __uint_as_float(w[e] << 16), b = __uint_as_float(w[e] & 0xffff0000u);
          ss += a * a + b * b;
        }
      }
      ss = wave_sum(ss);
      if (lane == 0) smf[s] = rsqrtf(ss * (1.f / 2048.f) + NORM_EPS);
    }
    __syncthreads();
    for (int task = threadIdx.x; task < 128 * 8; task += 256) {
      const int d4 = (qd * 128 + (task & 127)) * 4, sg = task >> 7;
      const float4 g4 = *(const float4*)(gv + d4);
      float v[8][4];
#pragma unroll
      for (int j = 0; j < 8; ++j) {
        const int s = sg * 8 + j;
        const uint2 q = *(const uint2*)(VR + (long)(c64 * 64 + s) * 2048 + d4);
        const float rs = smf[s];
        v[j][0] = __uint_as_float(q.x << 16) * rs * g4.x;
        v[j][1] = __uint_as_float(q.x & 0xffff0000u) * rs * g4.y;
        v[j][2] = __uint_as_float(q.y << 16) * rs * g4.z;
        v[j][3] = __uint_as_float(q.y & 0xffff0000u) * rs * g4.w;
        if (c64 >= 512) *(float4*)(p.out + O_SGV + (long)((c64 - 512) * 64 + s) * 2048 + d4) = make_float4(v[j][0], v[j][1], v[j][2], v[j][3]);
      }
#pragma unroll
      for (int e = 0; e < 4; ++e) {
        uint4 o = {pack2(v[0][e], v[1][e]), pack2(v[2][e], v[3][e]), pack2(v[4][e], v[5][e]), pack2(v[6][e], v[7][e])};
        *(uint4*)(VTS + ((long)c64 * 2048 + d4 + e) * 64 + sg * 8) = o;
      }
    }
  }
}

DI void phase_sgu_spatial(const P& p, bf16_t* smem) {
  unsigned char* big = p.ws + W_BIG;
  const bf16_t* U = (const bf16_t*)(big + B_U);
  const bf16_t* VTS = (const bf16_t*)(big + B_VTS);
  bf16_t* G = (bf16_t*)(big + B_G);
  const float* bs = p.in[45];
  __shared__ int s_qsp;
  DynQ dq = dynq_init(p, 21, 264 * 16);
  for (;;) {
    const int t = dynq_pop(dq, &s_qsp);
    if (t < 0) break;
    const int mt = t >> 4, g = (t >> 1) & 7, dt = t & 1;
    const bf16_t* a0 = (const bf16_t*)(p.ws + (mt < 256 ? W_WS1 : W_WS2)) + g * 128 * 128;
    const bf16_t* b0 = VTS + ((long)mt * 2 * 2048 + g * 256 + dt * 128) * 64;
    const bool prompt = mt < 256;
    gemm_tile(smem, [=](int r, int kt) { return a0 + r * 128 + kt * 64; }, [=](int r, int kt) { return b0 + (long)kt * 2048 * 64 + r * 64; }, 2,
              [=](int row0, int col, float4 v0, float4 v1) {
                const int gc = g * 256 + dt * 128 + col;
#pragma unroll
                for (int j = 0; j < 4; ++j) {
                  const int tr = row0 + j;
                  const float bias = bs[g * 128 + (prompt ? tr : (tr & 63))];
                  const long o = (long)(mt * 128 + tr) * 2048 + gc;
                  G[o] = f2bf(bf2f(U[o]) * (f4get(v0, j) + bias));
                  G[o + 32] = f2bf(bf2f(U[o + 32]) * (f4get(v1, j) + bias));
                }
              });
  }
}

DI void phase_final_norm(const P& p) {
  const int lane = threadIdx.x & 63;
  const int wv = blockIdx.x * 4 + (threadIdx.x >> 6), nwv = gridDim.x * 4;
  const float* gam = p.in[16];
  for (int row = wv; row < NT; row += nwv) {
    float* x = p.out + (long)row * 1024;
    float4 v[4];
    float ss = 0.f;
#pragma unroll
    for (int i = 0; i < 4; ++i) {
      v[i] = *(const float4*)(x + lane * 4 + 256 * i);
      ss += v[i].x * v[i].x + v[i].y * v[i].y + v[i].z * v[i].z + v[i].w * v[i].w;
    }
    ss = wave_sum(ss);
    const float rinv = rsqrtf(ss * (1.f / 1024.f) + NORM_EPS);
#pragma unroll
    for (int i = 0; i < 4; ++i) {
      const int col = lane * 4 + 256 * i;
      const float4 g4 = *(const float4*)(gam + col);
      *(float4*)(x + col) = make_float4(v[i].x * rinv * g4.x, v[i].y * rinv * g4.y, v[i].z * rinv * g4.z, v[i].w * rinv * g4.w);
    }
  }
}

DI bf16x8 pack8(const f32x16& x, int s) {
  unsigned a = pack2(x[8 * s], x[8 * s + 1]), b = pack2(x[8 * s + 2], x[8 * s + 3]), c = pack2(x[8 * s + 4], x[8 * s + 5]), d = pack2(x[8 * s + 6], x[8 * s + 7]);
  uint4 u = {a, b, c, d};
  return __builtin_bit_cast(bf16x8, u);
}

DI unsigned xb_xcc_id_fwd() { return (unsigned)__builtin_amdgcn_s_getreg((3 << 11) | 20) & 0xFu; }
template <bool MLA>
DI void phase_attn(const P& p, bf16_t* smem) {
  constexpr int NKS = MLA ? 6 : 4;
  constexpr int NDT = MLA ? 2 : 4;
  constexpr int NLD = MLA ? 9 : 8;
  unsigned char* big = p.ws + W_BIG;
  const bf16_t* Q = (const bf16_t*)(big + (MLA ? B_QM : B_QB));
  const bf16_t* KK = (const bf16_t*)(big + (MLA ? B_KN : B_KB));
  const bf16_t* KR = (const bf16_t*)(big + B_KR);
  const bf16_t* VT = (const bf16_t*)(big + (MLA ? B_VTM : B_VTD));
  bf16_t* OB = (bf16_t*)(big + (MLA ? B_OBM : B_OB));
  const float lam = *(const float*)(p.ws + W_LAM);
  const float* gsub = p.in[32];
  const int tid = threadIdx.x, lane = tid & 63, wave = tid >> 6;
  const int wp = wave >> 1, wq = wave & 1, r = lane & 31, hh = lane >> 5;
  constexpr int L_K0 = 0, L_K1 = 4608, L_KR = 9216, L_V0 = MLA ? 11776 : 9216, L_V1 = 16384;
  __shared__ int s_item;
  unsigned* qctr = (unsigned*)(p.ws + W_CTRL) + 3584 + (MLA ? 64 : 0);
  const int xs = (int)(xb_xcc_id_fwd() & 7u);
  for (int pass = 0; pass < 8; ++pass) {
  const int hx = (xs + pass) & 7;
  for (;;) {
    if (tid == 0) s_item = (int)atomicAdd(&qctr[hx * 8], 1u);
    __syncthreads();
    const int jq = s_item;
    __syncthreads();
    if (jq >= 528) break;
    int b, qrow0, ntiles, Lk; long R0, vbase;
    if (jq < 16) {
      b = jq; qrow0 = NTP + b * 64; ntiles = 65; Lk = SLK;
      R0 = (long)NTP + (long)b * SLK; vbase = 4l * 1024 * 8192 + (long)b * 1024 * SLK;
    } else {
      const int i = jq - 16; const int qc = 127 - (i >> 2); b = i & 3;
      qrow0 = b * 8192 + qc * 64; ntiles = qc + 1; Lk = 8192; R0 = (long)b * 8192; vbase = (long)b * 1024 * 8192;
    }
    bf16x8 qf[NKS];
    {
      const long qr = (long)(qrow0 + wq * 32 + r);
      const bf16_t* qp = MLA ? Q + qr * 1536 + (hx * 2 + wp) * 96 + 8 * hh : Q + qr * 1024 + (hx * 2 + wp) * 64 + 8 * hh;
#pragma unroll
      for (int ks = 0; ks < NKS; ++ks) qf[ks] = *(const bf16x8*)(qp + ks * 16);
    }
    f32x16 O[NDT];
#pragma unroll
    for (int d = 0; d < NDT; ++d)
#pragma unroll
      for (int i = 0; i < 16; ++i) O[d][i] = 0.f;
    float m_run = -1e30f, l_run = 0.f;
    u32x4 ld[NLD];
#define ATT_GLOAD(KT)                                                                                                   \
  {                                                                                                                     \
    const long kr0 = R0 + (long)(KT) * 64;                                                                              \
    _Pragma("unroll") for (int j = 0; j < 4; ++j) {                                                                     \
      const int c = j >> 1, id = tid + 256 * (j & 1), key = id >> 3, ch = id & 7;                                       \
      ld[j] = *(const u32x4*)(KK + (kr0 + key) * 1024 + (hx * 2 + c) * 64 + ch * 8);                                    \
    }                                                                                                                   \
    if (!MLA) {                                                                                                         \
      _Pragma("unroll") for (int i = 0; i < 4; ++i) {                                                                   \
        const int id = tid + 256 * i, dv = id >> 3, ch = id & 7;                                                        \
        ld[4 + i] = *(const u32x4*)(VT + vbase + (long)(hx * 128 + dv) * Lk + (KT) * 64 + ch * 8);                      \
      }                                                                                                                 \
    } else {                                                                                                            \
      _Pragma("unroll") for (int j = 0; j < 4; ++j) {                                                                   \
        const int c = j >> 1, id = tid + 256 * (j & 1), dv = id >> 3, ch = id & 7;                                      \
        ld[4 + j] = *(const u32x4*)(VT + vbase + (long)((hx * 2 + c) * 64 + dv) * Lk + (KT) * 64 + ch * 8);             \
      }                                                                                                                 \
      ld[NLD - 1] = *(const u32x4*)(KR + (kr0 + (tid >> 2)) * 32 + (tid & 3) * 8);                                      \
    }                                                                                                                   \
  }
#define ATT_SWRITE()                                                                                                    \
  {                                                                                                                     \
    _Pragma("unroll") for (int j = 0; j < 4; ++j) {                                                                     \
      const int c = j >> 1, id = tid + 256 * (j & 1), key = id >> 3, ch = id & 7;                                       \
      *(u32x4*)(smem + (c ? L_K1 : L_K0) + key * LST + ch * 8) = ld[j];                                                 \
    }                                                                                                                   \
    if (!MLA) {                                                                                                         \
      _Pragma("unroll") for (int i = 0; i < 4; ++i) {                                                                   \
        const int id = tid + 256 * i, dv = id >> 3, ch = id & 7;                                                        \
        *(u32x4*)(smem + L_V0 + dv * LST + ch * 8) = ld[4 + i];                                                         \
      }                                                                                                                 \
    } else {                                                                                                            \
      _Pragma("unroll") for (int j = 0; j < 4; ++j) {                                                                   \
        const int c = j >> 1, id = tid + 256 * (j & 1), dv = id >> 3, ch = id & 7;                                      \
        *(u32x4*)(smem + (c ? L_V1 : L_V0) + dv * LST + ch * 8) = ld[4 + j];                                            \
      }                                                                                                                 \
      *(u32x4*)(smem + L_KR + (tid >> 2) * 40 + (tid & 3) * 8) = ld[NLD - 1];                                           \
    }                                                                                                                   \
  }
    ATT_GLOAD(0)
    const bf16_t* sK = smem + (wp ? L_K1 : L_K0);
    const bf16_t* sV = smem + ((MLA && wp) ? L_V1 : L_V0);
    for (int kt = 0; kt < ntiles; ++kt) {
      __syncthreads();
      ATT_SWRITE()
      __syncthreads();
      if (kt + 1 < ntiles) ATT_GLOAD(kt + 1)
      __builtin_amdgcn_sched_barrier(0);
      f32x16 st[2];
#pragma unroll
      for (int mt = 0; mt < 2; ++mt) {
#pragma unroll
        for (int i = 0; i < 16; ++i) st[mt][i] = 0.f;
#pragma unroll
        for (int ks = 0; ks < NKS; ++ks) {
          bf16x8 a;
          if (ks < 4) a = *(const bf16x8*)(sK + (mt * 32 + r) * LST + ks * 16 + 8 * hh);
          else a = *(const bf16x8*)(smem + L_KR + (mt * 32 + r) * 40 + (ks - 4) * 16 + 8 * hh);
          st[mt] = MFMA(a, qf[ks], st[mt]);
        }
      }
      float mloc = st[0][0];
#pragma unroll
      for (int i = 1; i < 16; ++i) mloc = fmaxf(mloc, st[0][i]);
#pragma unroll
      for (int i = 0; i < 16; ++i) mloc = fmaxf(mloc, st[1][i]);
      mloc = fmaxf(mloc, __shfl_xor(mloc, 32));
      const bool need = mloc > m_run + 8.f;
      if (__any(need)) {
        const float mnew = need ? mloc : m_run;
        const float alpha = __builtin_amdgcn_exp2f(m_run - mnew);
        m_run = mnew;
        l_run *= alpha;
#pragma unroll
        for (int d = 0; d < NDT; ++d)
#pragma unroll
          for (int i = 0; i < 16; ++i) O[d][i] *= alpha;
      }
      float ps = 0.f;
#pragma unroll
      for (int mt = 0; mt < 2; ++mt)
#pragma unroll
        for (int i = 0; i < 16; ++i) { const float e = __builtin_amdgcn_exp2f(st[mt][i] - m_run); st[mt][i] = e; ps += e; }
      l_run += ps;
#pragma unroll
      for (int k2 = 0; k2 < 4; ++k2) {
        const bf16x8 pf = pack8(st[k2 >> 1], k2 & 1);
#pragma unroll
        for (int d = 0; d < NDT; ++d) {
          const bf16x8 va = *(const bf16x8*)(sV + (d * 32 + r) * LST + 16 * k2 + 8 * hh);
          O[d] = MFMA(va, pf, O[d]);
        }
      }
    }
    const float ltot = l_run + __shfl_xor(l_run, 32);
    const float linv = 1.f / ltot;
    const long orow = (long)(qrow0 + wq * 32 + r);
    if (MLA) {
#pragma unroll
      for (int d = 0; d < NDT; ++d)
#pragma unroll
        for (int g = 0; g < 4; ++g) {
          uint2 o = {pack2(O[d][4 * g] * linv, O[d][4 * g + 1] * linv), pack2(O[d][4 * g + 2] * linv, O[d][4 * g + 3] * linv)};
          *(uint2*)(OB + orow * 1024 + (hx * 2 + wp) * 64 + d * 32 + 8 * g + 4 * hh) = o;
        }
    } else {
      float* xs = (float*)smem;
      __syncthreads();
      if (wp == 1) {
#pragma unroll
        for (int d = 0; d < NDT; ++d)
#pragma unroll
          for (int i = 0; i < 16; ++i) xs[(wq * 64 + d * 16 + i) * 64 + lane] = O[d][i] * linv;
      }
      __syncthreads();
      if (wp == 0) {
        float ss = 0.f;
#pragma unroll
        for (int d = 0; d < NDT; ++d)
#pragma unroll
          for (int i = 0; i < 16; ++i) {
            const float o = O[d][i] * linv - lam * xs[(wq * 64 + d * 16 + i) * 64 + lane];
            O[d][i] = o; ss += o * o;
          }
        ss += __shfl_xor(ss, 32);
        const float rinv = rsqrtf(ss * (1.f / 128.f) + NORM_EPS) * (1.f - LAMBDA_INIT);
#pragma unroll
        for (int d = 0; d < NDT; ++d)
#pragma unroll
          for (int g = 0; g < 4; ++g) {
            const int dv = d * 32 + 8 * g + 4 * hh;
            const float4 gs4 = *(const float4*)(gsub + dv);
            uint2 o = {pack2(O[d][4 * g] * rinv * gs4.x, O[d][4 * g + 1] * rinv * gs4.y), pack2(O[d][4 * g + 2] * rinv * gs4.z, O[d][4 * g + 3] * rinv * gs4.w)};
            *(uint2*)(OB + orow * 1024 + hx * 128 + dv) = o;
          }
      }
    }
  }
  }
}


#define XB_TMO      128
#define XB_XCNT(j)  (256  + 64 * (j))
#define XB_XSUB(j)  (1280 + 64 * (j))
#define XB_XGEN(j)  (2304 + 64 * (j))
#define XB_TOP      3328
#define XB_TOPGEN   3392
#define XCD_BAR_WORDS 3456
#define XB_SPIN_CAP (1u << 22)
#define LAS __attribute__((address_space(3)))
DI unsigned xb_ld(unsigned* p) { return __hip_atomic_load(p, __ATOMIC_RELAXED, __HIP_MEMORY_SCOPE_AGENT); }
DI unsigned xb_add(unsigned* p, unsigned v) { return __hip_atomic_fetch_add(p, v, __ATOMIC_RELAXED, __HIP_MEMORY_SCOPE_AGENT); }
DI unsigned xb_xcc_id() { return (unsigned)__builtin_amdgcn_s_getreg((3 << 11) | 20) & 0xFu; }
#define XB_SPIN(cond, bar) do { unsigned _sp = 0; while (cond) { __builtin_amdgcn_s_sleep(1); \
    if ((++_sp & 255u) == 0u) { if (xb_ld(&(bar)[XB_TMO])) break; if (_sp > XB_SPIN_CAP) { atomicAdd(&(bar)[XB_TMO], 1u); break; } } } } while (0)
struct XcdBarrier { unsigned* bar; unsigned x; volatile LAS unsigned* st; };
DI XcdBarrier xcd_barrier_post(unsigned* bar, volatile LAS unsigned* st) {
  XcdBarrier b; b.bar = bar; b.x = xb_xcc_id(); b.st = st;
  if (threadIdx.x == 0) (void)xb_add(&bar[XB_XCNT(b.x)], 1u);
  return b;
}
DI void xcd_barrier_complete(unsigned* bar, unsigned x, unsigned& nloc, unsigned& nx) {
  const unsigned G = gridDim.x * gridDim.y * gridDim.z;
  unsigned sum, cnt, mine, sp = 0u;
  for (;;) {
    sum = 0u; cnt = 0u; mine = 0u;
#pragma unroll
    for (unsigned j = 0; j < 16; ++j) { const unsigned c = xb_ld(&bar[XB_XCNT(j)]); sum += c; cnt += (c > 0u) ? 1u : 0u; mine = (j == x) ? c : mine; }
    if (sum == G) break;
    __builtin_amdgcn_s_sleep(1);
    if ((++sp & 255u) == 0u) { if (xb_ld(&bar[XB_TMO])) break; if (sp > XB_SPIN_CAP) { atomicAdd(&bar[XB_TMO], 1u); break; } }
  }
  nloc = mine > 0u ? mine : 1u; nx = cnt > 0u ? cnt : 1u;
}
DI void xcd_barrier(const XcdBarrier& b) {
  asm volatile("s_waitcnt vmcnt(0)" ::: "memory");
  __syncthreads();
  if (threadIdx.x == 0) {
    unsigned* bar = b.bar;
    __builtin_amdgcn_s_waitcnt(0);
    unsigned nloc = b.st[0], nx = b.st[1];
    if (nloc == 0u) { xcd_barrier_complete(bar, b.x, nloc, nx); b.st[0] = nloc; b.st[1] = nx; }
    const unsigned old = xb_add(&bar[XB_XSUB(b.x)], 1u);
    const unsigned gen = old / nloc;
    if (old + 1u == (gen + 1u) * nloc) {
      __builtin_amdgcn_fence(__ATOMIC_RELEASE, "agent");
      asm volatile("s_waitcnt vmcnt(0)" ::: "memory");
      const unsigned og = xb_add(&bar[XB_TOP], 1u);
      const unsigned tg = og / nx;
      if (og + 1u == (tg + 1u) * nx) xb_add(&bar[XB_TOPGEN], 1u);
      else XB_SPIN(xb_ld(&bar[XB_TOPGEN]) == tg, bar);
      __builtin_amdgcn_fence(__ATOMIC_ACQUIRE, "agent");
      xb_add(&bar[XB_XGEN(b.x)], 1u);
      asm volatile("s_waitcnt vmcnt(0)" ::: "memory");
    } else {
      XB_SPIN(xb_ld(&bar[XB_XGEN(b.x)]) == gen, bar);
      __builtin_amdgcn_fence(__ATOMIC_ACQUIRE, "agent");
      asm volatile("s_waitcnt vmcnt(0)" ::: "memory");
    }
  }
  __syncthreads();
}

constexpr int NPH = 35;
__global__ void __launch_bounds__(256, 2) mk_forward(P p) {
  __shared__ __attribute__((aligned(16))) unsigned char smem_raw[73728];
  cg::grid_group grid = cg::this_grid();
  __shared__ uint4 xb_words;
  if (threadIdx.x == 0) xb_words = make_uint4(0u, 0u, 0u, 0u);
  __syncthreads();
  XcdBarrier xb;
  xb.bar = (unsigned*)(p.ws + W_CTRL); xb.x = 0; xb.st = (volatile LAS unsigned*)&xb_words;
  if (p.hi - p.lo > 1) xb = xcd_barrier_post((unsigned*)(p.ws + W_CTRL), (volatile LAS unsigned*)&xb_words);
  bf16_t* smem = (bf16_t*)smem_raw;
  float* smf = (float*)smem_raw;
  unsigned char* big = p.ws + W_BIG;
  int ph = 0;
#ifdef PROBE_DUP_UP
#define PROBE_UP(l) __syncthreads(); phase_mlp_up(p, smem, l)
#else
#define PROBE_UP(l)
#endif
#ifdef PROBE_DUP_ATTN
#define PROBE_AT(m) __syncthreads(); phase_attn<m>(p, smem)
#else
#define PROBE_AT(m)
#endif
#ifndef ONLY_PH
#define ONLY_PH -1
#endif
#ifndef DUPMASK
#define DUPMASK 0ull
#endif
#define PH(...) { if ((ONLY_PH < 0 || ph == ONLY_PH) && ph >= p.lo && ph < p.hi) { __VA_ARGS__; if ((DUPMASK >> ph) & 1ull) { __syncthreads(); __VA_ARGS__; } } ++ph; if (ph > p.lo && ph < p.hi) { if (p.hi < 0) grid.sync(); else xcd_barrier(xb); } }
  PH(phase0(p, smf))
  PH(phase1(p))
  PH(phase_modulate<1>(p, 0, 0))
  PH(phase_s5a(p, smem))
  PH(phase_s5_carry(p))
  PH(phase_s5b(p, smem))
  PH(phase_glu(p, smem))
  PH(phase_modulate<0>(p, 0, 1))
  PH(phase_mlp_up(p, smem, 0); PROBE_UP(0))
  PH(phase_mlp_down(p, smem, 0))
  PH(phase_modulate<0>(p, 1, 0))
  PH(phase_qkv(p, smem))
  PH(phase_attn<false>(p, smem); PROBE_AT(false))
  PH(phase_proj_resid(p, smem, (const bf16_t*)(big + B_OB), 1024, (const bf16_t*)(p.ws + W_DWO), 1))
  PH(phase_modulate<0>(p, 1, 1))
  PH(phase_mlp_up(p, smem, 1); PROBE_UP(1))
  PH(phase_mlp_down(p, smem, 1))
  PH(phase_modulate<0>(p, 2, 0))
  PH(phase_mla_down(p, smem))
  PH(phase_mla_norm(p))
  PH(phase_mla_up(p, smem))
  PH(phase_attn<true>(p, smem); PROBE_AT(true))
  PH(phase_proj_resid(p, smem, (const bf16_t*)(big + B_OBM), 1024, (const bf16_t*)(p.ws + W_MWO), 2))
  PH(phase_modulate<0>(p, 2, 1))
  PH(phase_mlp_up(p, smem, 2); PROBE_UP(2))
  PH(phase_mlp_down(p, smem, 2))
  PH(phase_modulate<0>(p, 3, 0))
  PH(phase_sgu_in(p, smem))
  PH(phase_sgu_norm(p, smf))
  PH(phase_sgu_spatial(p, smem))
  PH(phase_proj_resid(p, smem, (const bf16_t*)(big + B_G), 2048, (const bf16_t*)(p.ws + W_SOUT), 3))
  PH(phase_modulate<0>(p, 3, 1))
  PH(phase_mlp_up(p, smem, 3); PROBE_UP(3))
  PH(phase_mlp_down(p, smem, 3))
  PH(phase_final_norm(p))
#undef PH
}

extern "C" void kernel_launch(void* const* d_in, const int* in_sizes, int n_in, void* d_out, int out_size, void* d_ws, size_t ws_size,
                              hipStream_t stream) {
  static int grid_blocks = 0;
  if (!grid_blocks) {
    int dev = 0, cus = 0, per_cu = 0;
    hipGetDevice(&dev);
    hipDeviceGetAttribute(&cus, hipDeviceAttributeMultiprocessorCount, dev);
    hipOccupancyMaxActiveBlocksPerMultiprocessor(&per_cu, mk_forward, 256, 0);
    if (per_cu < 1) per_cu = 1;
    if (per_cu > 2) per_cu = 2;
    grid_blocks = cus * per_cu;
    if (ws_size < WS_NEED) fprintf(stderr, "kernel_launch: workspace too small: %zu < %zu\n", ws_size, (size_t)WS_NEED);
  }
  P p{};
  for (int i = 0; i < 47; ++i) p.in[i] = (const float*)d_in[i];
  p.out = (float*)d_out;
  p.ws = (unsigned char*)d_ws;
#if MK_SINGLE
  (void)hipMemsetAsync(d_ws, 0, 32768, stream);
  p.lo = 0; p.hi = NPH;
  void* args[] = {&p};
  hipError_t e = hipLaunchCooperativeKernel((void*)mk_forward, dim3(grid_blocks), dim3(256), args, 0, stream);
  if (e != hipSuccess) fprintf(stderr, "cooperative launch failed: %s (grid %d)\n", hipGetErrorString(e), grid_blocks);
#else
  for (int ph = 0; ph < NPH; ++ph) {
    p.lo = ph; p.hi = ph + 1;
    hipLaunchKernelGGL(mk_forward, dim3(grid_blocks), dim3(256), 0, stream, p);
  }
#endif
}
```

```cpp
#include <hip/hip_runtime.h>
#include <hip/hip_cooperative_groups.h>
#include <stdint.h>
#include <stdio.h>
namespace cg = cooperative_groups;

#ifndef MK_SINGLE
#define MK_SINGLE 1
#endif

typedef unsigned short bf16_t;
typedef __attribute__((ext_vector_type(8))) short bf16x8;
typedef __attribute__((ext_vector_type(4))) short s16x4;
typedef __attribute__((ext_vector_type(4))) unsigned u32x4;
typedef __attribute__((ext_vector_type(4))) float f32x4n;
typedef __attribute__((ext_vector_type(16))) float f32x16;
typedef __bf16 bf2_t __attribute__((ext_vector_type(2)));
typedef float fl2_t __attribute__((ext_vector_type(2)));
#define DI __device__ __forceinline__
#define MFMA(a, b, c) __builtin_amdgcn_mfma_f32_32x32x16_bf16((a), (b), (c), 0, 0, 0)

constexpr int NTP = 32768, NTS = 1024, NT = 33792;
constexpr int SLK = 4160;
constexpr int KROWS = 99328;
constexpr float NORM_EPS = 1e-6f;
constexpr float LAMBDA_INIT = 0.35550906759096933f;
constexpr float L2E = 1.4426950408889634f;

constexpr size_t O_S5RP = (size_t)NT * 1024, O_S5IP = O_S5RP + 16384, O_S5RS = O_S5IP + 16384, O_S5IS = O_S5RS + 65536,
                 O_DKP = O_S5IS + 65536, O_DVP = O_DKP + (size_t)NTP * 1024, O_DKS = O_DVP + (size_t)NTP * 1024,
                 O_DVS = O_DKS + (size_t)NTS * 1024, O_CKP = O_DVS + (size_t)NTS * 1024, O_KRP = O_CKP + (size_t)NTP * 128,
                 O_CKS = O_KRP + (size_t)NTP * 32, O_KRS = O_CKS + (size_t)NTS * 128, O_SGV = O_KRS + (size_t)NTS * 32;

constexpr size_t W_CTRL = 0;
constexpr size_t W_LAM = 32768;
constexpr size_t W_MODP = W_LAM + 256;
constexpr size_t W_MOD = W_MODP + 8ull * 20 * 24576 * 4;
constexpr size_t W_AP = W_MOD + 20ull * 24576 * 4;
constexpr size_t W_BBAR = W_AP + 64ull * 65 * 64 * 8;
constexpr size_t W_E = W_BBAR + 64ull * 64 * 16 * 8;
constexpr size_t W_CH = W_E + 64ull * 16 * 2048 * 2;
constexpr size_t W_MEND = W_CH + 64ull * 1024 * 128 * 2;
constexpr size_t W_WS1 = W_MEND + 64ull * 128 * 1024 * 2;
constexpr size_t W_WS2 = W_WS1 + 8ull * 128 * 128 * 2;
constexpr size_t W_WUP = W_WS2 + 8ull * 128 * 128 * 2;
constexpr size_t W_WDN = W_WUP + 4ull * 4096 * 1024 * 2;
constexpr size_t W_GLU = W_WDN + 4ull * 4096 * 1024 * 2;
constexpr size_t W_QKV = W_GLU + 2048ull * 1024 * 2;
constexpr size_t W_DWO = W_QKV + 3072ull * 1024 * 2;
constexpr size_t W_MD = W_DWO + 1024ull * 1024 * 2;
constexpr size_t W_MUQ = W_MD + 512ull * 1024 * 2;
constexpr size_t W_MUKV = W_MUQ + 1536ull * 256 * 2;
constexpr size_t W_MWO = W_MUKV + 2048ull * 128 * 2;
constexpr size_t W_SIN = W_MWO + 1024ull * 1024 * 2;
constexpr size_t W_SOUT = W_SIN + 4096ull * 1024 * 2;
constexpr size_t W_H = W_SOUT + 1024ull * 2048 * 2;
constexpr size_t W_BIG = W_H + (size_t)NT * 1024 * 2;
constexpr size_t B_HG = 0, B_SLOC = 94371840ull, B_Z = 115343360ull;
constexpr size_t B_ACT = 0;
constexpr size_t B_QB = 0, B_KB = 545259520ull, B_VTD = 272629760ull, B_OB = 476053504ull;
constexpr size_t B_RAW = 0, B_CQ = 51904512ull, B_OBM = 0, B_CKV = 69206016ull, B_KR = 94633984ull, B_QM = 100990976ull,
                 B_KN = 204800000ull, B_VTM = 408223744ull;
constexpr size_t B_U = 0, B_VRAW = 138412032ull, B_VTS = 276824064ull, B_G = 415236096ull;
constexpr size_t WS_NEED = W_BIG + 748683264ull;

struct P {
  const float* in[47];
  float* out;
  unsigned char* ws;
  int lo, hi;
};

DI unsigned pack2(float a, float b) {
  fl2_t f = {a, b};
  bf2_t r = __builtin_convertvector(f, bf2_t);
  return __builtin_bit_cast(unsigned, r);
}
DI bf16_t f2bf(float a) { return (bf16_t)(pack2(a, 0.f) & 0xffffu); }
DI float bf2f(bf16_t v) { return __uint_as_float(((unsigned)v) << 16); }
DI float gelu_t(float x) {
  float u = 0.7978845608028654f * (x + 0.044715f * x * x * x);
  float t = 1.f - 2.f / (__expf(2.f * u) + 1.f);
  return 0.5f * x * (1.f + t);
}
DI float sigmoid_f(float x) { return 1.f / (1.f + __expf(-x)); }
DI int batch_of(int row) { return row < NTP ? (row >> 13) : 4 + ((row - NTP) >> 6); }
DI int pos_of(int row) { return row < NTP ? (row & 8191) : 4096 + ((row - NTP) & 63); }
DI int krow_of(int row) { return row < NTP ? row : NTP + ((row - NTP) >> 6) * SLK + 4096 + ((row - NTP) & 63); }
DI void rope_cs(int pos, float invf, float& c, float& s) {
  double t = (double)pos * (double)invf * 0.15915494309189535;
  t -= __builtin_rint(t);
  float ft = (float)t;
  c = __builtin_amdgcn_cosf(ft);
  s = __builtin_amdgcn_sinf(ft);
}
DI float wave_sum(float v) {
#pragma unroll
  for (int o = 32; o > 0; o >>= 1) v += __shfl_xor(v, o);
  return v;
}

DI unsigned xcc_id_() { return (unsigned)__builtin_amdgcn_s_getreg((3 << 11) | 20) & 0xFu; }
struct DynQ {
  unsigned* ctr; int G, per, nq, items, x0, pass, x;
};
DI DynQ dynq_init(const P& p, int qid, int items) {
  DynQ q; q.ctr = (unsigned*)(p.ws + W_CTRL) + 4096 + qid * 64; q.G = gridDim.x; q.nq = ((q.G & 7) == 0) ? 8 : 1; q.per = q.G / q.nq;
  q.items = items; q.x0 = (int)(xcc_id_() & 7u) % q.nq; q.pass = 0; q.x = q.x0; return q;
}
DI int dynq_pop(DynQ& q, int* s_slot) {
  for (;;) {
    if (q.pass >= q.nq) return -1;
    if (threadIdx.x == 0) *s_slot = (int)atomicAdd(&q.ctr[q.x * 8], 1u);
    __syncthreads();
    const int j = *s_slot;
    __syncthreads();
    const int it = (j / q.per) * q.G + q.x * q.per + (j % q.per);
    if (it < q.items) return it;
    ++q.pass; q.x = (q.x0 + q.pass) % q.nq;
  }
}


constexpr int LST = 72;
template <class AF, class BF, class EPI>
DI void gemm_tile(bf16_t* smem, AF af, BF bf, int nkt, EPI epi) {
  const int tid = threadIdx.x, lane = tid & 63, wave = tid >> 6;
  const int wm = wave >> 1, wn = wave & 1, r = lane & 31, h = lane >> 5;
  bf16_t* sA = smem;
  bf16_t* sB = smem + 2 * 128 * LST;
  f32x16 acc[2][2];
#pragma unroll
  for (int a = 0; a < 2; ++a)
#pragma unroll
    for (int b = 0; b < 2; ++b)
#pragma unroll
      for (int i = 0; i < 16; ++i) acc[a][b][i] = 0.f;
  const int lr = tid >> 3, lc = (tid & 7) * 8;
  u32x4 ra[4], rb[4];
#pragma unroll
  for (int i = 0; i < 4; ++i) {
    ra[i] = *(const u32x4*)(af(lr + 32 * i, 0) + lc);
    rb[i] = *(const u32x4*)(bf(lr + 32 * i, 0) + lc);
  }
#pragma unroll
  for (int i = 0; i < 4; ++i) {
    *(u32x4*)(sA + (lr + 32 * i) * LST + lc) = ra[i];
    *(u32x4*)(sB + (lr + 32 * i) * LST + lc) = rb[i];
  }
  __syncthreads();
  for (int kt = 0; kt < nkt; ++kt) {
    const bool more = (kt + 1 < nkt);
    if (more) {
#pragma unroll
      for (int i = 0; i < 4; ++i) {
        ra[i] = *(const u32x4*)(af(lr + 32 * i, kt + 1) + lc);
        rb[i] = *(const u32x4*)(bf(lr + 32 * i, kt + 1) + lc);
      }
    }
    __builtin_amdgcn_sched_barrier(0);
    const bf16_t* pa = sA + (kt & 1) * 128 * LST + (wm * 64 + r) * LST + h * 8;
    const bf16_t* pb = sB + (kt & 1) * 128 * LST + (wn * 64 + r) * LST + h * 8;
#pragma unroll
    for (int ks = 0; ks < 4; ++ks) {
      bf16x8 a0 = *(const bf16x8*)(pa + ks * 16);
      bf16x8 a1 = *(const bf16x8*)(pa + 32 * LST + ks * 16);
      bf16x8 b0 = *(const bf16x8*)(pb + ks * 16);
      bf16x8 b1 = *(const bf16x8*)(pb + 32 * LST + ks * 16);
      acc[0][0] = MFMA(a0, b0, acc[0][0]);
      acc[0][1] = MFMA(a0, b1, acc[0][1]);
      acc[1][0] = MFMA(a1, b0, acc[1][0]);
      acc[1][1] = MFMA(a1, b1, acc[1][1]);
    }
    if (more) {
      const int nb = ((kt + 1) & 1) * 128 * LST;
#pragma unroll
      for (int i = 0; i < 4; ++i) {
        *(u32x4*)(sA + nb + (lr + 32 * i) * LST + lc) = ra[i];
        *(u32x4*)(sB + nb + (lr + 32 * i) * LST + lc) = rb[i];
      }
    }
    __syncthreads();
  }
#pragma unroll
  for (int mi = 0; mi < 2; ++mi)
#pragma unroll
    for (int g = 0; g < 4; ++g) {
      float4 v0 = {acc[mi][0][4 * g], acc[mi][0][4 * g + 1], acc[mi][0][4 * g + 2], acc[mi][0][4 * g + 3]};
      float4 v1 = {acc[mi][1][4 * g], acc[mi][1][4 * g + 1], acc[mi][1][4 * g + 2], acc[mi][1][4 * g + 3]};
      epi(wm * 64 + mi * 32 + 8 * g + 4 * h, wn * 64 + r, v0, v1);
      __builtin_amdgcn_sched_barrier(0);
    }
}


DI int vperm_key(int key) { const int q = (key >> 2) & 3; const int q2 = ((q & 1) << 1) | (q >> 1); return (key & ~15) | (q2 << 2); }

DI void conv_k_slice(const P& p, long t0, int n) {
  const float* ck = p.in[6];
  bf16_t* Kb = (bf16_t*)(p.ws + W_BIG + B_KB);
  for (int i = 0; i < n; ++i) {
    const long idx = t0 + (long)i * 256 + threadIdx.x;
    if (idx < 16l * 4096 * 128) {
      const long rowc = idx >> 7; const int c8 = (int)(idx & 127) * 8;
      const int b = (int)(rowc >> 12), jk = (int)(rowc & 4095);
      const f32x4n a = __builtin_nontemporal_load((const f32x4n*)(ck + rowc * 1024 + c8)), bq = __builtin_nontemporal_load((const f32x4n*)(ck + rowc * 1024 + c8 + 4));
      uint4 o = {pack2(a.x, a.y), pack2(a.z, a.w), pack2(bq.x, bq.y), pack2(bq.z, bq.w)};
      *(uint4*)(Kb + ((long)NTP + (long)b * SLK + jk) * 1024 + c8) = o;
    }
  }
}
DI void conv_v_slice(const P& p, long t0, int n) {
  const float* cv = p.in[7];
  bf16_t* VT = (bf16_t*)(p.ws + W_BIG + B_VTD);
  for (int i = 0; i < n; ++i) {
    const long idx = t0 + (long)i * 256 + threadIdx.x;
    if (idx < 16l * 512 * 1024) {
      const int hd = (int)(idx & 1023); const long t = idx >> 10;
      const int kg = (int)(t & 511), b = (int)(t >> 9);
      const float* src = cv + ((long)b * 4096 + kg * 8) * 1024 + hd;
      const float v0 = __builtin_nontemporal_load(src), v1 = __builtin_nontemporal_load(src + 1024), v2 = __builtin_nontemporal_load(src + 2048), v3 = __builtin_nontemporal_load(src + 3072), v4 = __builtin_nontemporal_load(src + 4096), v5 = __builtin_nontemporal_load(src + 5120), v6 = __builtin_nontemporal_load(src + 6144), v7 = __builtin_nontemporal_load(src + 7168);
      bf16_t* vd = VT + 4l * 1024 * 8192 + (long)b * 1024 * SLK + (long)hd * SLK;
      *(uint2*)(vd + vperm_key(kg * 8)) = make_uint2(pack2(v0, v1), pack2(v2, v3));
      *(uint2*)(vd + vperm_key(kg * 8 + 4)) = make_uint2(pack2(v4, v5), pack2(v6, v7));
    }
  }
}


typedef __attribute__((ext_vector_type(4))) float f32x4;
#define MFMA16(a, b, c) __builtin_amdgcn_mfma_f32_16x16x32_bf16((a), (b), (c), 0, 0, 0)
constexpr int LS2 = 80;
template <class EPI>
DI void gemm_tile256(bf16_t* smem, const bf16_t* __restrict__ Ab, int lda, const bf16_t* __restrict__ Bb, int ldb, int nkt, EPI epi) {
  const int tid = threadIdx.x, lane = tid & 63, wave = tid >> 6;
  const int wm = wave >> 1, wn = wave & 1, l15 = lane & 15, quad = lane >> 4;
  bf16_t* sA = smem;
  bf16_t* sB = smem + 256 * LS2;
  f32x4 acc[8][4];
#pragma unroll
  for (int a = 0; a < 8; ++a)
#pragma unroll
    for (int b = 0; b < 4; ++b)
#pragma unroll
      for (int i = 0; i < 4; ++i) acc[a][b][i] = 0.f;
  const int lr = tid >> 3, lc = (tid & 7) * 8;
  u32x4 rg[12];
  unsigned offa = (unsigned)(lr * lda + lc), offb = (unsigned)(lr * ldb + lc);
  const unsigned sta = 32u * lda, stb = 32u * ldb;
#pragma unroll
  for (int i = 0; i < 8; ++i) rg[i] = *(const u32x4*)(Ab + (offa + i * sta));
#pragma unroll
  for (int i = 0; i < 4; ++i) rg[8 + i] = *(const u32x4*)(Bb + (offb + i * stb));
  for (int kt = 0; kt < nkt; ++kt) {
    __syncthreads();
#pragma unroll
    for (int i = 0; i < 8; ++i) *(u32x4*)(sA + (lr + 32 * i) * LS2 + lc) = rg[i];
#pragma unroll
    for (int i = 0; i < 4; ++i) *(u32x4*)(sB + (lr + 32 * i) * LS2 + lc) = rg[8 + i];
    __syncthreads();
    if (kt + 1 < nkt) {
      offa += 64u; offb += 64u;
#pragma unroll
      for (int i = 0; i < 8; ++i) rg[i] = *(const u32x4*)(Ab + (offa + i * sta));
#pragma unroll
      for (int i = 0; i < 4; ++i) rg[8 + i] = *(const u32x4*)(Bb + (offb + i * stb));
    }
    __builtin_amdgcn_sched_barrier(0);
    const bf16_t* pa = sA + (wm * 128 + l15) * LS2 + quad * 8;
    const bf16_t* pb = sB + (wn * 64 + l15) * LS2 + quad * 8;
#pragma unroll
    for (int ks = 0; ks < 2; ++ks) {
      bf16x8 bfr[4];
#pragma unroll
      for (int ni = 0; ni < 4; ++ni) bfr[ni] = *(const bf16x8*)(pb + ni * 16 * LS2 + ks * 32);
#pragma unroll
      for (int mi = 0; mi < 8; ++mi) {
        const bf16x8 a = *(const bf16x8*)(pa + mi * 16 * LS2 + ks * 32);
#pragma unroll
        for (int ni = 0; ni < 4; ++ni) acc[mi][ni] = MFMA16(a, bfr[ni], acc[mi][ni]);
        if ((mi & 3) == 3) __builtin_amdgcn_sched_barrier(0);
      }
    }
  }
  __syncthreads();
#pragma unroll
  for (int mi = 0; mi < 8; ++mi)
#pragma unroll
    for (int pr = 0; pr < 2; ++pr) {
      float4 v0 = {acc[mi][pr][0], acc[mi][pr][1], acc[mi][pr][2], acc[mi][pr][3]};
      float4 v1 = {acc[mi][pr + 2][0], acc[mi][pr + 2][1], acc[mi][pr + 2][2], acc[mi][pr + 2][3]};
      epi(wm * 128 + mi * 16 + quad * 4, wn * 64 + pr * 16 + l15, v0, v1);
      __builtin_amdgcn_sched_barrier(0);
    }
}

template <bool SPLIT, class EPI>
DI void run_gemm256(const P& p, int qid, bf16_t* smem, const bf16_t* A, int lda, const bf16_t* B, int ldb, int mtiles, int ntiles, int nkt, EPI epi, int sidejob = 0) {
  const int T = mtiles * ntiles, G = gridDim.x;
  int full = T, S = 1;
  if (SPLIT) {
    const int R = T % G;
    if (R > 0) {
      full = T - R;
      S = 16;
      while (S > 1 && (S * R > G || S > nkt)) S >>= 1;
    }
  }
  const int items = full + (T - full) * S;
  __shared__ int s_git;
  DynQ dq = dynq_init(p, qid, items);
  for (;;) {
    const int it = dynq_pop(dq, &s_git);
    if (it < 0) break;
    int t = it, k0 = 0, nk = nkt; bool part = false;
    if (it >= full) { const int j = it - full; t = full + j / S; nk = nkt / S; k0 = (j % S) * nk; part = (S > 1); }
    const int mt = t / ntiles, nt = t % ntiles;
    const bf16_t* a0 = A + (long)mt * 256 * lda + k0 * 64;
    const bf16_t* b0 = B + (long)nt * 128 * ldb + k0 * 64;
    gemm_tile256(smem, a0, lda, b0, ldb, nk,
                 [=](int row0, int col, float4 v0, float4 v1) { epi(mt * 256 + row0, nt * 128 + col, v0, v1, part); });
    if (sidejob == 2 && it < 1024) { conv_v_slice(p, (long)it * 8192, 32); conv_k_slice(p, (long)it * 8192, 32); }
  }
}

DI float f4get(const float4& v, int j) { return j == 0 ? v.x : (j == 1 ? v.y : (j == 2 ? v.z : v.w)); }

template <class F>
DI void prep_w(bf16_t* dst, int K, int N, int ld, F colsrc) {
  const long total = (long)N * (K / 8);
  for (long idx = (long)blockIdx.x * 256 + threadIdx.x; idx < total; idx += (long)gridDim.x * 256) {
    const int n = (int)(idx % N);
    const int kg = (int)(idx / N);
    const float* s = colsrc(n);
    uint4 o = {0u, 0u, 0u, 0u};
    if (s) {
      s += (long)kg * 8 * ld;
      float v0 = __builtin_nontemporal_load(s), v1 = __builtin_nontemporal_load(s + (long)ld), v2 = __builtin_nontemporal_load(s + 2l * ld), v3 = __builtin_nontemporal_load(s + 3l * ld), v4 = __builtin_nontemporal_load(s + 4l * ld), v5 = __builtin_nontemporal_load(s + 5l * ld), v6 = __builtin_nontemporal_load(s + 6l * ld), v7 = __builtin_nontemporal_load(s + 7l * ld);
      o.x = pack2(v0, v1); o.y = pack2(v2, v3); o.z = pack2(v4, v5); o.w = pack2(v6, v7);
    }
    *(uint4*)(dst + (long)n * K + kg * 8) = o;
  }
}

DI void phase0(const P& p, float* smf) {
  unsigned char* ws = p.ws;
  const int gt = blockIdx.x * 256 + threadIdx.x, gs = gridDim.x * 256;
  {
    float* modp = (float*)(ws + W_MODP);
    __shared__ int s_qmp;
    DynQ dq = dynq_init(p, 24, 768);
    for (;;) {
      const int it = dynq_pop(dq, &s_qmp);
      if (it < 0) break;
      const int kc = it / 96, ch = it % 96;
      __syncthreads();
      for (int e = threadIdx.x; e < 20 * 128; e += 256) {
        const int m = e >> 7, k = e & 127;
        const float c = (m < 4) ? p.in[2][m * 1024 + kc * 128 + k] : p.in[3][(m - 4) * 1024 + kc * 128 + k];
        smf[k * 20 + m] = c / (1.f + __expf(-c));
      }
      __syncthreads();
      const int n = ch * 256 + threadIdx.x;
      const int layer = n / 6144, col = n % 6144;
      const float* w = p.in[10] + ((long)(layer * 1024 + kc * 128)) * 6144 + col;
      float acc[20];
#pragma unroll
      for (int m = 0; m < 20; ++m) acc[m] = 0.f;
      for (int k = 0; k < 128; ++k) {
        const float wv = __builtin_nontemporal_load(w + (long)k * 6144);
#pragma unroll
        for (int m = 0; m < 20; ++m) acc[m] += smf[k * 20 + m] * wv;
      }
#pragma unroll
      for (int m = 0; m < 20; ++m) modp[(long)(kc * 20 + m) * 24576 + n] = acc[m];
    }
  }
  {
    float2* ap = (float2*)(ws + W_AP);
    for (int idx = gt; idx < 64 * 65 * 64; idx += gs) {
      const int g = idx / (65 * 64), tau = (idx / 64) % 65, pp = idx & 63;
      const float dt = expf(p.in[24][g]);
      const float are = p.in[17][g * 64 + pp], aim = p.in[18][g * 64 + pp];
      const float mag = expf(are * dt * (float)tau);
      double t = (double)aim * (double)dt * (double)tau * 0.15915494309189535;
      t -= __builtin_rint(t);
      const float ft = (float)t;
      ap[idx] = make_float2(mag * __builtin_amdgcn_cosf(ft), mag * __builtin_amdgcn_sinf(ft));
    }
    float2* bb = (float2*)(ws + W_BBAR);
    for (int idx = gt; idx < 64 * 64 * 16; idx += gs) {
      const int g = idx / 1024, pp = (idx >> 4) & 63;
      const float dt = expf(p.in[24][g]);
      const float are = p.in[17][g * 64 + pp], aim = p.in[18][g * 64 + pp];
      const float mag = expf(are * dt);
      double t = (double)aim * (double)dt * 0.15915494309189535;
      t -= __builtin_rint(t);
      const float ft = (float)t;
      const float nr = mag * __builtin_amdgcn_cosf(ft) - 1.f, ni = mag * __builtin_amdgcn_sinf(ft);
      const float den = are * are + aim * aim;
      const float qr = (nr * are + ni * aim) / den, qi = (ni * are - nr * aim) / den;
      const float br = p.in[19][idx], bi = p.in[20][idx];
      bb[idx] = make_float2(qr * br - qi * bi, qr * bi + qi * br);
    }
  }
  if (gt == 0) {
    float s1 = 0.f, s2 = 0.f;
    for (int i = 0; i < 64; ++i) { s1 += p.in[28][i] * p.in[29][i]; s2 += p.in[30][i] * p.in[31][i]; }
    *(float*)(ws + W_LAM) = expf(s1) - expf(s2) + LAMBDA_INIT;
  }
  {
    bf16_t* w1 = (bf16_t*)(ws + W_WS1);
    bf16_t* w2 = (bf16_t*)(ws + W_WS2);
    const float* wsrc = p.in[44];
    for (int idx = gt; idx < 8 * 128 * 128; idx += gs) {
      const int g = idx >> 14, t = (idx >> 7) & 127, s = idx & 127;
      w1[idx] = f2bf(s <= t ? wsrc[idx] : 0.f);
      const int tt = t & 63, ss = s & 63;
      w2[idx] = f2bf(((t >> 6) == (s >> 6) && ss <= tt) ? wsrc[(g * 128 + tt) * 128 + ss] : 0.f);
    }
  }
#ifndef REP_W
#define REP_W 1
#endif
#pragma unroll 1
  for (int rep = 0; rep < REP_W; ++rep) {
  for (int l = 0; l < 4; ++l) {
    const float* up = p.in[14] + (long)l * 1024 * 4096;
    prep_w((bf16_t*)(ws + W_WUP) + (long)l * 4096 * 1024, 1024, 4096, 4096, [=](int n) { return up + n; });
    const float* dn = p.in[15] + (long)l * 4096 * 1024;
    prep_w((bf16_t*)(ws + W_WDN) + (long)l * 1024 * 4096, 4096, 1024, 1024, [=](int n) { return dn + n; });
  }
  {
    const float* ga = p.in[25]; const float* gb = p.in[26];
    prep_w((bf16_t*)(ws + W_GLU), 1024, 2048, 1024, [=](int n) { const int sp = n >> 6, w = n & 63; return ((w < 32) ? ga : gb) + sp * 32 + (w & 31); });
    const float* s = p.in[27];
    prep_w((bf16_t*)(ws + W_QKV), 1024, 3072, 3072, [=](int n) { return s + n; });
    const float* s2 = p.in[33];
    prep_w((bf16_t*)(ws + W_DWO), 1024, 1024, 1024, [=](int n) { return s2 + n; });
    const float* dq = p.in[34];
    prep_w((bf16_t*)(ws + W_MD), 1024, 256, 256, [=](int n) { return dq + n; });
    const float* dkv = p.in[37];
    prep_w((bf16_t*)(ws + W_MD) + 256 * 1024, 1024, 256, 160, [=](int n) -> const float* {
      if (n < 128) return dkv + n;
      const int w = n - 128;
      if (w < 16) return dkv + 128 + w;
      if (w >= 32 && w < 48) return dkv + 144 + (w - 32);
      return nullptr;
    });
    const float* uq = p.in[36];
    prep_w((bf16_t*)(ws + W_MUQ), 256, 1536, 1536, [=](int n) {
      if (n < 1024) return uq + (n >> 6) * 96 + (n & 63);
      const int sp = (n - 1024) >> 6, w = (n - 1024) & 63, half = w >> 5, ix = w & 31;
      const int head = sp * 2 + (ix >> 4), i = ix & 15;
      return uq + head * 96 + 64 + half * 16 + i;
    });
    const float* uk = p.in[39]; const float* uv = p.in[40];
    prep_w((bf16_t*)(ws + W_MUKV), 128, 2048, 1024, [=](int n) { return n < 1024 ? uk + n : uv + (n - 1024); });
    const float* mwo = p.in[41];
    prep_w((bf16_t*)(ws + W_MWO), 1024, 1024, 1024, [=](int n) { return mwo + n; });
    const float* sin_ = p.in[42];
    prep_w((bf16_t*)(ws + W_SIN), 1024, 4096, 4096, [=](int n) { return sin_ + n; });
    const float* sout = p.in[46];
    prep_w((bf16_t*)(ws + W_SOUT), 2048, 1024, 1024, [=](int n) { return sout + n; });
  }
  }
}

DI void phase1(const P& p) {
  unsigned char* ws = p.ws;
  const int gt = blockIdx.x * 256 + threadIdx.x, gs = gridDim.x * 256;
  {
    const float* modp = (const float*)(ws + W_MODP);
    float* mod = (float*)(ws + W_MOD);
    for (int idx = gt; idx < 20 * 24576; idx += gs) {
      const int n = idx % 24576;
      float s = p.in[11][n];
#pragma unroll
      for (int kc = 0; kc < 8; ++kc) s += modp[(long)kc * 20 * 24576 + idx];
      mod[idx] = s;
    }
  }
  const float2* ap = (const float2*)(ws + W_AP);
  const float2* bb = (const float2*)(ws + W_BBAR);
  const float* cre = p.in[21]; const float* cim = p.in[22];
  {
    bf16_t* E = (bf16_t*)(ws + W_E);
    for (int idx = gt; idx < 64 * 16 * 2048; idx += gs) {
      const int g = idx >> 15, co = (idx >> 11) & 15, j = idx & 2047;
      float v = 0.f;
      if (j < 1024) {
        const int tau = 63 - (j >> 4), ci = j & 15;
        for (int pp = 0; pp < 64; ++pp) {
          const float2 a = ap[(g * 65 + tau) * 64 + pp];
          const float2 b = bb[(g * 64 + pp) * 16 + ci];
          const float cr = cre[(g * 16 + co) * 64 + pp], cimv = cim[(g * 16 + co) * 64 + pp];
          const float abr = a.x * b.x - a.y * b.y, abi = a.x * b.y + a.y * b.x;
          v += cr * abr - cimv * abi;
        }
        if (tau == 0 && co == ci) v += p.in[23][g * 16 + co];
      }
      E[idx] = f2bf(v);
    }
    bf16_t* CH = (bf16_t*)(ws + W_CH);
    for (int idx = gt; idx < 64 * 1024 * 128; idx += gs) {
      const int g = idx >> 17, m = (idx >> 7) & 1023, q = idx & 127;
      const int t = m >> 4, co = m & 15, pp = q & 63;
      const float2 a = ap[(g * 65 + t + 1) * 64 + pp];
      const float cr = cre[(g * 16 + co) * 64 + pp], cimv = cim[(g * 16 + co) * 64 + pp];
      const float zr = cr * a.x - cimv * a.y, zi = cr * a.y + cimv * a.x;
      CH[idx] = f2bf(q < 64 ? zr : -zi);
    }
    bf16_t* ME = (bf16_t*)(ws + W_MEND);
    for (int idx = gt; idx < 64 * 128 * 1024; idx += gs) {
      const int g = idx >> 17, q = (idx >> 10) & 127, k = idx & 1023;
      const int s = k >> 4, c = k & 15, pp = q & 63;
      const float2 a = ap[(g * 65 + 63 - s) * 64 + pp];
      const float2 b = bb[(g * 64 + pp) * 16 + c];
      ME[idx] = f2bf(q < 64 ? (a.x * b.x - a.y * b.y) : (a.x * b.y + a.y * b.x));
    }
  }
}

template <int MODE>
DI void phase_modulate(const P& p, int layer, int which) {
  unsigned char* ws = p.ws;
  const float* mod = (const float*)(ws + W_MOD);
  const float* gam = (which == 0 ? p.in[12] : p.in[13]) + layer * 1024;
  const int lane = threadIdx.x & 63;
  const int wv = blockIdx.x * 4 + (threadIdx.x >> 6), nwv = gridDim.x * 4;
  bf16_t* H = (bf16_t*)(ws + W_H);
  bf16_t* HG = (bf16_t*)(ws + W_BIG + B_HG);
  for (int row = wv; row < NT; row += nwv) {
    const float* x = (MODE == 1) ? (row < NTP ? p.in[0] + (long)row * 1024 : p.in[1] + (long)(row - NTP) * 1024) : p.out + (long)row * 1024;
    float4 v[4];
    float ss = 0.f;
#pragma unroll
    for (int i = 0; i < 4; ++i) {
      if (MODE == 1) { const f32x4n t = __builtin_nontemporal_load((const f32x4n*)(x + lane * 4 + 256 * i)); v[i] = make_float4(t.x, t.y, t.z, t.w); }
      else v[i] = *(const float4*)(x + lane * 4 + 256 * i);
      ss += v[i].x * v[i].x + v[i].y * v[i].y + v[i].z * v[i].z + v[i].w * v[i].w;
    }
    ss = wave_sum(ss);
    const float rinv = rsqrtf(ss * (1.f / 1024.f) + NORM_EPS);
    const int b = batch_of(row);
    const float* sh = mod + (long)b * 24576 + layer * 6144 + (which * 3) * 1024;
    const float* sc = sh + 1024;
#pragma unroll
    for (int i = 0; i < 4; ++i) {
      const int col = lane * 4 + 256 * i;
      const float4 g4 = *(const float4*)(gam + col), sh4 = *(const float4*)(sh + col), sc4 = *(const float4*)(sc + col);
      const float h0 = v[i].x * rinv * g4.x * (1.f + sc4.x) + sh4.x;
      const float h1 = v[i].y * rinv * g4.y * (1.f + sc4.y) + sh4.y;
      const float h2 = v[i].z * rinv * g4.z * (1.f + sc4.z) + sh4.z;
      const float h3 = v[i].w * rinv * g4.w * (1.f + sc4.w) + sh4.w;
      uint2 o = {pack2(h0, h1), pack2(h2, h3)};
      if (MODE == 1) {
        *(float4*)(p.out + (long)row * 1024 + col) = v[i];
        const int g = col >> 4, c = col & 15, n = row >> 6, s = row & 63;
        *(uint2*)(HG + ((long)(g * 640 + n)) * 1152 + s * 16 + c) = o;
      } else {
        *(uint2*)(H + (long)row * 1024 + col) = o;
      }
    }
  }
}

DI void phase_s5_carry(const P& p) {
  unsigned char* ws = p.ws;
  const float2* ap = (const float2*)(ws + W_AP);
  const float* sloc = (const float*)(ws + W_BIG + B_SLOC);
  bf16_t* HG = (bf16_t*)(ws + W_BIG + B_HG);
  const int gt = blockIdx.x * 256 + threadIdx.x, gs = gridDim.x * 256;
  for (int idx = gt; idx < 64 * 20 * 64; idx += gs) {
    const int g = idx / 1280, bb = (idx >> 6) % 20, pp = idx & 63;
    const float2 a = ap[(g * 65 + 64) * 64 + pp];
    if (bb < 4) {
      float hr = 0.f, hi = 0.f;
#pragma unroll 8
      for (int k = 0; k < 128; ++k) {
        const long n = (long)g * 640 + bb * 128 + k;
        HG[n * 1152 + 1024 + pp] = f2bf(hr);
        HG[n * 1152 + 1088 + pp] = f2bf(hi);
        const float sr = sloc[n * 128 + pp], si = sloc[n * 128 + 64 + pp];
        const float nr = a.x * hr - a.y * hi + sr, ni = a.x * hi + a.y * hr + si;
        hr = nr; hi = ni;
      }
      p.out[O_S5RP + (bb * 64 + g) * 64 + pp] = hr;
      p.out[O_S5IP + (bb * 64 + g) * 64 + pp] = hi;
    } else {
      const int b = bb - 4;
      const long n = (long)g * 640 + 512 + b;
      float hr = p.in[4][(b * 64 + g) * 64 + pp], hi = p.in[5][(b * 64 + g) * 64 + pp];
      HG[n * 1152 + 1024 + pp] = f2bf(hr);
      HG[n * 1152 + 1088 + pp] = f2bf(hi);
      const float sr = sloc[n * 128 + pp], si = sloc[n * 128 + 64 + pp];
      p.out[O_S5RS + (b * 64 + g) * 64 + pp] = a.x * hr - a.y * hi + sr;
      p.out[O_S5IS + (b * 64 + g) * 64 + pp] = a.x * hi + a.y * hr + si;
    }
  }
}

DI const float* mod_ptr(const P& p, int layer, int k) { return (const float*)(p.ws + W_MOD) + layer * 6144 + k * 1024; }

DI void phase_s5a(const P& p, bf16_t* smem) {
  const bf16_t* HG = (const bf16_t*)(p.ws + W_BIG + B_HG);
  const bf16_t* ME = (const bf16_t*)(p.ws + W_MEND);
  float* sloc = (float*)(p.ws + W_BIG + B_SLOC);
  __shared__ int s_q5a;
  DynQ dq = dynq_init(p, 23, 64 * 5);
  for (;;) {
    const int t = dynq_pop(dq, &s_q5a);
    if (t < 0) break;
    const int g = t / 5, mi = t % 5;
    const bf16_t* a0 = HG + (long)(g * 640 + mi * 128) * 1152;
    const bf16_t* b0 = ME + (long)g * 128 * 1024;
    float* o = sloc + (long)(g * 640 + mi * 128) * 128;
    gemm_tile(smem, [=](int r, int kt) { return a0 + (long)r * 1152 + kt * 64; }, [=](int r, int kt) { return b0 + (long)r * 1024 + kt * 64; }, 16,
              [=](int row0, int col, float4 v0, float4 v1) {
#pragma unroll
                for (int j = 0; j < 4; ++j) {
                  o[(long)(row0 + j) * 128 + col] = f4get(v0, j);
                  o[(long)(row0 + j) * 128 + col + 32] = f4get(v1, j);
                }
              });
  }
}

DI void phase_s5b(const P& p, bf16_t* smem) {
  const bf16_t* HG = (const bf16_t*)(p.ws + W_BIG + B_HG);
  const bf16_t* E = (const bf16_t*)(p.ws + W_E);
  const bf16_t* CH = (const bf16_t*)(p.ws + W_CH);
  bf16_t* Z = (bf16_t*)(p.ws + W_BIG + B_Z);
  __shared__ int s_q5b;
  DynQ dq = dynq_init(p, 20, 64 * 5 * 8);
  for (;;) {
    const int t = dynq_pop(dq, &s_q5b);
    if (t < 0) break;
    const int j = 7 - t / 320, g = (t % 320) / 5, mi = t % 5;
    const int nE = 2 * j + 2;
    const bf16_t* a0 = HG + (long)(g * 640 + mi * 128) * 1152;
    const bf16_t* e0 = E + (long)g * 16 * 2048;
    const bf16_t* c0 = CH + ((long)g * 1024 + j * 128) * 128;
    gemm_tile(smem,
              [=](int r, int kt) { const int k = kt < nE ? kt : 16 + kt - nE; return a0 + (long)r * 1152 + k * 64; },
              [=](int r, int kt) -> const bf16_t* {
                if (kt < nE) { const int tt = 8 * j + (r >> 4), co = r & 15; return e0 + co * 2048 + (63 - tt) * 16 + kt * 64; }
                return c0 + (long)r * 128 + (kt - nE) * 64;
              },
              nE + 2,
              [=](int row0, int col, float4 v0, float4 v1) {
#pragma unroll
                for (int q = 0; q < 4; ++q) {
                  const int n = mi * 128 + row0 + q;
                  if (n < 528) {
                    const int c0_ = col, c1_ = col + 32;
                    const long tok0 = (long)n * 64 + 8 * j + (c0_ >> 4), tok1 = (long)n * 64 + 8 * j + (c1_ >> 4);
                    Z[tok0 * 1024 + g * 16 + (c0_ & 15)] = f2bf(gelu_t(f4get(v0, q)));
                    Z[tok1 * 1024 + g * 16 + (c1_ & 15)] = f2bf(gelu_t(f4get(v1, q)));
                  }
                }
              });
  }
}

template <class EPI>
DI void run_gemm(const P& p, int qid, bf16_t* smem, const bf16_t* A, int lda, const bf16_t* B, int ldb, int mtiles, int ntiles, int nkt, EPI epi) {
  __shared__ int s_git2;
  DynQ dq = dynq_init(p, qid, mtiles * ntiles);
  for (;;) {
    const int t = dynq_pop(dq, &s_git2);
    if (t < 0) break;
    const int mt = t / ntiles, nt = t % ntiles;
    const bf16_t* a0 = A + (long)mt * 128 * lda;
    const bf16_t* b0 = B + (long)nt * 128 * ldb;
    gemm_tile(smem, [=](int r, int kt) { return a0 + (long)r * lda + kt * 64; }, [=](int r, int kt) { return b0 + (long)r * ldb + kt * 64; }, nkt,
              [=](int row0, int col, float4 v0, float4 v1) { epi(mt * 128 + row0, nt * 128 + col, v0, v1); });
  }
}

DI void resid_add(const P& p, const float* gate, int row0, int col, float4 v0, float4 v1, bool part) {
  const float* gb = gate + (long)batch_of(row0) * 24576;
  const float g0 = 1.f + gb[col], g1 = 1.f + gb[col + 32];
  if (part) {
#pragma unroll
    for (int j = 0; j < 4; ++j) {
      float* x = p.out + (long)(row0 + j) * 1024;
      atomicAdd(x + col, g0 * f4get(v0, j));
      atomicAdd(x + col + 32, g1 * f4get(v1, j));
    }
  } else {
#pragma unroll
    for (int j = 0; j < 4; ++j) {
      float* x = p.out + (long)(row0 + j) * 1024;
      x[col] += g0 * f4get(v0, j);
      x[col + 32] += g1 * f4get(v1, j);
    }
  }
}

DI void phase_glu(const P& p, bf16_t* smem) {
  const float* gate = mod_ptr(p, 0, 2);
  run_gemm256<false>(p, 12, smem, (const bf16_t*)(p.ws + W_BIG + B_Z), 1024, (const bf16_t*)(p.ws + W_GLU), 1024, 132, 16, 16,
           [=](int row0, int col, float4 v0, float4 v1, bool) {
             const int oc = (col >> 6) * 32 + (col & 31);
             const float g0 = 1.f + gate[(long)batch_of(row0) * 24576 + oc];
#pragma unroll
             for (int j = 0; j < 4; ++j) {
               float* x = p.out + (long)(row0 + j) * 1024 + oc;
               *x += g0 * f4get(v0, j) * sigmoid_f(f4get(v1, j));
             }
           });
}

DI void phase_mlp_up(const P& p, bf16_t* smem, int layer) {
  bf16_t* act = (bf16_t*)(p.ws + W_BIG + B_ACT);
  run_gemm256<false>(p, layer, smem, (const bf16_t*)(p.ws + W_H), 1024, (const bf16_t*)(p.ws + W_WUP) + (long)layer * 4096 * 1024, 1024, 132, 32, 16,
           [=](int row0, int col, float4 v0, float4 v1, bool) {
#pragma unroll
             for (int j = 0; j < 4; ++j) {
               const float a = fmaxf(f4get(v0, j), 0.f), b = fmaxf(f4get(v1, j), 0.f);
               act[(long)(row0 + j) * 4096 + col] = f2bf(a * a);
               act[(long)(row0 + j) * 4096 + col + 32] = f2bf(b * b);
             }
           });
}

DI void phase_mlp_down(const P& p, bf16_t* smem, int layer) {
  const float* gate = mod_ptr(p, layer, 5);
  run_gemm256<true>(p, 4 + layer, smem, (const bf16_t*)(p.ws + W_BIG + B_ACT), 4096, (const bf16_t*)(p.ws + W_WDN) + (long)layer * 1024 * 4096, 4096, 132, 8, 64,
           [=](int row0, int col, float4 v0, float4 v1, bool part) { resid_add(p, gate, row0, col, v0, v1, part); }, layer == 0 ? 2 : 0);
}

DI void phase_proj_resid(const P& p, bf16_t* smem, const bf16_t* A, int K, const bf16_t* B, int layer) {
  const float* gate = mod_ptr(p, layer, 2);
  run_gemm256<true>(p, 8 + layer, smem, A, K, B, K, 132, 8, K / 64, [=](int row0, int col, float4 v0, float4 v1, bool part) { resid_add(p, gate, row0, col, v0, v1, part); });
}

DI void store_t4(bf16_t* dst, float4 v) { *(uint2*)dst = make_uint2(pack2(v.x, v.y), pack2(v.z, v.w)); }

DI void phase_qkv(const P& p, bf16_t* smem) {
  unsigned char* big = p.ws + W_BIG;
  bf16_t* Qb = (bf16_t*)(big + B_QB);
  bf16_t* Kb = (bf16_t*)(big + B_KB);
  bf16_t* VT = (bf16_t*)(big + B_VTD);
  const float qscale = 0.125f * L2E;
  run_gemm(p, 14, smem, (const bf16_t*)(p.ws + W_H), 1024, (const bf16_t*)(p.ws + W_QKV), 1024, 264, 24, 16,
           [=](int row0, int col, float4 v0, float4 v1) {
             const int region = col >> 10;
             if (region < 2) {
               const int d = col & 31;
               const float invf = exp2f(-(float)d * (13.287712379549449f / 32.f));
#pragma unroll
               for (int j = 0; j < 4; ++j) {
                 const int row = row0 + j;
                 float c, s;
                 rope_cs(pos_of(row), invf, c, s);
                 const float x1 = f4get(v0, j), x2 = f4get(v1, j);
                 const float o1 = x1 * c - x2 * s, o2 = x1 * s + x2 * c;
                 if (region == 0) {
                   Qb[(long)row * 1024 + col] = f2bf(o1 * qscale);
                   Qb[(long)row * 1024 + col + 32] = f2bf(o2 * qscale);
                 } else {
                   const int kc = col - 1024;
                   float* ko = (row < NTP) ? p.out + O_DKP + (long)row * 1024 : p.out + O_DKS + (long)(row - NTP) * 1024;
                   __builtin_nontemporal_store(o1, ko + kc); __builtin_nontemporal_store(o2, ko + kc + 32);
                   const long kr = krow_of(row);
                   Kb[kr * 1024 + kc] = f2bf(o1);
                   Kb[kr * 1024 + kc + 32] = f2bf(o2);
                 }
               }
             } else {
               const int vc = col - 2048;
#pragma unroll
               for (int j = 0; j < 4; ++j) {
                 const int row = row0 + j;
                 float* vo = (row < NTP) ? p.out + O_DVP + (long)row * 1024 : p.out + O_DVS + (long)(row - NTP) * 1024;
                 __builtin_nontemporal_store(f4get(v0, j), vo + vc); __builtin_nontemporal_store(f4get(v1, j), vo + vc + 32);
               }
               long base; int Lk, key;
               if (row0 < NTP) { const int b = row0 >> 13; key = row0 & 8191; Lk = 8192; base = (long)b * 1024 * 8192; }
               else { const int b = (row0 - NTP) >> 6; key = 4096 + ((row0 - NTP) & 63); Lk = SLK; base = 4l * 1024 * 8192 + (long)b * 1024 * SLK; }
               store_t4(VT + base + (long)vc * Lk + vperm_key(key), v0);
               store_t4(VT + base + (long)(vc + 32) * Lk + vperm_key(key), v1);
             }
           });
}

DI void phase_mla_down(const P& p, bf16_t* smem) {
  unsigned char* big = p.ws + W_BIG;
  float* raw = (float*)(big + B_RAW);
  bf16_t* KR = (bf16_t*)(big + B_KR);
  run_gemm(p, 16, smem, (const bf16_t*)(p.ws + W_H), 1024, (const bf16_t*)(p.ws + W_MD), 1024, 264, 4, 16,
           [=](int row0, int col, float4 v0, float4 v1) {
             if (col < 384) {
#pragma unroll
               for (int j = 0; j < 4; ++j) {
                 raw[(long)(row0 + j) * 384 + col] = f4get(v0, j);
                 raw[(long)(row0 + j) * 384 + col + 32] = f4get(v1, j);
               }
             } else if (col < 400) {
               const int i = col - 384;
               const float invf = exp2f(-(float)i * (13.287712379549449f / 16.f));
#pragma unroll
               for (int j = 0; j < 4; ++j) {
                 const int row = row0 + j;
                 float c, s;
                 rope_cs(pos_of(row), invf, c, s);
                 const float x1 = f4get(v0, j), x2 = f4get(v1, j);
                 const float o1 = x1 * c - x2 * s, o2 = x1 * s + x2 * c;
                 float* ko = (row < NTP) ? p.out + O_KRP + (long)row * 32 : p.out + O_KRS + (long)(row - NTP) * 32;
                 ko[i] = o1; ko[16 + i] = o2;
                 const long kr = krow_of(row);
                 KR[kr * 32 + i] = f2bf(o1); KR[kr * 32 + 16 + i] = f2bf(o2);
               }
             }
           });
  {
    bf16_t* CKV = (bf16_t*)(big + B_CKV);
    const float* cc = p.in[8]; const float* cr = p.in[9];
    const long gt = (long)blockIdx.x * 256 + threadIdx.x, gs = (long)gridDim.x * 256;
    for (long idx = gt; idx < 16l * 4096 * 16; idx += gs) {
      const long rowc = idx >> 4; const int c8 = (int)(idx & 15) * 8;
      const int b = (int)(rowc >> 12), jk = (int)(rowc & 4095);
      const float4 a = *(const float4*)(cc + rowc * 128 + c8), bq = *(const float4*)(cc + rowc * 128 + c8 + 4);
      uint4 o = {pack2(a.x, a.y), pack2(a.z, a.w), pack2(bq.x, bq.y), pack2(bq.z, bq.w)};
      *(uint4*)(CKV + ((long)NTP + (long)b * SLK + jk) * 128 + c8) = o;
    }
    for (long idx = gt; idx < 16l * 4096 * 4; idx += gs) {
      const long rowc = idx >> 2; const int c8 = (int)(idx & 3) * 8;
      const int b = (int)(rowc >> 12), jk = (int)(rowc & 4095);
      const float4 a = *(const float4*)(cr + rowc * 32 + c8), bq = *(const float4*)(cr + rowc * 32 + c8 + 4);
      uint4 o = {pack2(a.x, a.y), pack2(a.z, a.w), pack2(bq.x, bq.y), pack2(bq.z, bq.w)};
      *(uint4*)(KR + ((long)NTP + (long)b * SLK + jk) * 32 + c8) = o;
    }
  }
}

DI void phase_mla_norm(const P& p) {
  unsigned char* big = p.ws + W_BIG;
  const float* raw = (const float*)(big + B_RAW);
  bf16_t* CQ = (bf16_t*)(big + B_CQ);
  bf16_t* CKV = (bf16_t*)(big + B_CKV);
  const int lane = threadIdx.x & 63;
  const int wv = blockIdx.x * 4 + (threadIdx.x >> 6), nwv = gridDim.x * 4;
  const float4 gq = *(const float4*)(p.in[35] + lane * 4);
  const float2 gk = *(const float2*)(p.in[38] + lane * 2);
  for (int row = wv; row < NT; row += nwv) {
    const float4 q = *(const float4*)(raw + (long)row * 384 + lane * 4);
    const float2 k = *(const float2*)(raw + (long)row * 384 + 256 + lane * 2);
    const float sq = wave_sum(q.x * q.x + q.y * q.y + q.z * q.z + q.w * q.w);
    const float sk = wave_sum(k.x * k.x + k.y * k.y);
    const float rq = rsqrtf(sq * (1.f / 256.f) + NORM_EPS), rk = rsqrtf(sk * (1.f / 128.f) + NORM_EPS);
    *(uint2*)(CQ + (long)row * 256 + lane * 4) = make_uint2(pack2(q.x * rq * gq.x, q.y * rq * gq.y), pack2(q.z * rq * gq.z, q.w * rq * gq.w));
    const float c0 = k.x * rk * gk.x, c1 = k.y * rk * gk.y;
    float* co = (row < NTP) ? p.out + O_CKP + (long)row * 128 : p.out + O_CKS + (long)(row - NTP) * 128;
    *(float2*)(co + lane * 2) = make_float2(c0, c1);
    *(unsigned*)(CKV + (long)krow_of(row) * 128 + lane * 2) = pack2(c0, c1);
  }
}

DI void phase_mla_up(const P& p, bf16_t* smem) {
  unsigned char* big = p.ws + W_BIG;
  bf16_t* QM = (bf16_t*)(big + B_QM);
  bf16_t* KN = (bf16_t*)(big + B_KN);
  bf16_t* VT = (bf16_t*)(big + B_VTM);
  const float qscale = 0.10206207261596577f * L2E;
  run_gemm(p, 17, smem, (const bf16_t*)(big + B_CQ), 256, (const bf16_t*)(p.ws + W_MUQ), 256, 264, 12, 4,
           [=](int row0, int col, float4 v0, float4 v1) {
             if (col < 1024) {
               const int o = (col >> 6) * 96 + (col & 63);
#pragma unroll
               for (int j = 0; j < 4; ++j) {
                 QM[(long)(row0 + j) * 1536 + o] = f2bf(f4get(v0, j) * qscale);
                 QM[(long)(row0 + j) * 1536 + o + 32] = f2bf(f4get(v1, j) * qscale);
               }
             } else {
               const int sp = (col - 1024) >> 6, ix = col & 31;
               const int head = sp * 2 + (ix >> 4), i = ix & 15;
               const float invf = exp2f(-(float)i * (13.287712379549449f / 16.f));
#pragma unroll
               for (int j = 0; j < 4; ++j) {
                 const int row = row0 + j;
                 float c, s;
                 rope_cs(pos_of(row), invf, c, s);
                 const float x1 = f4get(v0, j), x2 = f4get(v1, j);
                 QM[(long)row * 1536 + head * 96 + 64 + i] = f2bf((x1 * c - x2 * s) * qscale);
                 QM[(long)row * 1536 + head * 96 + 80 + i] = f2bf((x1 * s + x2 * c) * qscale);
               }
             }
           });
  run_gemm(p, 18, smem, (const bf16_t*)(big + B_CKV), 128, (const bf16_t*)(p.ws + W_MUKV), 128, 776, 16, 2,
           [=](int row0, int col, float4 v0, float4 v1) {
             if (col < 1024) {
#pragma unroll
               for (int j = 0; j < 4; ++j) {
                 KN[(long)(row0 + j) * 1024 + col] = f2bf(f4get(v0, j));
                 KN[(long)(row0 + j) * 1024 + col + 32] = f2bf(f4get(v1, j));
               }
             } else {
               const int vc = col - 1024;
               long base; int Lk, key;
               if (row0 < NTP) { const int b = row0 >> 13; key = row0 & 8191; Lk = 8192; base = (long)b * 1024 * 8192; }
               else { const int b = (row0 - NTP) / SLK; key = (row0 - NTP) - b * SLK; Lk = SLK; base = 4l * 1024 * 8192 + (long)b * 1024 * SLK; }
               store_t4(VT + base + (long)vc * Lk + vperm_key(key), v0);
               store_t4(VT + base + (long)(vc + 32) * Lk + vperm_key(key), v1);
             }
           });
}

DI void phase_sgu_in(const P& p, bf16_t* smem) {
  unsigned char* big = p.ws + W_BIG;
  bf16_t* U = (bf16_t*)(big + B_U);
  bf16_t* VR = (bf16_t*)(big + B_VRAW);
  run_gemm256<false>(p, 13, smem, (const bf16_t*)(p.ws + W_H), 1024, (const bf16_t*)(p.ws + W_SIN), 1024, 132, 32, 16,
           [=](int row0, int col, float4 v0, float4 v1, bool) {
             bf16_t* dst = (col < 2048) ? U + col : VR + (col - 2048);
#pragma unroll
             for (int j = 0; j < 4; ++j) {
               dst[(long)(row0 + j) * 2048] = f2bf(gelu_t(f4get(v0, j)));
               dst[(long)(row0 + j) * 2048 + 32] = f2bf(gelu_t(f4get(v1, j)));
             }
           });
}

DI void phase_sgu_norm(const P& p, float* smf) {
  unsigned char* big = p.ws + W_BIG;
  const bf16_t* VR = (const bf16_t*)(big + B_VRAW);
  bf16_t* VTS = (bf16_t*)(big + B_VTS);
  const float* gv = p.in[43];
  const int lane = threadIdx.x & 63, wave = threadIdx.x >> 6;
  __shared__ int s_qsn;
  DynQ dq = dynq_init(p, 22, 528 * 4);
  for (;;) {
    const int itq = dynq_pop(dq, &s_qsn);
    if (itq < 0) break;
    const int c64 = itq >> 2, qd = itq & 3;
    __syncthreads();
    for (int s = wave; s < 64; s += 4) {
      const bf16_t* rowp = VR + (long)(c64 * 64 + s) * 2048;
      float ss = 0.f;
#pragma unroll
      for (int i = 0; i < 4; ++i) {
        const uint4 q = *(const uint4*)(rowp + lane * 8 + 512 * i);
        const unsigned w[4] = {q.x, q.y, q.z, q.w};
#pragma unroll
        for (int e = 0; e < 4; ++e) {
          const float a = __uint_as_float(w[e] << 16), b = __uint_as_float(w[e] & 0xffff0000u);
          ss += a * a + b * b;
        }
      }
      ss = wave_sum(ss);
      if (lane == 0) smf[s] = rsqrtf(ss * (1.f / 2048.f) + NORM_EPS);
    }
    __syncthreads();
    for (int task = threadIdx.x; task < 128 * 8; task += 256) {
      const int d4 = (qd * 128 + (task & 127)) * 4, sg = task >> 7;
      const float4 g4 = *(const float4*)(gv + d4);
      float v[8][4];
#pragma unroll
      for (int j = 0; j < 8; ++j) {
        const int s = sg * 8 + j;
        const uint2 q = *(const uint2*)(VR + (long)(c64 * 64 + s) * 2048 + d4);
        const float rs = smf[s];
        v[j][0] = __uint_as_float(q.x << 16) * rs * g4.x;
        v[j][1] = __uint_as_float(q.x & 0xffff0000u) * rs * g4.y;
        v[j][2] = __uint_as_float(q.y << 16) * rs * g4.z;
        v[j][3] = __uint_as_float(q.y & 0xffff0000u) * rs * g4.w;
        if (c64 >= 512) *(float4*)(p.out + O_SGV + (long)((c64 - 512) * 64 + s) * 2048 + d4) = make_float4(v[j][0], v[j][1], v[j][2], v[j][3]);
      }
#pragma unroll
      for (int e = 0; e < 4; ++e) {
        uint4 o = {pack2(v[0][e], v[1][e]), pack2(v[2][e], v[3][e]), pack2(v[4][e], v[5][e]), pack2(v[6][e], v[7][e])};
        *(uint4*)(VTS + ((long)c64 * 2048 + d4 + e) * 64 + sg * 8) = o;
      }
    }
  }
}

DI void phase_sgu_spatial(const P& p, bf16_t* smem) {
  unsigned char* big = p.ws + W_BIG;
  const bf16_t* U = (const bf16_t*)(big + B_U);
  const bf16_t* VTS = (const bf16_t*)(big + B_VTS);
  bf16_t* G = (bf16_t*)(big + B_G);
  const float* bs = p.in[45];
  __shared__ int s_qsp;
  DynQ dq = dynq_init(p, 21, 264 * 16);
  for (;;) {
    const int t = dynq_pop(dq, &s_qsp);
    if (t < 0) break;
    const int mt = t >> 4, g = (t >> 1) & 7, dt = t & 1;
    const bf16_t* a0 = (const bf16_t*)(p.ws + (mt < 256 ? W_WS1 : W_WS2)) + g * 128 * 128;
    const bf16_t* b0 = VTS + ((long)mt * 2 * 2048 + g * 256 + dt * 128) * 64;
    const bool prompt = mt < 256;
    gemm_tile(smem, [=](int r, int kt) { return a0 + r * 128 + kt * 64; }, [=](int r, int kt) { return b0 + (long)kt * 2048 * 64 + r * 64; }, 2,
              [=](int row0, int col, float4 v0, float4 v1) {
                const int gc = g * 256 + dt * 128 + col;
#pragma unroll
                for (int j = 0; j < 4; ++j) {
                  const int tr = row0 + j;
                  const float bias = bs[g * 128 + (prompt ? tr : (tr & 63))];
                  const long o = (long)(mt * 128 + tr) * 2048 + gc;
                  G[o] = f2bf(bf2f(U[o]) * (f4get(v0, j) + bias));
                  G[o + 32] = f2bf(bf2f(U[o + 32]) * (f4get(v1, j) + bias));
                }
              });
  }
}

DI void phase_final_norm(const P& p) {
  const int lane = threadIdx.x & 63;
  const int wv = blockIdx.x * 4 + (threadIdx.x >> 6), nwv = gridDim.x * 4;
  const float* gam = p.in[16];
  for (int row = wv; row < NT; row += nwv) {
    float* x = p.out + (long)row * 1024;
    float4 v[4];
    float ss = 0.f;
#pragma unroll
    for (int i = 0; i < 4; ++i) {
      v[i] = *(const float4*)(x + lane * 4 + 256 * i);
      ss += v[i].x * v[i].x + v[i].y * v[i].y + v[i].z * v[i].z + v[i].w * v[i].w;
    }
    ss = wave_sum(ss);
    const float rinv = rsqrtf(ss * (1.f / 1024.f) + NORM_EPS);
#pragma unroll
    for (int i = 0; i < 4; ++i) {
      const int col = lane * 4 + 256 * i;
      const float4 g4 = *(const float4*)(gam + col);
      const f32x4n yv = {v[i].x * rinv * g4.x, v[i].y * rinv * g4.y, v[i].z * rinv * g4.z, v[i].w * rinv * g4.w};
      __builtin_nontemporal_store(yv, (f32x4n*)(x + col));
    }
  }
}

DI bf16x8 pack8(const f32x16& x, int s) {
  unsigned a = pack2(x[8 * s], x[8 * s + 1]), b = pack2(x[8 * s + 2], x[8 * s + 3]), c = pack2(x[8 * s + 4], x[8 * s + 5]), d = pack2(x[8 * s + 6], x[8 * s + 7]);
  uint4 u = {a, b, c, d};
  return __builtin_bit_cast(bf16x8, u);
}

DI unsigned xb_xcc_id_fwd() { return (unsigned)__builtin_amdgcn_s_getreg((3 << 11) | 20) & 0xFu; }
template <bool MLA>
DI void phase_attn(const P& p, bf16_t* smem) {
  constexpr int NKS = MLA ? 6 : 4;
  constexpr int NDT = MLA ? 2 : 4;
  constexpr int NLD = MLA ? 9 : 8;
  unsigned char* big = p.ws + W_BIG;
  const bf16_t* Q = (const bf16_t*)(big + (MLA ? B_QM : B_QB));
  const bf16_t* KK = (const bf16_t*)(big + (MLA ? B_KN : B_KB));
  const bf16_t* KR = (const bf16_t*)(big + B_KR);
  const bf16_t* VT = (const bf16_t*)(big + (MLA ? B_VTM : B_VTD));
  bf16_t* OB = (bf16_t*)(big + (MLA ? B_OBM : B_OB));
  const float lam = *(const float*)(p.ws + W_LAM);
  const float* gsub = p.in[32];
  const int tid = threadIdx.x, lane = tid & 63, wave = tid >> 6;
  const int wp = wave >> 1, wq = wave & 1, r = lane & 31, hh = lane >> 5;
  constexpr int L_K0 = 0, L_K1 = 4608, L_KR = 9216, L_V0 = MLA ? 11776 : 9216, L_V1 = 16384;
  __shared__ int s_item;
  unsigned* qctr = (unsigned*)(p.ws + W_CTRL) + 3584 + (MLA ? 64 : 0);
  const int xs = (int)(xb_xcc_id_fwd() & 7u);
  for (int pass = 0; pass < 8; ++pass) {
  const int hx = (xs + pass) & 7;
  for (;;) {
    if (tid == 0) s_item = (int)atomicAdd(&qctr[hx * 8], 1u);
    __syncthreads();
    const int jq = s_item;
    __syncthreads();
    if (jq >= 528) break;
    int b, qrow0, ntiles, Lk; long R0, vbase;
    if (jq < 16) {
      b = jq; qrow0 = NTP + b * 64; ntiles = 65; Lk = SLK;
      R0 = (long)NTP + (long)b * SLK; vbase = 4l * 1024 * 8192 + (long)b * 1024 * SLK;
    } else {
      const int i = jq - 16; const int qc = 127 - (i >> 2); b = i & 3;
      qrow0 = b * 8192 + qc * 64; ntiles = qc + 1; Lk = 8192; R0 = (long)b * 8192; vbase = (long)b * 1024 * 8192;
    }
    bf16x8 qf[NKS];
    {
      const long qr = (long)(qrow0 + wq * 32 + r);
      const bf16_t* qp = MLA ? Q + qr * 1536 + (hx * 2 + wp) * 96 + 8 * hh : Q + qr * 1024 + (hx * 2 + wp) * 64 + 8 * hh;
#pragma unroll
      for (int ks = 0; ks < NKS; ++ks) qf[ks] = *(const bf16x8*)(qp + ks * 16);
    }
    f32x16 O[NDT];
#pragma unroll
    for (int d = 0; d < NDT; ++d)
#pragma unroll
      for (int i = 0; i < 16; ++i) O[d][i] = 0.f;
    float m_run = -1e30f, l_run = 0.f;
    u32x4 ld[NLD];
#define ATT_GLOAD(KT)                                                                                                   \
  {                                                                                                                     \
    const long kr0 = R0 + (long)(KT) * 64;                                                                              \
    _Pragma("unroll") for (int j = 0; j < 4; ++j) {                                                                     \
      const int c = j >> 1, id = tid + 256 * (j & 1), key = id >> 3, ch = id & 7;                                       \
      ld[j] = *(const u32x4*)(KK + (kr0 + key) * 1024 + (hx * 2 + c) * 64 + ch * 8);                                    \
    }                                                                                                                   \
    if (!MLA) {                                                                                                         \
      _Pragma("unroll") for (int i = 0; i < 4; ++i) {                                                                   \
        const int id = tid + 256 * i, dv = id >> 3, ch = id & 7;                                                        \
        ld[4 + i] = *(const u32x4*)(VT + vbase + (long)(hx * 128 + dv) * Lk + (KT) * 64 + ch * 8);                      \
      }                                                                                                                 \
    } else {                                                                                                            \
      _Pragma("unroll") for (int j = 0; j < 4; ++j) {                                                                   \
        const int c = j >> 1, id = tid + 256 * (j & 1), dv = id >> 3, ch = id & 7;                                      \
        ld[4 + j] = *(const u32x4*)(VT + vbase + (long)((hx * 2 + c) * 64 + dv) * Lk + (KT) * 64 + ch * 8);             \
      }                                                                                                                 \
      ld[NLD - 1] = *(const u32x4*)(KR + (kr0 + (tid >> 2)) * 32 + (tid & 3) * 8);                                      \
    }                                                                                                                   \
  }
#define ATT_SWRITE()                                                                                                    \
  {                                                                                                                     \
    _Pragma("unroll") for (int j = 0; j < 4; ++j) {                                                                     \
      const int c = j >> 1, id = tid + 256 * (j & 1), key = id >> 3, ch = id & 7;                                       \
      *(u32x4*)(smem + (c ? L_K1 : L_K0) + key * LST + ch * 8) = ld[j];                                                 \
    }                                                                                                                   \
    if (!MLA) {                                                                                                         \
      _Pragma("unroll") for (int i = 0; i < 4; ++i) {                                                                   \
        const int id = tid + 256 * i, dv = id >> 3, ch = id & 7;                                                        \
        *(u32x4*)(smem + L_V0 + dv * LST + ch * 8) = ld[4 + i];                                                         \
      }                                                                                                                 \
    } else {                                                                                                            \
      _Pragma("unroll") for (int j = 0; j < 4; ++j) {                                                                   \
        const int c = j >> 1, id = tid + 256 * (j & 1), dv = id >> 3, ch = id & 7;                                      \
        *(u32x4*)(smem + (c ? L_V1 : L_V0) + dv * LST + ch * 8) = ld[4 + j];                                            \
      }                                                                                                                 \
      *(u32x4*)(smem + L_KR + (tid >> 2) * 40 + (tid & 3) * 8) = ld[NLD - 1];                                           \
    }                                                                                                                   \
  }
    ATT_GLOAD(0)
    const bf16_t* sK = smem + (wp ? L_K1 : L_K0);
    const bf16_t* sV = smem + ((MLA && wp) ? L_V1 : L_V0);
    for (int kt = 0; kt < ntiles; ++kt) {
      __syncthreads();
      ATT_SWRITE()
      __syncthreads();
      if (kt + 1 < ntiles) ATT_GLOAD(kt + 1)
      __builtin_amdgcn_sched_barrier(0);
      f32x16 st[2];
#pragma unroll
      for (int mt = 0; mt < 2; ++mt) {
#pragma unroll
        for (int i = 0; i < 16; ++i) st[mt][i] = 0.f;
#pragma unroll
        for (int ks = 0; ks < NKS; ++ks) {
          bf16x8 a;
          if (ks < 4) a = *(const bf16x8*)(sK + (mt * 32 + r) * LST + ks * 16 + 8 * hh);
          else a = *(const bf16x8*)(smem + L_KR + (mt * 32 + r) * 40 + (ks - 4) * 16 + 8 * hh);
          st[mt] = MFMA(a, qf[ks], st[mt]);
        }
      }
      float mloc = st[0][0];
#pragma unroll
      for (int i = 1; i < 16; ++i) mloc = fmaxf(mloc, st[0][i]);
#pragma unroll
      for (int i = 0; i < 16; ++i) mloc = fmaxf(mloc, st[1][i]);
      mloc = fmaxf(mloc, __shfl_xor(mloc, 32));
      const bool need = mloc > m_run + 8.f;
      if (__any(need)) {
        const float mnew = need ? mloc : m_run;
        const float alpha = __builtin_amdgcn_exp2f(m_run - mnew);
        m_run = mnew;
        l_run *= alpha;
#pragma unroll
        for (int d = 0; d < NDT; ++d)
#pragma unroll
          for (int i = 0; i < 16; ++i) O[d][i] *= alpha;
      }
      float ps = 0.f;
#pragma unroll
      for (int mt = 0; mt < 2; ++mt)
#pragma unroll
        for (int i = 0; i < 16; ++i) { const float e = __builtin_amdgcn_exp2f(st[mt][i] - m_run); st[mt][i] = e; ps += e; }
      l_run += ps;
#pragma unroll
      for (int k2 = 0; k2 < 4; ++k2) {
        const bf16x8 pf = pack8(st[k2 >> 1], k2 & 1);
#pragma unroll
        for (int d = 0; d < NDT; ++d) {
          const bf16x8 va = *(const bf16x8*)(sV + (d * 32 + r) * LST + 16 * k2 + 8 * hh);
          O[d] = MFMA(va, pf, O[d]);
        }
      }
    }
    const float ltot = l_run + __shfl_xor(l_run, 32);
    const float linv = 1.f / ltot;
    const long orow = (long)(qrow0 + wq * 32 + r);
    if (MLA) {
#pragma unroll
      for (int d = 0; d < NDT; ++d)
#pragma unroll
        for (int g = 0; g < 4; ++g) {
          uint2 o = {pack2(O[d][4 * g] * linv, O[d][4 * g + 1] * linv), pack2(O[d][4 * g + 2] * linv, O[d][4 * g + 3] * linv)};
          *(uint2*)(OB + orow * 1024 + (hx * 2 + wp) * 64 + d * 32 + 8 * g + 4 * hh) = o;
        }
    } else {
      float* xs = (float*)smem;
      __syncthreads();
      if (wp == 1) {
#pragma unroll
        for (int d = 0; d < NDT; ++d)
#pragma unroll
          for (int i = 0; i < 16; ++i) xs[(wq * 64 + d * 16 + i) * 64 + lane] = O[d][i] * linv;
      }
      __syncthreads();
      if (wp == 0) {
        float ss = 0.f;
#pragma unroll
        for (int d = 0; d < NDT; ++d)
#pragma unroll
          for (int i = 0; i < 16; ++i) {
            const float o = O[d][i] * linv - lam * xs[(wq * 64 + d * 16 + i) * 64 + lane];
            O[d][i] = o; ss += o * o;
          }
        ss += __shfl_xor(ss, 32);
        const float rinv = rsqrtf(ss * (1.f / 128.f) + NORM_EPS) * (1.f - LAMBDA_INIT);
#pragma unroll
        for (int d = 0; d < NDT; ++d)
#pragma unroll
          for (int g = 0; g < 4; ++g) {
            const int dv = d * 32 + 8 * g + 4 * hh;
            const float4 gs4 = *(const float4*)(gsub + dv);
            uint2 o = {pack2(O[d][4 * g] * rinv * gs4.x, O[d][4 * g + 1] * rinv * gs4.y), pack2(O[d][4 * g + 2] * rinv * gs4.z, O[d][4 * g + 3] * rinv * gs4.w)};
            *(uint2*)(OB + orow * 1024 + hx * 128 + dv) = o;
          }
      }
    }
  }
  }
}


#define XB_TMO      128
#define XB_XCNT(j)  (256  + 64 * (j))
#define XB_XSUB(j)  (1280 + 64 * (j))
#define XB_XGEN(j)  (2304 + 64 * (j))
#define XB_TOP      3328
#define XB_TOPGEN   3392
#define XCD_BAR_WORDS 3456
#define XB_SPIN_CAP (1u << 22)
#define LAS __attribute__((address_space(3)))
DI unsigned xb_ld(unsigned* p) { return __hip_atomic_load(p, __ATOMIC_RELAXED, __HIP_MEMORY_SCOPE_AGENT); }
DI unsigned xb_add(unsigned* p, unsigned v) { return __hip_atomic_fetch_add(p, v, __ATOMIC_RELAXED, __HIP_MEMORY_SCOPE_AGENT); }
DI unsigned xb_xcc_id() { return (unsigned)__builtin_amdgcn_s_getreg((3 << 11) | 20) & 0xFu; }
#define XB_SPIN(cond, bar) do { unsigned _sp = 0; while (cond) { __builtin_amdgcn_s_sleep(1); \
    if ((++_sp & 255u) == 0u) { if (xb_ld(&(bar)[XB_TMO])) break; if (_sp > XB_SPIN_CAP) { atomicAdd(&(bar)[XB_TMO], 1u); break; } } } } while (0)
struct XcdBarrier { unsigned* bar; unsigned x; volatile LAS unsigned* st; };
DI XcdBarrier xcd_barrier_post(unsigned* bar, volatile LAS unsigned* st) {
  XcdBarrier b; b.bar = bar; b.x = xb_xcc_id(); b.st = st;
  if (threadIdx.x == 0) (void)xb_add(&bar[XB_XCNT(b.x)], 1u);
  return b;
}
DI void xcd_barrier_complete(unsigned* bar, unsigned x, unsigned& nloc, unsigned& nx) {
  const unsigned G = gridDim.x * gridDim.y * gridDim.z;
  unsigned sum, cnt, mine, sp = 0u;
  for (;;) {
    sum = 0u; cnt = 0u; mine = 0u;
#pragma unroll
    for (unsigned j = 0; j < 16; ++j) { const unsigned c = xb_ld(&bar[XB_XCNT(j)]); sum += c; cnt += (c > 0u) ? 1u : 0u; mine = (j == x) ? c : mine; }
    if (sum == G) break;
    __builtin_amdgcn_s_sleep(1);
    if ((++sp & 255u) == 0u) { if (xb_ld(&bar[XB_TMO])) break; if (sp > XB_SPIN_CAP) { atomicAdd(&bar[XB_TMO], 1u); break; } }
  }
  nloc = mine > 0u ? mine : 1u; nx = cnt > 0u ? cnt : 1u;
}
DI void xcd_barrier(const XcdBarrier& b) {
  asm volatile("s_waitcnt vmcnt(0)" ::: "memory");
  __syncthreads();
  if (threadIdx.x == 0) {
    unsigned* bar = b.bar;
    __builtin_amdgcn_s_waitcnt(0);
    unsigned nloc = b.st[0], nx = b.st[1];
    if (nloc == 0u) { xcd_barrier_complete(bar, b.x, nloc, nx); b.st[0] = nloc; b.st[1] = nx; }
    const unsigned old = xb_add(&bar[XB_XSUB(b.x)], 1u);
    const unsigned gen = old / nloc;
    if (old + 1u == (gen + 1u) * nloc) {
      __builtin_amdgcn_fence(__ATOMIC_RELEASE, "agent");
      asm volatile("s_waitcnt vmcnt(0)" ::: "memory");
      const unsigned og = xb_add(&bar[XB_TOP], 1u);
      const unsigned tg = og / nx;
      if (og + 1u == (tg + 1u) * nx) xb_add(&bar[XB_TOPGEN], 1u);
      else XB_SPIN(xb_ld(&bar[XB_TOPGEN]) == tg, bar);
      __builtin_amdgcn_fence(__ATOMIC_ACQUIRE, "agent");
      xb_add(&bar[XB_XGEN(b.x)], 1u);
      asm volatile("s_waitcnt vmcnt(0)" ::: "memory");
    } else {
      XB_SPIN(xb_ld(&bar[XB_XGEN(b.x)]) == gen, bar);
      __builtin_amdgcn_fence(__ATOMIC_ACQUIRE, "agent");
      asm volatile("s_waitcnt vmcnt(0)" ::: "memory");
    }
  }
  __syncthreads();
}

constexpr int NPH = 35;
__global__ void __launch_bounds__(256, 2) mk_forward(P p) {
  __shared__ __attribute__((aligned(16))) unsigned char smem_raw[73728];
  cg::grid_group grid = cg::this_grid();
  __shared__ uint4 xb_words;
  if (threadIdx.x == 0) xb_words = make_uint4(0u, 0u, 0u, 0u);
  __syncthreads();
  XcdBarrier xb;
  xb.bar = (unsigned*)(p.ws + W_CTRL); xb.x = 0; xb.st = (volatile LAS unsigned*)&xb_words;
  if (p.hi - p.lo > 1) xb = xcd_barrier_post((unsigned*)(p.ws + W_CTRL), (volatile LAS unsigned*)&xb_words);
  bf16_t* smem = (bf16_t*)smem_raw;
  float* smf = (float*)smem_raw;
  unsigned char* big = p.ws + W_BIG;
  int ph = 0;
#ifdef PROBE_DUP_UP
#define PROBE_UP(l) __syncthreads(); phase_mlp_up(p, smem, l)
#else
#define PROBE_UP(l)
#endif
#ifdef PROBE_DUP_ATTN
#define PROBE_AT(m) __syncthreads(); phase_attn<m>(p, smem)
#else
#define PROBE_AT(m)
#endif
#ifndef ONLY_PH
#define ONLY_PH -1
#endif
#ifndef DUPMASK
#define DUPMASK 0ull
#endif
#define PH(...) { if ((ONLY_PH < 0 || ph == ONLY_PH) && ph >= p.lo && ph < p.hi) { __VA_ARGS__; if ((DUPMASK >> ph) & 1ull) { __syncthreads(); __VA_ARGS__; } } ++ph; if (ph > p.lo && ph < p.hi) { if (p.hi < 0) grid.sync(); else xcd_barrier(xb); } }
  PH(phase0(p, smf))
  PH(phase1(p))
  PH(phase_modulate<1>(p, 0, 0))
  PH(phase_s5a(p, smem))
  PH(phase_s5_carry(p))
  PH(phase_s5b(p, smem))
  PH(phase_glu(p, smem))
  PH(phase_modulate<0>(p, 0, 1))
  PH(phase_mlp_up(p, smem, 0); PROBE_UP(0))
  PH(phase_mlp_down(p, smem, 0))
  PH(phase_modulate<0>(p, 1, 0))
  PH(phase_qkv(p, smem))
  PH(phase_attn<false>(p, smem); PROBE_AT(false))
  PH(phase_proj_resid(p, smem, (const bf16_t*)(big + B_OB), 1024, (const bf16_t*)(p.ws + W_DWO), 1))
  PH(phase_modulate<0>(p, 1, 1))
  PH(phase_mlp_up(p, smem, 1); PROBE_UP(1))
  PH(phase_mlp_down(p, smem, 1))
  PH(phase_modulate<0>(p, 2, 0))
  PH(phase_mla_down(p, smem))
  PH(phase_mla_norm(p))
  PH(phase_mla_up(p, smem))
  PH(phase_attn<true>(p, smem); PROBE_AT(true))
  PH(phase_proj_resid(p, smem, (const bf16_t*)(big + B_OBM), 1024, (const bf16_t*)(p.ws + W_MWO), 2))
  PH(phase_modulate<0>(p, 2, 1))
  PH(phase_mlp_up(p, smem, 2); PROBE_UP(2))
  PH(phase_mlp_down(p, smem, 2))
  PH(phase_modulate<0>(p, 3, 0))
  PH(phase_sgu_in(p, smem))
  PH(phase_sgu_norm(p, smf))
  PH(phase_sgu_spatial(p, smem))
  PH(phase_proj_resid(p, smem, (const bf16_t*)(big + B_G), 2048, (const bf16_t*)(p.ws + W_SOUT), 3))
  PH(phase_modulate<0>(p, 3, 1))
  PH(phase_mlp_up(p, smem, 3); PROBE_UP(3))
  PH(phase_mlp_down(p, smem, 3))
  PH(phase_final_norm(p))
#undef PH
}

extern "C" void kernel_launch(void* const* d_in, const int* in_sizes, int n_in, void* d_out, int out_size, void* d_ws, size_t ws_size,
                              hipStream_t stream) {
  static int grid_blocks = 0;
  if (!grid_blocks) {
    int dev = 0, cus = 0, per_cu = 0;
    hipGetDevice(&dev);
    hipDeviceGetAttribute(&cus, hipDeviceAttributeMultiprocessorCount, dev);
    hipOccupancyMaxActiveBlocksPerMultiprocessor(&per_cu, mk_forward, 256, 0);
    if (per_cu < 1) per_cu = 1;
    if (per_cu > 2) per_cu = 2;
    grid_blocks = cus * per_cu;
    if (ws_size < WS_NEED) fprintf(stderr, "kernel_launch: workspace too small: %zu < %zu\n", ws_size, (size_t)WS_NEED);
  }
  P p{};
  for (int i = 0; i < 47; ++i) p.in[i] = (const float*)d_in[i];
  p.out = (float*)d_out;
  p.ws = (unsigned char*)d_ws;
#if MK_SINGLE
  (void)hipMemsetAsync(d_ws, 0, 32768, stream);
  p.lo = 0; p.hi = NPH;
  void* args[] = {&p};
  hipError_t e = hipLaunchCooperativeKernel((void*)mk_forward, dim3(grid_blocks), dim3(256), args, 0, stream);
  if (e != hipSuccess) fprintf(stderr, "cooperative launch failed: %s (grid %d)\n", hipGetErrorString(e), grid_blocks);
#else
  for (int ph = 0; ph < NPH; ++ph) {
    p.lo = ph; p.hi = ph + 1;
    hipLaunchKernelGGL(mk_forward, dim3(grid_blocks), dim3(256), 0, stream, p);
  }
#endif
}
```
